# Optimizing an MI355X kernel written in HIP

```python
import math
import jax
import jax.numpy as jnp
from jax import lax
import numpy as np

D_MODEL = 1024
BATCH = 4
SEQ = 4096
DEPTH = 4

GRID_W = 64
CTX_LEN = 256
N_GROUPS = 4
GROUP_W = D_MODEL // N_GROUPS
GROUP_HEADS = 4
HEAD_DIM = GROUP_W // GROUP_HEADS
NA_WIN_H = 8
NA_WIN_W = 16
DN_CONV_K = 5
DN_CHUNK = 64
DIFF_DIM = HEAD_DIM // 2
Q_BLOCK = 128
FT_DIM = GROUP_W // GROUP_HEADS
N_EXPERTS = 16
EC_FACTOR = 2
D_EXPERT = 2 * D_MODEL
ROPE_BASE = 10000.0
RMS_EPS = 1e-6
IN_WIDTHS = (GROUP_W, GROUP_W, GROUP_W, 3 * GROUP_W, 2 * GROUP_HEADS, 2 * GROUP_HEADS, GROUP_W, GROUP_W, GROUP_W, GROUP_W, GROUP_W)
IN_W = 11 * GROUP_W + 4 * GROUP_HEADS
F32 = jnp.float32

kernel_name = 'hybrid_parallel_group_dit_block'


def rmsnorm(x, g):
    xf = x.astype(F32)
    y = xf * lax.rsqrt(jnp.mean(xf * xf, axis=-1, keepdims=True) + RMS_EPS)
    return (y * g.astype(F32)).astype(x.dtype)


def l2norm(x):
    return x * lax.rsqrt(jnp.sum(x * x, axis=-1, keepdims=True) + 1e-6)


def modulate(h, shift, scale):
    return h * (1 + scale) + shift


def split_heads(t, d=HEAD_DIM):
    return t.reshape(*t.shape[:-1], t.shape[-1] // d, d)


def split_proj(p):
    idx, acc = [], 0
    for w in IN_WIDTHS[:-1]:
        acc += w
        idx.append(acc)
    return jnp.split(p, idx, axis=-1)


def axial_rope(n_tok, dim):
    t = jnp.arange(n_tok)
    pos = jnp.stack([t // GRID_W, t % GRID_W], axis=-1).astype(F32)
    n_freq = dim // 4
    inv = ROPE_BASE ** (-jnp.arange(n_freq, dtype=F32) / n_freq)
    ang = (pos[:, :, None] * inv).reshape(n_tok, 2 * n_freq)
    return jnp.cos(ang), jnp.sin(ang)


def apply_rope(x, cos, sin):
    xf = x.astype(F32).reshape(*x.shape[:-1], -1, 2)
    x1, x2 = xf[..., 0], xf[..., 1]
    out = jnp.stack([x1 * cos - x2 * sin, x1 * sin + x2 * cos], axis=-1)
    return out.reshape(x.shape).astype(x.dtype)


def softmax_attention(q, k, v):
    s = jnp.einsum('bqhd,bkhd->bhqk', q, k).astype(F32) * q.shape[-1] ** -0.5
    p = jax.nn.softmax(s, axis=-1)
    return jnp.einsum('bhqk,bkhd->bqhd', p, v.astype(F32))


def neighbourhood_attention(q, k, v, k_ctx, v_ctx, rpb):
    B, S, H, dh = q.shape
    rows = S // GRID_W
    wh = min(NA_WIN_H, rows)
    r = jnp.arange(rows)
    row_idx = jnp.clip(r - wh // 2, 0, rows - wh)[:, None] + jnp.arange(wh)[None, :]
    cq = jnp.arange(GRID_W)
    c0 = jnp.clip(cq - NA_WIN_W // 2, 0, GRID_W - NA_WIN_W)
    in_win = (cq[None, :] >= c0[:, None]) & (cq[None, :] < c0[:, None] + NA_WIN_W)
    dy = row_idx - r[:, None] + NA_WIN_H - 1
    dx = jnp.clip(cq[None, :] - cq[:, None], 1 - NA_WIN_W, NA_WIN_W - 1) + NA_WIN_W - 1
    bias = rpb[:, dy[:, None, :, None], dx[None, :, None, :]].astype(F32)
    qg = q.reshape(B, rows, GRID_W, H, dh)
    k_blk = k.reshape(B, rows, GRID_W, H, dh)[:, row_idx]
    v_blk = v.reshape(B, rows, GRID_W, H, dh)[:, row_idx]
    scale = dh ** -0.5
    s_win = jnp.einsum('brqhd,brwkhd->bhrqwk', qg, k_blk).astype(F32) * scale + bias
    s_win = jnp.where(in_win[:, None, :], s_win, -jnp.inf)
    s_ctx = jnp.einsum('brqhd,blhd->bhrql', qg, k_ctx).astype(F32) * scale
    n_win = wh * GRID_W
    p = jax.nn.softmax(jnp.concatenate([s_win.reshape(B, H, rows, GRID_W, n_win), s_ctx], axis=-1), axis=-1)
    p_win = p[..., :n_win].reshape(B, H, rows, GRID_W, wh, GRID_W)
    p_ctx = p[..., n_win:]
    out = jnp.einsum('bhrqwk,brwkhd->brqhd', p_win, v_blk.astype(F32)) + jnp.einsum('bhrql,blhd->brqhd', p_ctx, v_ctx.astype(F32))
    return out.reshape(B, S, H, dh)


def short_conv(u, w):
    return lax.conv_general_dilated(u, w[:, None, :].astype(u.dtype), window_strides=(1,), padding=[(DN_CONV_K // 2, DN_CONV_K // 2)], dimension_numbers=('NWC', 'WIO', 'NWC'), feature_group_count=u.shape[-1])


def chunk_gated_delta(q, k, v, g, beta, s0):
    B, T, H, dk = q.shape
    n, C = T // DN_CHUNK, DN_CHUNK

    def chunks(t):
        return jnp.swapaxes(t.reshape(B, n, C, H, *t.shape[3:]), 2, 3)
    qc, kc, vc, bc = chunks(q), chunks(k), chunks(v), chunks(beta)
    gc = jnp.cumsum(chunks(g), axis=-1)
    incl = jnp.tril(jnp.ones((C, C), bool))
    strict = jnp.tril(jnp.ones((C, C), bool), -1)
    decay = jnp.exp(jnp.where(incl, gc[..., :, None] - gc[..., None, :], -jnp.inf))
    kb = kc * bc[..., None]
    lower = jnp.where(strict, jnp.einsum('bnhid,bnhjd->bnhij', kb, kc) * decay, 0.0)
    eye = jnp.eye(C, dtype=F32)
    t_inv = lax.linalg.triangular_solve(eye + lower, jnp.broadcast_to(eye, lower.shape), left_side=True, lower=True, unit_diagonal=True)
    u = t_inv @ (vc * bc[..., None])
    w = t_inv @ (kb * jnp.exp(gc)[..., None])
    qk = jnp.where(incl, jnp.einsum('bnhid,bnhjd->bnhij', qc, kc) * decay, 0.0)
    q_dec = qc * jnp.exp(gc)[..., None]
    k_dec = kc * jnp.exp(gc[..., -1:] - gc)[..., None]
    g_last = jnp.exp(gc[..., -1])

    def step(s, xs):
        u_i, w_i, qk_i, qd_i, kd_i, gl_i = xs
        v_new = u_i - jnp.einsum('bhcd,bhde->bhce', w_i, s)
        o_i = jnp.einsum('bhcd,bhde->bhce', qd_i, s) + jnp.einsum('bhcj,bhje->bhce', qk_i, v_new)
        s = s * gl_i[..., None, None] + jnp.einsum('bhcd,bhce->bhde', kd_i, v_new)
        return s, o_i
    xs = tuple(jnp.swapaxes(t, 0, 1) for t in (u, w, qk, q_dec, k_dec, g_last))
    s_fin, o = lax.scan(step, s0, xs)
    o = jnp.swapaxes(jnp.swapaxes(o, 0, 1), 2, 3).reshape(B, T, H, -1)
    return o, s_fin


def gated_deltanet(lat, ctx, conv_w, a_log, dt_bias, norm_g):
    def prep(qkv, a, b):
        B, T, _ = qkv.shape
        qkv = jax.nn.silu(short_conv(qkv, conv_w)).astype(F32)
        q, k, v = [split_heads(t) for t in jnp.split(qkv, 3, axis=-1)]
        q = l2norm(q) * HEAD_DIM ** -0.5
        k = l2norm(k)
        a = a.astype(F32).reshape(B, T, 2, GROUP_HEADS)
        b = b.astype(F32).reshape(B, T, 2, GROUP_HEADS)
        g = -jnp.exp(a_log.astype(F32)) * jax.nn.softplus(a + dt_bias.astype(F32))
        return q, k, v, g, jax.nn.sigmoid(b)
    ql, kl, vl, gl, bl = prep(lat[0], lat[1], lat[2])
    qc, kc, vc, gc, bc = prep(ctx[0], ctx[1], ctx[2])
    s0 = jnp.zeros((ql.shape[0], GROUP_HEADS, HEAD_DIM, HEAD_DIM), F32)
    flip = lambda t: jnp.flip(t, axis=1)
    oc_f, sc_f = chunk_gated_delta(qc, kc, vc, gc[:, :, 0], bc[:, :, 0], s0)
    ol_f, _ = chunk_gated_delta(ql, kl, vl, gl[:, :, 0], bl[:, :, 0], sc_f)
    oc_b, sc_b = chunk_gated_delta(flip(qc), flip(kc), flip(vc), flip(gc[:, :, 1]), flip(bc[:, :, 1]), s0)
    ol_b, _ = chunk_gated_delta(flip(ql), flip(kl), flip(vl), flip(gl[:, :, 1]), flip(bl[:, :, 1]), sc_b)

    def finish(o, gate):
        y = rmsnorm(o, norm_g) * jax.nn.silu(split_heads(gate.astype(F32)))
        return y.reshape(gate.shape).astype(gate.dtype)
    return finish(ol_f + flip(ol_b), lat[3]), finish(oc_f + flip(oc_b), ctx[3])


def diff_core(q, k, v, lam):
    s = jnp.einsum('bqhmd,bkhmd->bhmqk', q, k).astype(F32) * q.shape[-1] ** -0.5
    p = jax.nn.softmax(s, axis=-1)
    a = p[:, :, 0] - lam * p[:, :, 1]
    return jnp.einsum('bhqk,bkhd->bqhd', a, v.astype(F32))


def fourier_mix(u, w):
    B, T, _ = u.shape
    uf = u.astype(F32).reshape(B, T, GROUP_HEADS, FT_DIM)
    y = jnp.fft.fft2(uf, axes=(1, 3), norm='ortho').real.reshape(B, T, GROUP_W)
    return (y @ w.astype(F32)).astype(u.dtype)


def expert_choice_ffn(h, w_router, w_gate, w_up, w_down):
    B, N, D = h.shape
    cap = EC_FACTOR * N // N_EXPERTS
    aff = jax.nn.softmax((h @ w_router).astype(F32), axis=-1)
    gate, idx = lax.top_k(jnp.swapaxes(aff, 1, 2), cap)
    xg = jax.vmap(lambda hb, ib: hb[ib])(h, idx)
    hid = jax.nn.silu(jnp.einsum('becd,edf->becf', xg, w_gate)) * jnp.einsum('becd,edf->becf', xg, w_up)
    y = jnp.einsum('becf,efd->becd', hid, w_down) * gate[..., None].astype(h.dtype)
    return jax.vmap(lambda yb, ib: jnp.zeros((N, D), yb.dtype).at[ib.reshape(-1)].add(yb.reshape(-1, D)))(y, idx)


def token_mixers(h_lat, h_ctx, w_in, rpb, conv_w, a_log, dt_bias, dn_g, df_lam, lam_init, df_g, ft_w, cos, sin, ctx_out):
    B, S, _ = h_lat.shape
    L = h_ctx.shape[1]
    (na_q, na_k, na_v, dn_qkv, dn_a, dn_b, dn_gate, df_q, df_k, df_v, ft_u) = split_proj(h_lat @ w_in)
    (cna_q, cna_k, cna_v, cdn_qkv, cdn_a, cdn_b, cdn_gate, cdf_q, cdf_k, cdf_v, cft_u) = split_proj(h_ctx @ w_in)
    diff_heads = lambda t: t.reshape(*t.shape[:-1], GROUP_HEADS, 2, DIFF_DIM)
    dt = h_lat.dtype
    o_na = neighbourhood_attention(split_heads(na_q), split_heads(na_k), split_heads(na_v), split_heads(cna_k), split_heads(cna_v), rpb)
    o_dn, c_dn = gated_deltanet((dn_qkv, dn_a, dn_b, dn_gate), (cdn_qkv, cdn_a, cdn_b, cdn_gate), conv_w, a_log, dt_bias, dn_g)
    lq1, lk1, lq2, lk2 = df_lam.astype(F32)
    lam = jnp.exp(jnp.sum(lq1 * lk1)) - jnp.exp(jnp.sum(lq2 * lk2)) + lam_init
    q_d = apply_rope(diff_heads(df_q), cos, sin)
    k_d = apply_rope(diff_heads(df_k), cos, sin)
    kc_d, vc_d = diff_heads(cdf_k), split_heads(cdf_v)
    k_all = jnp.concatenate([kc_d, k_d], axis=1)
    v_all = jnp.concatenate([vc_d, split_heads(df_v)], axis=1)
    q_blocks = jnp.swapaxes(q_d.reshape(B, S // Q_BLOCK, Q_BLOCK, GROUP_HEADS, 2, DIFF_DIM), 0, 1)
    o_df = lax.map(lambda qb: diff_core(qb, k_all, v_all, lam), q_blocks)
    o_df = jnp.swapaxes(o_df, 0, 1).reshape(B, S, GROUP_HEADS, HEAD_DIM)
    diff_out = lambda o: rmsnorm(o, df_g) * (1.0 - lam_init)
    o_ft = fourier_mix(ft_u, ft_w)
    mix_lat = jnp.concatenate([o_na.reshape(B, S, GROUP_W).astype(dt), o_dn.astype(dt), diff_out(o_df).reshape(B, S, GROUP_W).astype(dt), o_ft.astype(dt)], axis=-1)
    if not ctx_out:
        return mix_lat, None
    c_na = softmax_attention(split_heads(cna_q), split_heads(cna_k), split_heads(cna_v))
    c_df = diff_out(diff_core(diff_heads(cdf_q), kc_d, vc_d, lam))
    c_ft = fourier_mix(cft_u, ft_w)
    mix_ctx = jnp.concatenate([c_na.reshape(B, L, GROUP_W).astype(dt), c_dn.astype(dt), c_df.reshape(B, L, GROUP_W).astype(dt), c_ft.astype(dt)], axis=-1)
    return mix_lat, mix_ctx


def setup_inputs(seed: int = 0) -> dict:
    key = jax.random.key(seed)
    ks = jax.random.split(key, 24)
    nrm = lambda k, shape, s: jax.random.normal(k, shape, F32) * s
    H = GROUP_HEADS
    a_init = jax.random.uniform(ks[9], (DEPTH, 2, H), F32, 1.0, 16.0)
    dt_init = jnp.exp(jax.random.uniform(ks[10], (DEPTH, 2, H), F32, math.log(1e-3), math.log(1e-1)))
    return {
        'x': nrm(ks[0], (BATCH, SEQ, D_MODEL), 1.0),
        'c': nrm(ks[1], (BATCH, D_MODEL), 1.0),
        'ctx': nrm(ks[2], (BATCH, CTX_LEN, D_MODEL), 1.0),
        'c_ctx': nrm(ks[3], (D_MODEL,), 1.0),
        'w_mod': nrm(ks[4], (DEPTH, D_MODEL, 6 * D_MODEL), 0.5 * D_MODEL ** -0.5),
        'b_mod': nrm(ks[5], (DEPTH, 6 * D_MODEL), 0.01),
        'norm1_g': 1.0 + nrm(ks[6], (DEPTH, D_MODEL), 0.02),
        'w_in': nrm(ks[7], (DEPTH, D_MODEL, IN_W), D_MODEL ** -0.5),
        'na_rpb': nrm(ks[8], (DEPTH, H, 2 * NA_WIN_H - 1, 2 * NA_WIN_W - 1), 0.02),
        'dn_conv_w': nrm(ks[11], (DEPTH, DN_CONV_K, 3 * GROUP_W), DN_CONV_K ** -0.5),
        'dn_a_log': jnp.log(a_init),
        'dn_dt_bias': dt_init + jnp.log(-jnp.expm1(-dt_init)),
        'dn_norm_g': 1.0 + nrm(ks[12], (DEPTH, HEAD_DIM), 0.02),
        'df_lambda': nrm(ks[13], (DEPTH, 4, DIFF_DIM), 0.1),
        'df_norm_g': 1.0 + nrm(ks[14], (DEPTH, HEAD_DIM), 0.02),
        'ft_w': nrm(ks[15], (DEPTH, GROUP_W, GROUP_W), GROUP_W ** -0.5),
        'w_out': nrm(ks[16], (DEPTH, D_MODEL, D_MODEL), D_MODEL ** -0.5),
        'norm2_g': 1.0 + nrm(ks[17], (DEPTH, D_MODEL), 0.02),
        'w_router': nrm(ks[18], (DEPTH, D_MODEL, N_EXPERTS), D_MODEL ** -0.5),
        'w_gate': nrm(ks[19], (DEPTH, N_EXPERTS, D_MODEL, D_EXPERT), D_MODEL ** -0.5),
        'w_up': nrm(ks[20], (DEPTH, N_EXPERTS, D_MODEL, D_EXPERT), D_MODEL ** -0.5),
        'w_down': nrm(ks[21], (DEPTH, N_EXPERTS, D_EXPERT, D_MODEL), D_EXPERT ** -0.5),
        'final_norm_g': 1.0 + nrm(ks[22], (D_MODEL,), 0.02),
    }


def reference(x, c, ctx, c_ctx, w_mod, b_mod, norm1_g, w_in, na_rpb, dn_conv_w, dn_a_log, dn_dt_bias, dn_norm_g, df_lambda, df_norm_g, ft_w, w_out, norm2_g, w_router, w_gate, w_up, w_down, final_norm_g):
    S = x.shape[1]
    cos, sin = axial_rope(S, DIFF_DIM)
    cos, sin = cos[:, None, None, :], sin[:, None, None, :]
    s_lat = jax.nn.silu(c)
    s_ctx = jax.nn.silu(c_ctx)
    x_lat, x_ctx = x, ctx
    for l in range(DEPTH):
        ctx_out = l < DEPTH - 1
        lam_init = 0.8 - 0.6 * math.exp(-0.3 * l)
        m_lat = jnp.split((s_lat @ w_mod[l] + b_mod[l])[:, None, :], 6, axis=-1)
        m_ctx = jnp.split(s_ctx @ w_mod[l] + b_mod[l], 6, axis=-1)
        h_lat = modulate(rmsnorm(x_lat, norm1_g[l]), m_lat[0], m_lat[1])
        h_ctx = modulate(rmsnorm(x_ctx, norm1_g[l]), m_ctx[0], m_ctx[1])
        mix_lat, mix_ctx = token_mixers(h_lat, h_ctx, w_in[l], na_rpb[l], dn_conv_w[l], dn_a_log[l], dn_dt_bias[l], dn_norm_g[l], df_lambda[l], lam_init, df_norm_g[l], ft_w[l], cos, sin, ctx_out)
        x_lat = x_lat + m_lat[2] * (mix_lat @ w_out[l])
        h_lat = modulate(rmsnorm(x_lat, norm2_g[l]), m_lat[3], m_lat[4])
        x_lat = x_lat + m_lat[5] * expert_choice_ffn(h_lat, w_router[l], w_gate[l], w_up[l], w_down[l])
        if ctx_out:
            x_ctx = x_ctx + m_ctx[2] * (mix_ctx @ w_out[l])
            h_ctx = modulate(rmsnorm(x_ctx, norm2_g[l]), m_ctx[3], m_ctx[4])
            x_ctx = x_ctx + m_ctx[5] * expert_choice_ffn(h_ctx, w_router[l], w_gate[l], w_up[l], w_down[l])
    return rmsnorm(x_lat, final_norm_g)
```

```cpp
#ifdef EMU
#include "emu.h"
#define LAS
#define WAIT_VM(n)
#define WAIT_LGKM(n) emu::rendezvous(nullptr, 0, [](emu::Wave*, int) {})
#define CFENCE()
#define LAUNDER_V(x)
#define LAUNDER_S(x)
#else
#include <hip/hip_runtime.h>
#include <cstdio>
#define LAS __attribute__((address_space(3)))
#define WAIT_VM(n) asm volatile("s_waitcnt vmcnt(" #n ")" ::: "memory")
#define WAIT_LGKM(n) asm volatile("s_waitcnt lgkmcnt(" #n ")" ::: "memory")
#define CFENCE() asm volatile("" ::: "memory")
#define LAUNDER_V(x) asm volatile("" : "+v"(x))
#define LAUNDER_S(x) asm volatile("" : "+s"(x))
#endif
#define DI __device__ __forceinline__

#ifndef CFG_BATCH
#define CFG_BATCH 4
#define CFG_SEQ 4096
#define CFG_CTX 256
#define CFG_DEPTH 4
#define CFG_NEXP 16
#define CFG_DEXP 2048
#define CFG_KS 4
#endif
constexpr int NB = CFG_BATCH, SEQ = CFG_SEQ, CTX = CFG_CTX, DEPTH = CFG_DEPTH, NEXP = CFG_NEXP, DEXP = CFG_DEXP, KSPLIT = CFG_KS;
constexpr int D = 1024, GW = 256, NH = 4, HD = 64, GRIDW = 64, GROWS = SEQ / GRIDW;
constexpr int IN_W = 11 * GW + 4 * NH;
constexpr int R_LAT = NB * SEQ, R_CTX = NB * CTX, RT = R_LAT + R_CTX;
constexpr int NTILE = 13, NPROJ = NTILE * 256;
constexpr int PLD = 12 * 256;
constexpr int CAP_LAT = 2 * SEQ / NEXP, CAP_CTX = 2 * CTX / NEXP;
constexpr int EROWS = NB * (CAP_LAT + CAP_CTX), EROWS_PAD = (EROWS + 255) / 256 * 256, EROWS_LAT_PAD = (NB * CAP_LAT + 255) / 256 * 256;
constexpr int NCC = CTX / 64, NCL = SEQ / 64, NCH = NCC + NCL, NUNIT = NB * NH * 2 * NCH;
constexpr int WH = GROWS < 8 ? GROWS : 8;
constexpr float RMS_EPS = 1e-6f;
constexpr float LOG2E = 1.4426950408889634f;
static_assert(R_LAT % 256 == 0 && R_CTX % 256 == 0 && SEQ % 256 == 0 && CTX % 256 == 0, "row panels");
constexpr int KCH = SEQ / KSPLIT;
constexpr int HSEQ = SEQ / 2;
static_assert(KCH % 128 == 0 && KCH >= 256 && HSEQ % 256 == 0 && DEXP % 128 == 0 && DEXP >= 256, "gemm K");

constexpr size_t al256(size_t x) { return (x + 255) / 256 * 256; }
constexpr size_t WS_CTL = 0, CTL_BYTES = 1u << 20;
constexpr size_t WS_MODL = WS_CTL + CTL_BYTES;
constexpr size_t WS_MODC = WS_MODL + al256((size_t)DEPTH * NB * 6 * D * 4);
constexpr size_t WS_ROPE = WS_MODC + al256((size_t)DEPTH * 6 * D * 4);
constexpr size_t WS_DFTL = WS_ROPE + al256((size_t)SEQ * 32 * 4);
constexpr size_t WS_DFTC = WS_DFTL + al256((size_t)SEQ * 2 * SEQ * 2);
constexpr size_t WS_WIN = WS_DFTC + al256((size_t)CTX * 2 * SEQ * 2);
constexpr size_t WS_WOUT = WS_WIN + al256((size_t)DEPTH * NPROJ * D * 2);
constexpr size_t WS_WGU = WS_WOUT + al256((size_t)DEPTH * D * D * 2);
constexpr size_t WS_WD = WS_WGU + al256((size_t)DEPTH * NEXP * 2 * DEXP * D * 2);
constexpr size_t WS_MZT = WS_WD + al256((size_t)DEPTH * NEXP * D * DEXP * 2);
constexpr size_t WS_WFT = WS_MZT + al256((size_t)DEPTH * 512 * 256 * 2);
constexpr size_t WS_XRES = WS_WFT + al256((size_t)DEPTH * D * 256 * 2);
constexpr size_t WS_H = WS_XRES + al256((size_t)RT * D * 4);
constexpr size_t WS_PROJ = WS_H + al256((size_t)RT * D * 2);
constexpr size_t WS_AB = WS_PROJ + al256((size_t)RT * PLD * 2);
constexpr size_t WS_DNP = WS_AB + al256((size_t)RT * 16 * 4);
constexpr size_t WS_GB = WS_DNP + al256((size_t)RT * 768 * 2);
constexpr size_t WS_AN = WS_GB + al256((size_t)RT * 16 * 4);
constexpr size_t WS_QE = WS_AN + al256((size_t)NUNIT * 8192);
constexpr size_t WS_SN = WS_QE + al256((size_t)NUNIT * 8192);
constexpr size_t WS_BN = WS_SN + al256((size_t)NUNIT * 8192);
constexpr size_t WS_OI = WS_BN + al256((size_t)NUNIT * 16384);
constexpr size_t WS_ZTL = WS_OI + al256((size_t)NUNIT * 16384);
constexpr size_t WS_ZTC = WS_ZTL + al256((size_t)NB * 256 * 2 * SEQ * 2);
constexpr size_t WS_SLAB = WS_ZTC + al256((size_t)NB * 256 * 2 * SEQ * 2);
constexpr size_t WS_SLABC = WS_SLAB + al256((size_t)KSPLIT * R_LAT * 256 * 4);
constexpr size_t WS_MIX = WS_SLABC + al256((size_t)R_CTX * 256 * 4);
constexpr size_t WS_AFF = WS_MIX + al256((size_t)RT * D * 2);
constexpr size_t WS_RIDX = WS_AFF + al256((size_t)RT * NEXP * 4);
constexpr size_t WS_GATEV = WS_RIDX + al256((size_t)NEXP * EROWS_PAD * 4);
constexpr size_t WS_INV = WS_GATEV + al256((size_t)NEXP * EROWS_PAD * 4);
constexpr size_t WS_DMIX = WS_PROJ;
constexpr size_t WS_HID = WS_INV + al256((size_t)RT * NEXP * 4);
constexpr size_t WS_Y = WS_HID + al256((size_t)NEXP * EROWS_PAD * DEXP * 2);
constexpr size_t WS_END = WS_Y + al256((size_t)NEXP * EROWS_PAD * D * 2);
constexpr int CW_OUTC = 1024;
constexpr int CW_CHC = 2048;
constexpr int CW_BAR = 4096;

constexpr int LDS_WORK = 131072;
constexpr int LDS_MISC = LDS_WORK;
constexpr int LDS_BYTES = 147456;

typedef unsigned short bf16_t;
typedef short bf16x8 __attribute__((ext_vector_type(8)));
typedef short s16x4 __attribute__((ext_vector_type(4)));
typedef float f32x2 __attribute__((ext_vector_type(2)));
typedef float f32x4 __attribute__((ext_vector_type(4)));
typedef float f32x16 __attribute__((ext_vector_type(16)));
typedef unsigned u32x2 __attribute__((ext_vector_type(2)));
typedef unsigned u32x4 __attribute__((ext_vector_type(4)));
typedef int i32x4 __attribute__((ext_vector_type(4)));

DI float bf2f(bf16_t b) { return __builtin_bit_cast(float, ((unsigned)b) << 16); }
DI float bflo(unsigned w) { return __builtin_bit_cast(float, w << 16); }
DI float bfhi(unsigned w) { return __builtin_bit_cast(float, w & 0xffff0000u); }
#ifdef EMU
DI unsigned pk2(float lo, float hi) { return (unsigned)emu::f2bf(lo) | ((unsigned)emu::f2bf(hi) << 16); }
#else
typedef __bf16 bf16x2v __attribute__((ext_vector_type(2)));
DI unsigned pk2(float lo, float hi) { f32x2 v = {lo, hi}; return __builtin_bit_cast(unsigned, __builtin_convertvector(v, bf16x2v)); }
#endif
DI bf16_t f2bf(float f) { return (bf16_t)(pk2(f, 0.f) & 0xffffu); }
DI float siluf(float x) { return x * __builtin_amdgcn_rcpf(1.0f + __expf(-x)); }
DI float wave_sum(float v) {
#pragma unroll
    for (int o = 1; o < 64; o <<= 1) v += __shfl_xor(v, o);
    return v;
}
DI int crow(int reg, int hh) { return (reg & 3) + 8 * (reg >> 2) + 4 * hh; }
DI f32x16 zero16() { f32x16 z; for (int i = 0; i < 16; ++i) z[i] = 0.f; return z; }
DI bf16x8 pack8(const f32x16& x, int s) {
    u32x4 p; p.x = pk2(x[8 * s], x[8 * s + 1]); p.y = pk2(x[8 * s + 2], x[8 * s + 3]); p.z = pk2(x[8 * s + 4], x[8 * s + 5]); p.w = pk2(x[8 * s + 6], x[8 * s + 7]);
    return __builtin_bit_cast(bf16x8, p);
}
DI bf16x8 cat44(u32x2 lo, u32x2 hi) { u32x4 p; p.x = lo.x; p.y = lo.y; p.z = hi.x; p.w = hi.y; return __builtin_bit_cast(bf16x8, p); }
#define MFMA32(a, b, c) __builtin_amdgcn_mfma_f32_32x32x16_bf16((a), (b), (c), 0, 0, 0)
#define MFMA16(a, b, c) __builtin_amdgcn_mfma_f32_16x16x32_bf16((a), (b), (c), 0, 0, 0)

#define XB_TMO      128
#define XB_XCNT(j)  (256  + 64 * (j))
#define XB_XSUB(j)  (1280 + 64 * (j))
#define XB_XGEN(j)  (2304 + 64 * (j))
#define XB_TOP      3328
#define XB_TOPGEN   3392
#define XCD_BAR_WORDS 3456
#define XB_SPIN_CAP (1u << 18)
DI unsigned xb_ld(unsigned* p)              { return __hip_atomic_load(p, __ATOMIC_RELAXED, __HIP_MEMORY_SCOPE_AGENT); }
DI unsigned xb_add(unsigned* p, unsigned v) { return __hip_atomic_fetch_add(p, v, __ATOMIC_RELAXED, __HIP_MEMORY_SCOPE_AGENT); }
DI unsigned xb_xcc_id() { return (unsigned)__builtin_amdgcn_s_getreg((3 << 11) | 20) & 0xFu; }
#define XB_SPIN(cond, bar) do { unsigned _sp = 0; while (cond) { __builtin_amdgcn_s_sleep(1); \
    if ((++_sp & 255u) == 0u) { if (xb_ld(&(bar)[XB_TMO])) break; if (_sp > XB_SPIN_CAP) { atomicAdd(&(bar)[XB_TMO], 1u); break; } } } } while (0)
struct XcdBarrier { unsigned* bar; unsigned x; volatile LAS unsigned* st; };
DI XcdBarrier xcd_barrier_post(unsigned* bar, volatile LAS unsigned* st) {
    XcdBarrier b; b.bar = bar; b.x = (unsigned)__builtin_amdgcn_readfirstlane((int)xb_xcc_id()); b.st = st;
    if (threadIdx.x == 0) (void)xb_add(&bar[XB_XCNT(b.x)], 1u);
    return b;
}
DI void xcd_barrier_complete(unsigned* bar, unsigned x, unsigned& nloc, unsigned& nx) {
    const unsigned G = gridDim.x * gridDim.y * gridDim.z;
    unsigned sum, cnt, mine, sp = 0u;
    for (;;) {
        sum = 0u; cnt = 0u; mine = 0u;
#pragma unroll
        for (unsigned j = 0; j < 16; ++j) { const unsigned c = xb_ld(&bar[XB_XCNT(j)]); sum += c; cnt += (c > 0u) ? 1u : 0u; mine = (j == x) ? c : mine; }
        if (sum == G) break;
        __builtin_amdgcn_s_sleep(1);
        if ((++sp & 255u) == 0u) { if (xb_ld(&bar[XB_TMO])) break; if (sp > XB_SPIN_CAP) { atomicAdd(&bar[XB_TMO], 1u); break; } }
    }
    nloc = mine > 0u ? mine : 1u; nx = cnt > 0u ? cnt : 1u;
}
DI void xcd_barrier(const XcdBarrier& b) {
    WAIT_VM(0);
    __syncthreads();
    unsigned* bar = b.bar; unsigned bx = b.x; LAUNDER_S(bar); LAUNDER_S(bx);
    if (threadIdx.x == 0) {
        __builtin_amdgcn_s_waitcnt(0);
        unsigned nloc = b.st[0], nx = b.st[1];
        if (nloc == 0u) { xcd_barrier_complete(bar, bx, nloc, nx); b.st[0] = nloc; b.st[1] = nx; }
        const unsigned old = xb_add(&bar[XB_XSUB(bx)], 1u);
        const unsigned gen = old / nloc;
        if (old + 1u == (gen + 1u) * nloc) {
            __builtin_amdgcn_fence(__ATOMIC_RELEASE, "agent");
            WAIT_VM(0);
            const unsigned og = xb_add(&bar[XB_TOP], 1u);
            const unsigned tg = og / nx;
            if (og + 1u == (tg + 1u) * nx) xb_add(&bar[XB_TOPGEN], 1u);
            else XB_SPIN(xb_ld(&bar[XB_TOPGEN]) == tg, bar);
            __builtin_amdgcn_fence(__ATOMIC_ACQUIRE, "agent");
            xb_add(&bar[XB_XGEN(bx)], 1u);
            WAIT_VM(0);
        } else {
            XB_SPIN(xb_ld(&bar[XB_XGEN(bx)]) == gen, bar);
            __builtin_amdgcn_fence(__ATOMIC_ACQUIRE, "agent");
            WAIT_VM(0);
        }
    }
    __syncthreads();
}

#ifndef G8_SP2
#define G8_SP2 true
#endif
#ifndef G8_ALIGN_W
#define G8_ALIGN_W false
#endif
#ifndef G8_ALIGN_PROJ
#define G8_ALIGN_PROJ true
#endif
#ifndef G8_ALIGN_OUT
#define G8_ALIGN_OUT true
#endif
#ifndef G8_ALIGN_DFT
#define G8_ALIGN_DFT true
#endif
#ifndef G8_ALIGN_GU
#define G8_ALIGN_GU true
#endif
#ifndef G8_ALIGN_DOWN
#define G8_ALIGN_DOWN true
#endif
namespace g8 {
constexpr int BM = 256, BK = 64, HALF = 128, HTB = HALF * BK * 2, STAGE_BYTES = 8 * HTB;
DI int lds_byte(int r, int c) { const int st = (r >> 4) * 2 + (c >> 5), rr = r & 15, cc = c & 31, ob = rr * 64 + cc * 2; return st * 1024 + (ob ^ (((ob >> 9) & 1) << 5)); }
DI void stage_rc(int b, int& R, int& C) { const int st = b / 1024, sb = b % 1024, swz = sb ^ (((sb >> 9) & 1) << 5); R = (st >> 1) * 16 + swz / 64; C = (st & 1) * 32 + (swz % 64) / 2; }
DI int perm32(int rho) { const int n = rho >> 4, i = rho & 15; return 8 * (i >> 2) + 4 * n + (i & 3); }
struct Unit { const char* A; const char* B; const int* gidx; int pm, pn, aux, nt, half; };

template <class Epi, class Sched, bool GATHER>
DI void gemm_phase(LAS unsigned char* lds, const int lda, const int ldb, const Sched& S, const Epi& E) {
    int tid = threadIdx.x; LAUNDER_V(tid);
    const int wid = __builtin_amdgcn_readfirstlane(tid >> 6), lane = tid & 63, wr = wid >> 2, wc = wid & 3, fr = lane & 15, fq = lane >> 4;
    int Rr[2], Cc[2]; unsigned voffB[2];
#pragma unroll
    for (int i = 0; i < 2; ++i) { stage_rc(tid * 16 + i * 8192, Rr[i], Cc[i]); const int Rb = Epi::PERM ? ((Rr[i] & ~31) + perm32(Rr[i] & 31)) : Rr[i]; voffB[i] = (unsigned)(Rb * ldb + Cc[i]) * 2u; }
    const size_t kstep = (size_t)(BK * 2);
    const size_t hstepB = (size_t)HALF * ldb * 2;
    const unsigned ldsw = (unsigned)wid * 1024u;
    const int aoff = lds_byte(wr * 64 + fr, fq * 8), boff = lds_byte(wc * 32 + fr, fq * 8);
#define G8_SA(b, h) (((b) * 2 + (h)) * HTB)
#define G8_SB(b, h) ((4 + (b) * 2 + (h)) * HTB)
#define G8_STAGE(bufoff, gbase, v0, v1) do { \
        __builtin_amdgcn_global_load_lds((const unsigned*)((const char*)(gbase) + (v0)), (LAS unsigned*)(lds + (bufoff) + ldsw), 16, 0, 0); \
        __builtin_amdgcn_global_load_lds((const unsigned*)((const char*)(gbase) + (v1)), (LAS unsigned*)(lds + (bufoff) + ldsw + 8192), 16, 0, 0); } while (0)
#define G8_STAGE_B(bufoff, gbase) G8_STAGE(bufoff, gbase, voffB[0], voffB[1])
#define G8_LDA(dst, b, h) do { _Pragma("unroll") for (int m = 0; m < 4; ++m) _Pragma("unroll") for (int k = 0; k < 2; ++k) dst[m][k] = *(const LAS bf16x8*)(lds + G8_SA(b, h) + aoff + m * 2048 + k * 1024); } while (0)
#define G8_LDB(dst, b, h) do { _Pragma("unroll") for (int n = 0; n < 2; ++n) _Pragma("unroll") for (int k = 0; k < 2; ++k) dst[n][k] = *(const LAS bf16x8*)(lds + G8_SB(b, h) + boff + n * 2048 + k * 1024); } while (0)
#define G8_MMA(ai, bj, At, Bt) do { __builtin_amdgcn_s_setprio(1); _Pragma("unroll") for (int m = 0; m < 4; ++m) _Pragma("unroll") for (int n = 0; n < 2; ++n) _Pragma("unroll") for (int k = 0; k < 2; ++k) \
        acc[ai][bj][m][n] = MFMA16(Bt[n][k], At[m][k], acc[ai][bj][m][n]); __builtin_amdgcn_s_setprio(0); } while (0)
#define G8_BAR __builtin_amdgcn_s_barrier()
#define G8_SCHED __builtin_amdgcn_sched_barrier(0)
#define G8_VA(u, V) do { _Pragma("unroll") for (int h = 0; h < 2; ++h) _Pragma("unroll") for (int i = 0; i < 2; ++i) { \
        const int rr = GATHER ? (u).gidx[h * HALF + Rr[i]] : (h * HALF + Rr[i]); V[h][i] = (unsigned)(rr * lda + Cc[i]) * 2u; } } while (0)
    Unit cur, nxt; int ui = 0;
    if (!S.next(0, cur)) return;
    f32x4 acc[2][2][4][2];
#pragma unroll
    for (int a = 0; a < 2; ++a)
#pragma unroll
        for (int b = 0; b < 2; ++b)
#pragma unroll
            for (int m = 0; m < 4; ++m)
#pragma unroll
                for (int n = 0; n < 2; ++n) acc[a][b][m][n] = (f32x4){0.f, 0.f, 0.f, 0.f};
    bf16x8 At[4][2], B0[2][2], B1[2][2];
    unsigned vaC[2][2], vaN[2][2];
    G8_VA(cur, vaC);
    const char* cA = cur.A; const char* cB = cur.B;
    if constexpr (G8_SP2) {
        G8_STAGE_B(G8_SB(0, 0), cB); G8_STAGE_B(G8_SB(0, 1), cB + hstepB); G8_STAGE(G8_SA(0, 0), cA, vaC[0][0], vaC[0][1]); G8_STAGE(G8_SA(0, 1), cA, vaC[1][0], vaC[1][1]);
        if (wr == 1) G8_BAR;
        WAIT_VM(2); G8_BAR;
    } else {
        G8_STAGE_B(G8_SB(0, 0), cB); G8_STAGE(G8_SA(0, 0), cA, vaC[0][0], vaC[0][1]); G8_STAGE_B(G8_SB(0, 1), cB + hstepB); G8_STAGE(G8_SA(0, 1), cA, vaC[1][0], vaC[1][1]);
        if (wr == 1) G8_BAR;
        WAIT_VM(4); G8_BAR;
    }
    G8_STAGE_B(G8_SB(1, 0), cB + kstep); G8_STAGE(G8_SA(1, 0), cA + kstep, vaC[0][0], vaC[0][1]); G8_STAGE_B(G8_SB(1, 1), cB + hstepB + kstep);
    WAIT_VM(6); G8_BAR;
    for (;;) {
        const bool has_next = S.next(ui + 1, nxt);
        const int nt = cur.nt; const bool hf = cur.half != 0;
        const char* nA = has_next ? nxt.A : cA; const char* nB = has_next ? nxt.B : cB;
        if (GATHER) { if (has_next) { G8_VA(nxt, vaN); } else {
#pragma unroll
            for (int h = 0; h < 2; ++h)
#pragma unroll
                for (int i = 0; i < 2; ++i) vaN[h][i] = vaC[h][i]; } }
        for (int t = 0; t < nt; t += 2) {
            const bool last = (t == nt - 2);
            const char* a1 = cA + (size_t)(t + 1) * kstep;
            const char* a2 = last ? nA : cA + (size_t)(t + 2) * kstep; const char* b2 = last ? nB : cB + (size_t)(t + 2) * kstep;
            const char* a3 = a2 + kstep; const char* b3 = b2 + kstep;
            unsigned x00, x01, x10, x11;
            if (GATHER) { x00 = last ? vaN[0][0] : vaC[0][0]; x01 = last ? vaN[0][1] : vaC[0][1]; x10 = last ? vaN[1][0] : vaC[1][0]; x11 = last ? vaN[1][1] : vaC[1][1]; }
            else { x00 = vaC[0][0]; x01 = vaC[0][1]; x10 = vaC[1][0]; x11 = vaC[1][1]; }
            if constexpr (G8_SP2) {
            G8_LDB(B0, 0, 0); G8_LDB(B1, 0, 1); G8_SCHED; G8_LDA(At, 0, 0); G8_STAGE(G8_SA(1, 1), a1, vaC[1][0], vaC[1][1]);
            WAIT_VM(8); WAIT_LGKM(0); G8_BAR; G8_MMA(0, 0, At, B0); G8_MMA(0, 1, At, B1); G8_BAR; G8_SCHED;
            G8_LDA(At, 0, 1); G8_STAGE_B(G8_SB(0, 0), b2); G8_STAGE_B(G8_SB(0, 1), b2 + hstepB); G8_STAGE(G8_SA(0, 0), a2, x00, x01);
            WAIT_VM(8); WAIT_LGKM(0); G8_BAR; if (!hf) { G8_MMA(1, 0, At, B0); G8_MMA(1, 1, At, B1); } G8_BAR; G8_SCHED;
            G8_LDB(B0, 1, 0); G8_LDB(B1, 1, 1); G8_SCHED; G8_LDA(At, 1, 0); G8_STAGE(G8_SA(0, 1), a2, x10, x11);
            WAIT_VM(8); WAIT_LGKM(0); G8_BAR; G8_MMA(0, 0, At, B0); G8_MMA(0, 1, At, B1); G8_BAR; G8_SCHED;
            G8_LDA(At, 1, 1); G8_STAGE_B(G8_SB(1, 0), b3); G8_STAGE_B(G8_SB(1, 1), b3 + hstepB); G8_STAGE(G8_SA(1, 0), a3, x00, x01);
            WAIT_VM(8); WAIT_LGKM(0); G8_BAR; if (!hf) { G8_MMA(1, 0, At, B0); G8_MMA(1, 1, At, B1); } G8_BAR; G8_SCHED;
            } else {
            G8_LDB(B0, 0, 0); G8_SCHED; G8_LDA(At, 0, 0); G8_STAGE(G8_SA(1, 1), a1, vaC[1][0], vaC[1][1]);
            WAIT_LGKM(8); G8_BAR; WAIT_LGKM(0); G8_MMA(0, 0, At, B0); G8_BAR; G8_SCHED;
            G8_LDB(B1, 0, 1); G8_STAGE_B(G8_SB(0, 0), b2);
            G8_BAR; WAIT_LGKM(0); G8_MMA(0, 1, At, B1); G8_BAR;
            G8_LDA(At, 0, 1); G8_STAGE(G8_SA(0, 0), a2, x00, x01);
            G8_BAR; WAIT_LGKM(0); if (!hf) G8_MMA(1, 0, At, B0); G8_BAR; G8_SCHED;
            G8_STAGE_B(G8_SB(0, 1), b2 + hstepB);
            WAIT_VM(6); G8_BAR; if (!hf) G8_MMA(1, 1, At, B1); G8_BAR;
            G8_LDB(B0, 1, 0); G8_SCHED; G8_LDA(At, 1, 0); G8_STAGE(G8_SA(0, 1), a2, x10, x11);
            WAIT_LGKM(8); G8_BAR; WAIT_LGKM(0); G8_MMA(0, 0, At, B0); G8_BAR; G8_SCHED;
            G8_LDB(B1, 1, 1); G8_STAGE_B(G8_SB(1, 0), b3);
            G8_BAR; WAIT_LGKM(0); G8_MMA(0, 1, At, B1); G8_BAR;
            G8_LDA(At, 1, 1); G8_STAGE(G8_SA(1, 0), a3, x00, x01);
            G8_BAR; WAIT_LGKM(0); if (!hf) G8_MMA(1, 0, At, B0); G8_BAR; G8_SCHED;
            G8_STAGE_B(G8_SB(1, 1), b3 + hstepB);
            WAIT_VM(6); G8_BAR; if (!hf) G8_MMA(1, 1, At, B1); G8_BAR;
            }
        }
        if constexpr (Epi::ALIGN) { if (wr == 0) G8_BAR; }
        E(acc, cur, wr, wc, fr, fq);
        if (!has_next) break;
#pragma unroll
        for (int a = 0; a < 2; ++a)
#pragma unroll
            for (int b = 0; b < 2; ++b)
#pragma unroll
                for (int m = 0; m < 4; ++m)
#pragma unroll
                    for (int n = 0; n < 2; ++n) acc[a][b][m][n] = (f32x4){0.f, 0.f, 0.f, 0.f};
        cur = nxt; cA = nA; cB = nB; ++ui;
        if (GATHER) {
#pragma unroll
            for (int h = 0; h < 2; ++h)
#pragma unroll
                for (int i = 0; i < 2; ++i) vaC[h][i] = vaN[h][i]; }
        if constexpr (Epi::ALIGN) { if (wr == 1) G8_BAR; }
    }
    WAIT_VM(0);
    if constexpr (!Epi::ALIGN) { if (wr == 0) G8_BAR; }
    G8_BAR;
#undef G8_SA
#undef G8_SB
#undef G8_STAGE
#undef G8_STAGE_B
#undef G8_LDA
#undef G8_LDB
#undef G8_MMA
#undef G8_BAR
#undef G8_SCHED
#undef G8_VA
}
}

struct Params { const float* in[23]; float* out; unsigned char* ws; };
enum { I_X = 0, I_C, I_CTX, I_CCTX, I_WMOD, I_BMOD, I_N1G, I_WIN, I_RPB, I_CONVW, I_ALOG, I_DTB, I_DNG, I_DFLAM, I_DFG, I_FTW, I_WOUT, I_N2G, I_WR, I_WG, I_WU, I_WDN, I_FNG };
struct Frame { LAS unsigned char* lds; int tid, lane, wave, G, bid, gw, ngw; };
template <class T> DI T* wsp(const Params& P, size_t off) { return (T*)(P.ws + off); }
DI Frame relaunder(const Frame& F0) { Frame F = F0; LAUNDER_V(F.tid); F.lane = F.tid & 63; F.wave = __builtin_amdgcn_readfirstlane(F.tid >> 6); LAUNDER_S(F.bid); F.gw = F.wave * F.G + F.bid; return F; }
DI float cospi_(float x) { return cosf(3.14159265358979323846f * x); }
DI float sinpi_(float x) { return sinf(3.14159265358979323846f * x); }

struct TItem { const float* src; bf16_t* dst; int ldw, ldt; };
DI TItem p0_decode(const Params& P, int it) {
    constexpr int I_WINc = 10 * 16 * 8, I_ABc = 16, I_WOUTc = 16 * 32, I_Gc = NEXP * 16 * (DEXP / 32), I_Dc = NEXP * (DEXP / 64) * 32;
    constexpr int I_LAYER = I_WINc + I_ABc + I_WOUTc + 2 * I_Gc + I_Dc;
    bf16_t* WinT = wsp<bf16_t>(P, WS_WIN); bf16_t* WoutT = wsp<bf16_t>(P, WS_WOUT); bf16_t* WguT = wsp<bf16_t>(P, WS_WGU); bf16_t* WdT = wsp<bf16_t>(P, WS_WD);
    const int l = it / I_LAYER; int r = it % I_LAYER; TItem t;
    const float* w_in = P.in[I_WIN] + (size_t)l * D * IN_W;
    if (r < I_WINc) { const int g = r / 128, rr = r % 128, kb = ((rr >> 2) / 8) * 4 + (rr & 3), nb = (rr >> 2) % 8; const int so = 256 * g + (g >= 6 ? 16 : 0);
        t.src = w_in + so + nb * 32 + (size_t)64 * kb * IN_W; t.ldw = IN_W; t.dst = WinT + ((size_t)l * NPROJ + g * 256 + nb * 32) * D + 64 * kb; t.ldt = D; return t; }
    r -= I_WINc;
    if (r < I_ABc) { t.src = w_in + 1536 + (size_t)64 * r * IN_W; t.ldw = IN_W; t.dst = WinT + ((size_t)l * NPROJ + 12 * 256) * D + 64 * r; t.ldt = D; return t; }
    r -= I_ABc;
    if (r < I_WOUTc) { const int kb = ((r >> 2) / 32) * 4 + (r & 3), nb = (r >> 2) % 32; t.src = P.in[I_WOUT] + (size_t)l * D * D + nb * 32 + (size_t)64 * kb * D; t.ldw = D; t.dst = WoutT + ((size_t)l * D + nb * 32) * D + 64 * kb; t.ldt = D; return t; }
    r -= I_WOUTc;
    if (r < 2 * I_Gc) { const int up = r >= I_Gc; if (up) r -= I_Gc; const int e = r / (16 * (DEXP / 32)), rr = r % (16 * (DEXP / 32)), kb = ((rr >> 2) / (DEXP / 32)) * 4 + (rr & 3), nb = (rr >> 2) % (DEXP / 32), f0 = 32 * nb;
        t.src = P.in[up ? I_WU : I_WG] + ((size_t)l * NEXP + e) * D * DEXP + f0 + (size_t)64 * kb * DEXP; t.ldw = DEXP;
        t.dst = WguT + (((size_t)l * NEXP + e) * 2 * DEXP + (f0 / 128) * 256 + up * 128 + (f0 % 128)) * D + 64 * kb; t.ldt = D; return t; }
    r -= 2 * I_Gc;
    { const int e = r / ((DEXP / 64) * 32), rr = r % ((DEXP / 64) * 32), kb = ((rr >> 2) / 32) * 4 + (rr & 3), nb = (rr >> 2) % 32;
        t.src = P.in[I_WDN] + ((size_t)l * NEXP + e) * DEXP * D + nb * 32 + (size_t)64 * kb * D; t.ldw = D; t.dst = WdT + (((size_t)l * NEXP + e) * D + nb * 32) * DEXP + 64 * kb; t.ldt = DEXP; }
    return t;
}
DI void p0_weights(const Frame& F0, const Params& P) {
    const Frame F = relaunder(F0);
    LAS float* scr = (LAS float*)(F.lds + F.wave * 8448);
    constexpr int I_LAYER = 10 * 16 * 8 + 16 + 16 * 32 + 2 * NEXP * 16 * (DEXP / 32) + NEXP * (DEXP / 64) * 32, NIT = DEPTH * I_LAYER;
    const int lane = F.lane, lr = lane >> 3, lc = lane & 7;
    f32x4 va[8], vb[8];
#define P0_LOAD(dst_, it_) do { const int itc_ = (it_) < NIT ? (it_) : F.gw; const TItem tl_ = p0_decode(P, itc_); _Pragma("unroll") for (int i = 0; i < 8; ++i) dst_[i] = *(const f32x4*)(tl_.src + (size_t)(8 * i + lr) * tl_.ldw + 4 * lc); } while (0)
#define P0_ITEM(src_, it_, nx_) do { const TItem t_ = p0_decode(P, (it_)); \
        _Pragma("unroll") for (int i = 0; i < 8; ++i) { LAS float* s = scr + (8 * i + lr) * 33 + 4 * lc; s[0] = src_[i].x; s[1] = src_[i].y; s[2] = src_[i].z; s[3] = src_[i].w; } \
        P0_LOAD(src_, (nx_)); \
        WAIT_LGKM(0); CFENCE(); \
        _Pragma("unroll") for (int j = 0; j < 4; ++j) { const int n = lr + 8 * j; const LAS float* s = scr + (8 * lc) * 33 + n; \
            u32x4 o; o.x = pk2(s[0 * 33], s[1 * 33]); o.y = pk2(s[2 * 33], s[3 * 33]); o.z = pk2(s[4 * 33], s[5 * 33]); o.w = pk2(s[6 * 33], s[7 * 33]); \
            *(u32x4*)(t_.dst + (size_t)n * t_.ldt + 8 * lc) = o; } \
        WAIT_LGKM(0); CFENCE(); } while (0)
#define P0_SEQ(j_) ((F.gw + ((j_) >> 2) * F.ngw) * 4 + ((j_) & 3))
    if (P0_SEQ(0) < NIT) { P0_LOAD(va, P0_SEQ(0)); P0_LOAD(vb, P0_SEQ(1)); }
    for (int j = 0; P0_SEQ(j) < NIT; j += 2) {
        P0_ITEM(va, P0_SEQ(j), P0_SEQ(j + 2));
        if (P0_SEQ(j + 1) < NIT) P0_ITEM(vb, P0_SEQ(j + 1), P0_SEQ(j + 3));
    }
#undef P0_SEQ
#undef P0_LOAD
#undef P0_ITEM
}
DI void p0_mod(const Frame& F0, const Params& P) {
    const Frame F = relaunder(F0);
    LAS float* sv = (LAS float*)F.lds;
    LAS f32x2* red = (LAS f32x2*)(sv + (NB + 1) * D);
    float* modL = wsp<float>(P, WS_MODL); float* modC = wsp<float>(P, WS_MODC);
    for (int i = F.tid; i < (NB + 1) * D; i += 512) { const int s = i / D, k = i % D; sv[i] = siluf(s < NB ? P.in[I_C][s * D + k] : P.in[I_CCTX][k]); }
    __syncthreads();
    for (int it = F.bid; it < DEPTH * 48; it += F.G) {
        const int l = it / 48, n = (it % 48) * 128 + 2 * F.lane;
        const float* wm = P.in[I_WMOD] + (size_t)l * D * 6 * D + n;
        f32x2 acc[NB + 1];
#pragma unroll
        for (int s = 0; s <= NB; ++s) acc[s] = (f32x2){0.f, 0.f};
        for (int k0 = F.wave * 128; k0 < F.wave * 128 + 128; k0 += 16) { f32x2 w[16];
#pragma unroll
            for (int i = 0; i < 16; ++i) w[i] = *(const f32x2*)(wm + (size_t)(k0 + i) * 6 * D);
#pragma unroll
            for (int i = 0; i < 16; ++i)
#pragma unroll
                for (int s = 0; s <= NB; ++s) acc[s] += w[i] * sv[s * D + k0 + i]; }
#pragma unroll
        for (int s = 0; s <= NB; ++s) red[(F.wave * (NB + 1) + s) * 64 + F.lane] = acc[s];
        __syncthreads();
        if (F.tid < (NB + 1) * 64) { const int s = F.tid / 64, ln = F.tid % 64; f32x2 v = {0.f, 0.f};
            for (int w = 0; w < 8; ++w) v += red[(w * (NB + 1) + s) * 64 + ln];
            const int nn = (it % 48) * 128 + 2 * ln; v += *(const f32x2*)(P.in[I_BMOD] + (size_t)l * 6 * D + nn);
            *(f32x2*)((s < NB ? modL + ((size_t)l * NB + s) * 6 * D : modC + (size_t)l * 6 * D) + nn) = v; }
        __syncthreads();
    }
}
DI void p0_misc(const Frame& F0, const Params& P) {
    const Frame F = relaunder(F0);
    const size_t gt = (size_t)F.bid * 512 + F.tid, ngt = (size_t)F.G * 512;
    { float* rope = wsp<float>(P, WS_ROPE);
      for (size_t i = gt; i < (size_t)SEQ * 16; i += ngt) { const int t = (int)(i / 16), p = (int)(i % 16); const float pos = (p < 8) ? (float)(t / GRIDW) : (float)(t % GRIDW);
          const float inv = exp2f(-(float)(p & 7) * (13.287712379549449f / 8.0f));     const float ang = pos * inv; rope[2 * i] = cosf(ang); rope[2 * i + 1] = sinf(ang); } }
    { LAS float* ct = (LAS float*)F.lds;
      for (int m = F.tid; m < SEQ; m += 512) ct[m] = cospi_(2.0f * (float)m / (float)SEQ);
      __syncthreads();
      bf16_t* dl = wsp<bf16_t>(P, WS_DFTL); const float sc = 1.0f / sqrtf((float)SEQ);
      for (size_t i = gt; i < (size_t)(HSEQ + 1) * SEQ / 2; i += ngt) { const int k = (int)(i / (SEQ / 2)), t = 2 * (int)(i % (SEQ / 2));     const int m0 = (int)(((long long)k * t) % SEQ), m1 = (m0 + k) % SEQ;
          *(unsigned*)(dl + (size_t)k * 2 * SEQ + t) = pk2(ct[m0] * sc, ct[m1] * sc);
          *(unsigned*)(dl + (size_t)k * 2 * SEQ + SEQ + t) = pk2(ct[(m0 + 3 * SEQ / 4) % SEQ] * sc, ct[(m1 + 3 * SEQ / 4) % SEQ] * sc); }
      bf16_t* dc = wsp<bf16_t>(P, WS_DFTC); const float scc = 1.0f / sqrtf((float)CTX); constexpr int STEP = SEQ / CTX;
      for (size_t i = gt; i < (size_t)CTX * 2 * CTX; i += ngt) { const int k = (int)(i / (2 * CTX)), c = (int)(i % (2 * CTX)), t = c % CTX; const int m = ((k * t) % CTX) * STEP;
          dc[(size_t)k * 2 * SEQ + c] = f2bf((c < CTX ? ct[m] : ct[(m + 3 * SEQ / 4) % SEQ]) * scc); }
      __syncthreads(); }
    { bf16_t* mz = wsp<bf16_t>(P, WS_MZT);
      for (size_t i = gt; i < (size_t)DEPTH * 512 * 256; i += ngt) { const int l = (int)(i / (512 * 256)), np = (int)((i / 256) % 512), c = (int)(i % 256); const int n = np & 255, g0 = c & ~63;
          const float* fw = P.in[I_FTW] + (size_t)l * 256 * 256; float a = 0.f;
          for (int j = 0; j < 64; ++j) { const int m = ((c & 63) * j) & 63; const float x = 2.0f * (float)m / 64.0f; const float tr = (np < 256) ? cospi_(x) : -sinpi_(x); a += tr * fw[(size_t)(g0 + j) * 256 + n]; }
          mz[i] = f2bf(a * 0.125f); }
      bf16_t* wf = wsp<bf16_t>(P, WS_WFT);
      for (size_t i = gt; i < (size_t)DEPTH * D * 256; i += ngt) { const int l = (int)(i / (D * 256)), k = (int)((i / 256) % D), c = (int)(i % 256); wf[i] = f2bf(P.in[I_WIN][((size_t)l * D + k) * IN_W + 2576 + c]); } }
    { int* ridx = wsp<int>(P, WS_RIDX); for (size_t i = gt; i < (size_t)NEXP * EROWS_PAD; i += ngt) ridx[i] = 0; }
}

DI void phase_norm1(const Frame& F0, const Params& P, const int l) {
    const Frame F = relaunder(F0);
    float* xres = wsp<float>(P, WS_XRES); bf16_t* hb = wsp<bf16_t>(P, WS_H);
    const int* inv = wsp<int>(P, WS_INV); const bf16_t* yb = wsp<bf16_t>(P, WS_Y);
    const float* modL = wsp<float>(P, WS_MODL); const float* modC = wsp<float>(P, WS_MODC);
    const bool fin = (l == DEPTH);
    const int nrows = fin ? R_LAT : RT;
    if (F.gw >= nrows) return;
    constexpr int NSL = 4;
#define N1_XSRC(r_) ((l <= 1) ? (const f32x4*)((r_) < R_LAT ? P.in[I_X] + (size_t)(r_) * D : P.in[I_CTX] + (size_t)((r_) - R_LAT) * D) + F.lane : (const f32x4*)(xres + (size_t)(r_) * D) + F.lane)
#define N1_LDINV(r_) do { const i32x4* ip_ = (const i32x4*)(inv + (size_t)(r_) * NEXP); _Pragma("unroll") for (int q_ = 0; q_ < NEXP / 4; ++q_) ivv[q_] = ip_[q_]; } while (0)
#define N1_ISSUE(r_) do { \
        _Pragma("unroll") for (int k_ = 0; k_ < NSL; ++k_) sl[k_] = -1; \
        if (l > 0) { int cnt_ = 0; \
            _Pragma("unroll") for (int e_ = 0; e_ < NEXP; ++e_) { const int ix_ = __builtin_amdgcn_readfirstlane(ivv[e_ >> 2][e_ & 3]); \
                if (ix_ >= 0) { _Pragma("unroll") for (int k_ = 0; k_ < NSL; ++k_) sl[k_] = (cnt_ == k_) ? ix_ : sl[k_]; ++cnt_; } } \
            nsel = cnt_; } \
        { const f32x4* xs_ = N1_XSRC(r_); _Pragma("unroll") for (int j_ = 0; j_ < 4; ++j_) xn[j_] = xs_[64 * j_]; } \
        if (l > 0) { const u32x2* dm_ = (const u32x2*)(dmix + (size_t)(r_) * D) + F.lane; _Pragma("unroll") for (int j_ = 0; j_ < 4; ++j_) dn[j_] = dm_[64 * j_]; } \
        if (l > 0) { _Pragma("unroll") for (int k_ = 0; k_ < NSL; ++k_) { const u32x2* yr_ = (const u32x2*)(yb + (size_t)(sl[k_] < 0 ? 0 : sl[k_]) * D) + F.lane; \
            _Pragma("unroll") for (int j_ = 0; j_ < 4; ++j_) yn[k_][j_] = yr_[64 * j_]; } } } while (0)
    const bf16_t* dmix = wsp<bf16_t>(P, WS_DMIX);
    i32x4 ivv[NEXP / 4]; int sl[NSL], nsel = 0; f32x4 xn[4]; u32x2 yn[NSL][4]; u32x2 dn[4];
    int row = F.gw;
    if (l > 0) N1_LDINV(row);
    N1_ISSUE(row);
    { const int r1 = row + F.ngw < nrows ? row + F.ngw : row; if (l > 0) N1_LDINV(r1); }
    for (; row < nrows; row += F.ngw) {
        const bool lat = row < R_LAT; const int b = lat ? row / SEQ : 0;
        f32x4* xr = (f32x4*)(xres + (size_t)row * D) + F.lane;
        f32x4 v[4]; u32x2 y[NSL][4]; int sc[NSL]; const int nc = nsel;
#pragma unroll
        for (int j = 0; j < 4; ++j) { v[j] = xn[j]; if (l > 0) { const u32x2 w = dn[j]; v[j] += (f32x4){bflo(w.x), bfhi(w.x), bflo(w.y), bfhi(w.y)}; } }
#pragma unroll
        for (int k = 0; k < NSL; ++k) { sc[k] = sl[k];
#pragma unroll
            for (int j = 0; j < 4; ++j) y[k][j] = yn[k][j]; }
        { const int r1 = row + F.ngw < nrows ? row + F.ngw : row, r2 = r1 + F.ngw < nrows ? r1 + F.ngw : r1;
          N1_ISSUE(r1);
          if (l > 0) N1_LDINV(r2); }
        if (l > 0) {
            const float* mp = (lat ? modL + ((size_t)(l - 1) * NB + b) * 6 * D : modC + (size_t)(l - 1) * 6 * D) + 5 * D;
            f32x4 s[4];
#pragma unroll
            for (int j = 0; j < 4; ++j) s[j] = (f32x4){0.f, 0.f, 0.f, 0.f};
#pragma unroll
            for (int k = 0; k < NSL; ++k) if (sc[k] >= 0) {
#pragma unroll
                for (int j = 0; j < 4; ++j) { const u32x2 w = y[k][j]; s[j] += (f32x4){bflo(w.x), bfhi(w.x), bflo(w.y), bfhi(w.y)}; } }
            if (nc > NSL) { int seen = 0;
                for (int e = 0; e < NEXP; ++e) { const int ix = __builtin_amdgcn_readfirstlane(inv[(size_t)row * NEXP + e]);
                    if (ix >= 0) { if (seen >= NSL) { const u32x2* yr = (const u32x2*)(yb + (size_t)ix * D) + F.lane;
#pragma unroll
                            for (int j = 0; j < 4; ++j) { const u32x2 w = yr[64 * j]; s[j] += (f32x4){bflo(w.x), bfhi(w.x), bflo(w.y), bfhi(w.y)}; } }
                        ++seen; } } }
#pragma unroll
            for (int j = 0; j < 4; ++j) { const f32x4 g = *((const f32x4*)mp + F.lane + 64 * j); v[j] += g * s[j]; xr[64 * j] = v[j]; }
        }
        float ss = 0.f;
#pragma unroll
        for (int j = 0; j < 4; ++j) ss += (v[j].x * v[j].x + v[j].y * v[j].y) + (v[j].z * v[j].z + v[j].w * v[j].w);
        const float rstd = 1.0f / sqrtf(wave_sum(ss) * (1.0f / D) + RMS_EPS);
        if (fin) {
            const f32x4* g = (const f32x4*)P.in[I_FNG] + F.lane; f32x4* o = (f32x4*)(P.out + (size_t)row * D) + F.lane;
#pragma unroll
            for (int j = 0; j < 4; ++j) o[64 * j] = v[j] * rstd * g[64 * j];
        } else {
            const f32x4* g = (const f32x4*)(P.in[I_N1G] + (size_t)l * D) + F.lane;
            const float* mp = lat ? modL + ((size_t)l * NB + b) * 6 * D : modC + (size_t)l * 6 * D;
            u32x2* ho = (u32x2*)(hb + (size_t)row * D) + F.lane;
#pragma unroll
            for (int j = 0; j < 4; ++j) { const f32x4 sh = *((const f32x4*)mp + F.lane + 64 * j), scl = *((const f32x4*)(mp + D) + F.lane + 64 * j);
                const f32x4 hv = v[j] * rstd * g[64 * j] * (scl + 1.0f) + sh; u32x2 w; w.x = pk2(hv.x, hv.y); w.y = pk2(hv.z, hv.w); ho[64 * j] = w; }
        }
    }
#undef N1_XSRC
#undef N1_LDINV
#undef N1_ISSUE
}
constexpr int lg2c(int x) { return x <= 1 ? 0 : 1 + lg2c(x / 2); }
template <int N> struct RouterRed {
    template <int OFF> static DI float run(float (&v)[N], int lane) {
        float w[N / 2];
        const bool up = (lane & OFF) != 0;
#pragma unroll
        for (int i = 0; i < N / 2; ++i) { const float send = up ? v[i] : v[i + N / 2], keep = up ? v[i + N / 2] : v[i]; w[i] = keep + __shfl_xor(send, OFF); }
        return RouterRed<N / 2>::template run<OFF / 2>(w, lane);
    }
};
template <> struct RouterRed<1> { template <int OFF> static DI float run(float (&v)[1], int) { float x = v[0];
#pragma unroll
        for (int o = OFF; o >= 1; o >>= 1) x += __shfl_xor(x, o);
        return x; } };
DI void phase_norm2(const Frame& F0, const Params& P, const int l, const int nbc, unsigned* cnt) {
    const Frame F = relaunder(F0);
    const float* xres = wsp<float>(P, WS_XRES); bf16_t* hb = wsp<bf16_t>(P, WS_H); float* aff = wsp<float>(P, WS_AFF);
    const float* modL = wsp<float>(P, WS_MODL); const float* modC = wsp<float>(P, WS_MODC);
    const float* wr = P.in[I_WR] + (size_t)l * D * NEXP;
    constexpr int EC = NEXP / 4, LGE = lg2c(NEXP);
    LAS f32x4* wl = (LAS f32x4*)F.lds;
    for (int i = F.tid; i < 16 * EC * 64; i += 512) { const int ln = i & 63, c = (i >> 6) % EC, jq = (i >> 6) / EC, col = 4 * ln + 256 * (jq >> 2) + (jq & 3);
        wl[i] = *(const f32x4*)(wr + (size_t)col * NEXP + 4 * c); }
    __syncthreads();
    const int lane = F.lane;
    int elane = 0;
#pragma unroll
    for (int s = 0; s < LGE; ++s) elane |= ((lane >> (5 - s)) & 1) << (LGE - 1 - s);
    const int nrows = (l < DEPTH - 1) ? RT : R_LAT;
    const bf16_t* dmix = wsp<bf16_t>(P, WS_DMIX);
#define N2_XSRC(r_) ((l == 0) ? (const f32x4*)((r_) < R_LAT ? P.in[I_X] + (size_t)(r_) * D : P.in[I_CTX] + (size_t)((r_) - R_LAT) * D) + lane : (const f32x4*)(xres + (size_t)(r_) * D) + lane)
    f32x4 vn[4]; u32x2 dn[4];
    for (int seg = 0; seg < 2; ++seg) {
    int row, rend, rstep;
    if (seg == 0) { if (nbc == 0) { row = F.gw; rend = nrows; rstep = F.ngw; } else { row = F.bid >= nbc ? F.wave * (F.G - nbc) + (F.bid - nbc) : R_LAT; rend = R_LAT; rstep = (F.G - nbc) * 8; } }
    else { if (nbc == 0) break;
        { unsigned sp = 0u; while (xb_ld(cnt) < (unsigned)nbc) { __builtin_amdgcn_s_sleep(2); if (++sp > (1u << 22)) break; } }
        __builtin_amdgcn_fence(__ATOMIC_ACQUIRE, "agent");
        row = R_LAT + F.gw; rend = RT; rstep = F.ngw; }
    { const int r0 = row < rend ? row : 0; const f32x4* xr = N2_XSRC(r0); const u32x2* dm = (const u32x2*)(dmix + (size_t)r0 * D) + lane;
#pragma unroll
      for (int j = 0; j < 4; ++j) { vn[j] = xr[64 * j]; dn[j] = dm[64 * j]; } }
    for (; row < rend; row += rstep) {
        const bool lat = row < R_LAT; const int b = lat ? row / SEQ : 0;
        const LAS f32x4* wlr = wl; LAUNDER_V(wlr);
        f32x4 v[4]; float ss = 0.f;
#pragma unroll
        for (int j = 0; j < 4; ++j) { const u32x2 w = dn[j]; v[j] = vn[j] + (f32x4){bflo(w.x), bfhi(w.x), bflo(w.y), bfhi(w.y)}; ss += (v[j].x * v[j].x + v[j].y * v[j].y) + (v[j].z * v[j].z + v[j].w * v[j].w); }
        { const int rn = row + rstep < rend ? row + rstep : row; const f32x4* xr = N2_XSRC(rn); const u32x2* dm = (const u32x2*)(dmix + (size_t)rn * D) + lane;
#pragma unroll
          for (int j = 0; j < 4; ++j) { vn[j] = xr[64 * j]; dn[j] = dm[64 * j]; } }
        const float rstd = 1.0f / sqrtf(wave_sum(ss) * (1.0f / D) + RMS_EPS);
        const f32x4* g = (const f32x4*)(P.in[I_N2G] + (size_t)l * D) + lane;
        const float* mp = lat ? modL + ((size_t)l * NB + b) * 6 * D : modC + (size_t)l * 6 * D;
        u32x2* ho = (u32x2*)(hb + (size_t)row * D) + lane;
        float lg[NEXP];
#pragma unroll
        for (int e = 0; e < NEXP; ++e) lg[e] = 0.f;
#pragma unroll
        for (int j = 0; j < 4; ++j) { const f32x4 sh = *((const f32x4*)(mp + 3 * D) + lane + 64 * j), scl = *((const f32x4*)(mp + 4 * D) + lane + 64 * j);
            const f32x4 hv = v[j] * rstd * g[64 * j] * (scl + 1.0f) + sh; u32x2 w; w.x = pk2(hv.x, hv.y); w.y = pk2(hv.z, hv.w); ho[64 * j] = w;
#pragma unroll
            for (int q = 0; q < 4; ++q)
#pragma unroll
                for (int c = 0; c < EC; ++c) { const f32x4 wv = wlr[((j * 4 + q) * EC + c) * 64 + lane]; lg[4 * c] += hv[q] * wv.x; lg[4 * c + 1] += hv[q] * wv.y; lg[4 * c + 2] += hv[q] * wv.z; lg[4 * c + 3] += hv[q] * wv.w; } }
        const float logit = RouterRed<NEXP>::template run<32>(lg, lane);
        float mx = logit;
#pragma unroll
        for (int s = 0; s < LGE; ++s) mx = fmaxf(mx, __shfl_xor(mx, 32 >> s));
        const float ex = __expf(logit - mx); float sum = ex;
#pragma unroll
        for (int s = 0; s < LGE; ++s) sum += __shfl_xor(sum, 32 >> s);
        if ((lane & ((64 >> LGE) - 1)) == 0) aff[(size_t)row * NEXP + elane] = ex / sum;
    }
    }
    __syncthreads();
}

DI int xcd_remap(int L, int total) { const int q = total / 8, r = total % 8, x = L % 8, off = L / 8; return (x < r ? x * (q + 1) : r * (q + 1) + (x - r) * q) + off; }
DI void decode2d(int L, int nM, int nN, int& pm, int& pn) { const int nig = 8 * nN, gid = L / nig, fm = gid * 8, gsz = (nM - fm) < 8 ? (nM - fm) : 8; pm = fm + (L % nig) % gsz; pn = (L % nig) / gsz; }

struct SchedW {
    int G, c; const char* mz; const char* wf;
    DI bool next(int i, g8::Unit& u) const { const int L = i * G + c; if (L >= DEPTH * 8) return false; const int l = L / 8, pm = (L % 8) / 4, pn = L % 4;
        u.A = mz + ((size_t)l * 512 + pm * 256) * 256 * 2; u.B = wf + ((size_t)l * D + pn * 256) * 256 * 2; u.gidx = nullptr; u.pm = pm; u.pn = pn; u.aux = l; u.nt = 4; u.half = 0; return true; }
};
struct EpiW { static constexpr bool ALIGN = G8_ALIGN_W; static constexpr bool PERM = true; bf16_t* WinT;
    DI void operator()(const f32x4 (&acc)[2][2][4][2], const g8::Unit& u, int wr, int wc, int fr, int fq) const {
#pragma unroll
        for (int ai = 0; ai < 2; ++ai)
#pragma unroll
            for (int m = 0; m < 4; ++m) { const int r = u.pm * 256 + ai * 128 + wr * 64 + m * 16 + fr; bf16_t* rowp = WinT + ((size_t)u.aux * NPROJ + 2560 + r) * D + u.pn * 256 + wc * 32 + 8 * fq;
#pragma unroll
                for (int bj = 0; bj < 2; ++bj) { const f32x4 v0 = acc[ai][bj][m][0], v1 = acc[ai][bj][m][1]; u32x4 w; w.x = pk2(v0.x, v0.y); w.y = pk2(v0.z, v0.w); w.z = pk2(v1.x, v1.y); w.w = pk2(v1.z, v1.w); *(u32x4*)(rowp + bj * 128) = w; } }
    }
};
struct SchedProj {
    int G, c, last; const char* A; const char* B;
    DI bool next(int i, g8::Unit& u) const {
        constexpr int nLat = R_LAT / 256, nCtx = R_CTX / 256;
        const int ntc = last ? 8 : NTILE, total = nLat * NTILE + nCtx * ntc;
        int L = i * G + c; if (L >= total) return false; L = xcd_remap(L, total);
        int pm, pn;
        if (L < nLat * NTILE) decode2d(L, nLat, NTILE, pm, pn);
        else { L -= nLat * NTILE; pm = nLat + L / ntc; pn = L % ntc; if (last) { const int k = pn; pn = (k < 5) ? k + 1 : (k == 5 ? 8 : (k == 6 ? 9 : 12)); } }
        u.A = A + (size_t)pm * 256 * D * 2; u.B = B + (size_t)pn * 256 * D * 2; u.gidx = nullptr; u.pm = pm; u.pn = pn; u.aux = 0; u.nt = D / 64; u.half = 0; return true; }
};
struct EpiProj { static constexpr bool ALIGN = G8_ALIGN_PROJ; static constexpr bool PERM = true; bf16_t* proj; float* ab; bf16_t* ztl; bf16_t* ztc; const float* rope;
    DI void operator()(const f32x4 (&acc)[2][2][4][2], const g8::Unit& u, int wr, int wc, int fr, int fq) const {
        const int pn = u.pn; const bool lat = u.pm * 256 < R_LAT;
#pragma unroll
        for (int ai = 0; ai < 2; ++ai)
#pragma unroll
            for (int m = 0; m < 4; ++m) {
                const int row = u.pm * 256 + ai * 128 + wr * 64 + m * 16 + fr;
                int b, t; if (lat) { b = row / SEQ; t = row % SEQ; } else { const int rr = row - R_LAT; b = rr / CTX; t = rr % CTX; }
#pragma unroll
                for (int bj = 0; bj < 2; ++bj) {
                    const int c8 = 128 * bj + 32 * wc + 8 * fq; f32x4 v0 = acc[ai][bj][m][0], v1 = acc[ai][bj][m][1];
                    if (pn == 0) { v0 = v0 * (0.125f * LOG2E); v1 = v1 * (0.125f * LOG2E); }
                    if (pn == 7) { v0 = v0 * (0.17677669529663687f * LOG2E); v1 = v1 * (0.17677669529663687f * LOG2E); }
                    if (pn < 10) {
                        if ((pn == 7 || pn == 8) && lat) { const f32x4* cs = (const f32x4*)(rope + ((size_t)t * 16 + 4 * fq) * 2); const f32x4 c0 = cs[0], c1 = cs[1];
                            v0 = (f32x4){v0.x * c0.x - v0.y * c0.y, v0.x * c0.y + v0.y * c0.x, v0.z * c0.z - v0.w * c0.w, v0.z * c0.w + v0.w * c0.z};
                            v1 = (f32x4){v1.x * c1.x - v1.y * c1.y, v1.x * c1.y + v1.y * c1.x, v1.z * c1.z - v1.w * c1.w, v1.z * c1.w + v1.w * c1.z}; }
                        u32x4 w; w.x = pk2(v0.x, v0.y); w.y = pk2(v0.z, v0.w); w.z = pk2(v1.x, v1.y); w.w = pk2(v1.z, v1.w);
                        *(u32x4*)(proj + (size_t)row * PLD + pn * 256 + c8) = w;
                    } else if (pn < 12) {
                        bf16_t* base = (lat ? ztl : ztc) + ((size_t)(b * 256 + c8)) * (2 * SEQ) + (pn - 10) * (lat ? SEQ : CTX) + t;
#pragma unroll
                        for (int j = 0; j < 4; ++j) { base[(size_t)j * 2 * SEQ] = f2bf(v0[j]); base[(size_t)(j + 4) * 2 * SEQ] = f2bf(v1[j]); }
                    } else if (bj == 0 && wc == 0 && fq < 2) { f32x4* o = (f32x4*)(ab + (size_t)row * 16 + 8 * fq); o[0] = v0; o[1] = v1; }
                }
            }
    }
};
struct SchedOut {
    int G, c, ctx; const char* A; const char* B;
    DI bool next(int i, g8::Unit& u) const { const int nM = ctx ? R_CTX / 256 : R_LAT / 256, total = nM * 4; int L = i * G + c; if (L >= total) return false;
        int pm, pn; if (ctx) { pm = R_LAT / 256 + L % nM; pn = L / nM; } else { L = xcd_remap(L, total); decode2d(L, nM, 4, pm, pn); }
        u.A = A + (size_t)pm * 256 * D * 2; u.B = B + (size_t)pn * 256 * D * 2; u.gidx = nullptr; u.pm = pm; u.pn = pn; u.aux = 0; u.nt = D / 64; u.half = 0; return true; }
};
struct EpiOut { static constexpr bool ALIGN = G8_ALIGN_OUT; static constexpr bool PERM = true; bf16_t* dmix; const float* modL; const float* modC;
    DI void operator()(const f32x4 (&acc)[2][2][4][2], const g8::Unit& u, int wr, int wc, int fr, int fq) const {
        const bool lat = u.pm * 256 < R_LAT; const int b = lat ? (u.pm * 256) / SEQ : 0;
        const float* g2 = lat ? modL + (size_t)b * 6 * D : modC;
#pragma unroll
        for (int bj = 0; bj < 2; ++bj) { const int c = u.pn * 256 + 128 * bj + 32 * wc + 8 * fq; const f32x4 g0 = *(const f32x4*)(g2 + c), g1 = *(const f32x4*)(g2 + c + 4);
#pragma unroll
            for (int ai = 0; ai < 2; ++ai)
#pragma unroll
                for (int m = 0; m < 4; ++m) { const int row = u.pm * 256 + ai * 128 + wr * 64 + m * 16 + fr; const f32x4 v0 = g0 * acc[ai][bj][m][0], v1 = g1 * acc[ai][bj][m][1];
                    u32x4 w; w.x = pk2(v0.x, v0.y); w.y = pk2(v0.z, v0.w); w.z = pk2(v1.x, v1.y); w.w = pk2(v1.z, v1.w); *(u32x4*)(dmix + (size_t)row * D + c) = w; } }
    }
};
struct SchedDft {
    int G, c, lat_on, ctx_on; const char* dl; const char* dc; const char* zl; const char* zc;
    DI bool next(int i, g8::Unit& u) const { constexpr int nlatc = (HSEQ / 256) * 2 * KSPLIT * NB, nctx = (CTX / 256) * NB; const int nlat = lat_on ? nlatc : 0, nc = ctx_on ? nctx : 0, total = nlat + nc;
        int L = i * G + c; if (L >= total) return false;
        if (L >= nc) { L = xcd_remap(L - nc, nlat); const int b = L % NB, ks = (L / NB) % (2 * KSPLIT), pm = L / (NB * 2 * KSPLIT);
            const size_t ko = (ks < KSPLIT) ? (size_t)ks * KCH : (size_t)SEQ + (size_t)(ks - KSPLIT) * KCH;
            u.A = dl + ((size_t)(1 + pm * 256) * 2 * SEQ + ko) * 2; u.B = zl + ((size_t)b * 256 * 2 * SEQ + ko) * 2; u.pm = pm; u.pn = b; u.aux = ks; u.nt = KCH / 64; }
        else { const int b = L % NB, pm = L / NB; u.A = dc + (size_t)pm * 256 * 2 * SEQ * 2; u.B = zc + (size_t)b * 256 * 2 * SEQ * 2; u.pm = pm; u.pn = b; u.aux = -1; u.nt = 2 * CTX / 64; }
        u.gidx = nullptr; u.half = 0; return true; }
};
struct EpiDft { static constexpr bool ALIGN = G8_ALIGN_DFT; static constexpr bool PERM = false; float* slab; float* slabc;
    DI void operator()(const f32x4 (&acc)[2][2][4][2], const g8::Unit& u, int wr, int wc, int fr, int fq) const {
        float* base = (u.aux >= 0) ? slab + ((size_t)u.aux * (NB * HSEQ) + (size_t)u.pn * HSEQ + u.pm * 256) * 256 : slabc + ((size_t)u.pn * CTX + u.pm * 256) * 256;
#pragma unroll
        for (int ai = 0; ai < 2; ++ai)
#pragma unroll
            for (int m = 0; m < 4; ++m) { float* rowp = base + (size_t)(ai * 128 + wr * 64 + m * 16 + fr) * 256 + 32 * wc + 4 * fq;
#pragma unroll
                for (int bj = 0; bj < 2; ++bj)
#pragma unroll
                    for (int n = 0; n < 2; ++n) *(f32x4*)(rowp + 128 * bj + 16 * n) = acc[ai][bj][m][n]; }
    }
};
constexpr bool EHALF = (EROWS % 256 != 0) && (EROWS % 256 <= 128);
struct SchedGU {
    int G, c, epan; const char* A; const char* B; const int* ridx;
    DI bool next(int i, g8::Unit& u) const { constexpr int NN = 2 * DEXP / 256; const int total = NEXP * epan * NN; int L = i * G + c; if (L >= total) return false;
        const bool hp = EHALF && (epan == EROWS_PAD / 256); const int ef = hp ? epan - 1 : epan, nfull = NEXP * ef * NN;
        int e, pn, pm, hf = 0;
        if (L < nfull) { L = xcd_remap(L, nfull); e = L / (ef * NN); const int rem = L % (ef * NN); pn = rem / ef; pm = rem % ef; }
        else { L -= nfull; e = L / NN; pn = L % NN; pm = epan - 1; hf = 1; }
        u.A = A; u.gidx = ridx + (size_t)e * EROWS_PAD + pm * 256; u.B = B + ((size_t)e * 2 * DEXP + pn * 256) * D * 2; u.pm = e * (EROWS_PAD / 256) + pm; u.pn = pn; u.aux = e; u.nt = D / 64; u.half = hf; return true; }
};
struct EpiGU { static constexpr bool ALIGN = G8_ALIGN_GU; static constexpr bool PERM = true; bf16_t* hid;
    DI void operator()(const f32x4 (&acc)[2][2][4][2], const g8::Unit& u, int wr, int wc, int fr, int fq) const {
#pragma unroll
        for (int ai = 0; ai < 2; ++ai)
#pragma unroll
            for (int m = 0; m < 4; ++m) { if (ai == 1 && u.half) continue; const int row = u.pm * 256 + ai * 128 + wr * 64 + m * 16 + fr;
                const f32x4 g0 = acc[ai][0][m][0], g1 = acc[ai][0][m][1], u0 = acc[ai][1][m][0], u1 = acc[ai][1][m][1];
                u32x4 w; w.x = pk2(siluf(g0.x) * u0.x, siluf(g0.y) * u0.y); w.y = pk2(siluf(g0.z) * u0.z, siluf(g0.w) * u0.w); w.z = pk2(siluf(g1.x) * u1.x, siluf(g1.y) * u1.y); w.w = pk2(siluf(g1.z) * u1.z, siluf(g1.w) * u1.w);
                *(u32x4*)(hid + (size_t)row * DEXP + u.pn * 128 + 32 * wc + 8 * fq) = w; }
    }
};
struct SchedDown {
    int G, c, epan; const char* A; const char* B;
    DI bool next(int i, g8::Unit& u) const { const int total = NEXP * epan * 4; int L = i * G + c; if (L >= total) return false;
        const bool hp = EHALF && (epan == EROWS_PAD / 256); const int ef = hp ? epan - 1 : epan, nfull = NEXP * ef * 4;
        int e, pn, pm, hf = 0;
        if (L < nfull) { L = xcd_remap(L, nfull); e = L / (ef * 4); const int rem = L % (ef * 4); pn = rem / ef; pm = rem % ef; }
        else { L -= nfull; e = L / 4; pn = L % 4; pm = epan - 1; hf = 1; }
        u.A = A + ((size_t)e * EROWS_PAD + pm * 256) * DEXP * 2; u.gidx = nullptr; u.B = B + ((size_t)e * D + pn * 256) * DEXP * 2; u.pm = e * (EROWS_PAD / 256) + pm; u.pn = pn; u.aux = e; u.nt = DEXP / 64; u.half = hf; return true; }
};
struct EpiDown { static constexpr bool ALIGN = G8_ALIGN_DOWN; static constexpr bool PERM = true; bf16_t* y; const float* gatev;
    DI void operator()(const f32x4 (&acc)[2][2][4][2], const g8::Unit& u, int wr, int wc, int fr, int fq) const {
#pragma unroll
        for (int ai = 0; ai < 2; ++ai)
#pragma unroll
            for (int m = 0; m < 4; ++m) { if (ai == 1 && u.half) continue; const int row = u.pm * 256 + ai * 128 + wr * 64 + m * 16 + fr; const float gv = gatev[row];
#pragma unroll
                for (int bj = 0; bj < 2; ++bj) { const f32x4 v0 = acc[ai][bj][m][0] * gv, v1 = acc[ai][bj][m][1] * gv; u32x4 w; w.x = pk2(v0.x, v0.y); w.y = pk2(v0.z, v0.w); w.z = pk2(v1.x, v1.y); w.w = pk2(v1.z, v1.w);
                    *(u32x4*)(y + (size_t)row * D + u.pn * 256 + 128 * bj + 32 * wc + 8 * fq) = w; } }
    }
};

DI int block_sum_i(const Frame& F, int v, LAS int* tmp) {
#pragma unroll
    for (int o = 1; o < 64; o <<= 1) v += __shfl_xor(v, o);
    if (F.lane == 0) tmp[F.wave] = v;
    __syncthreads();
    int s = 0;
#pragma unroll
    for (int w = 0; w < 8; ++w) s += tmp[w];
    __syncthreads();
    return s;
}
DI int block_excl_scan_i(const Frame& F, int v, LAS int* tmp) {
    int inc = v;
#pragma unroll
    for (int o = 1; o < 64; o <<= 1) { const int t = __shfl_up(inc, o); if (F.lane >= o) inc += t; }
    if (F.lane == 63) tmp[F.wave] = inc;
    __syncthreads();
    int base = 0;
#pragma unroll
    for (int w = 0; w < 8; ++w) base += (w < F.wave) ? tmp[w] : 0;
    __syncthreads();
    return base + inc - v;
}
template <int KPT>
DI void topk_problem(const Frame& F, const float* aff, int* ridx, float* gatev, int* inv, int e, int N, int cap, int rowbase, int slotbase) {
    LAS int* tmp = (LAS int*)F.lds;
    unsigned key[KPT];
#pragma unroll
    for (int j = 0; j < KPT; ++j) { const int tok = F.tid * KPT + j; key[j] = (tok < N) ? __float_as_uint(aff[(size_t)(rowbase + tok) * NEXP + e]) : 0u; }
    unsigned T = 0u;
    for (int bit = 31; bit >= 0; --bit) { const unsigned cand = T | (1u << bit); int c = 0;
#pragma unroll
        for (int j = 0; j < KPT; ++j) c += (key[j] >= cand) ? 1 : 0;
        if (block_sum_i(F, c, tmp) >= cap) T = cand; }
    int cg = 0, ce = 0;
#pragma unroll
    for (int j = 0; j < KPT; ++j) { cg += (key[j] > T) ? 1 : 0; ce += (key[j] == T) ? 1 : 0; }
    const int need_eq = cap - block_sum_i(F, cg, tmp);
    int eqb = block_excl_scan_i(F, ce, tmp);
    int sel[KPT]; int ns = 0;
#pragma unroll
    for (int j = 0; j < KPT; ++j) { const bool s = (key[j] > T) || (key[j] == T && eqb < need_eq); if (key[j] == T) ++eqb; sel[j] = s ? 1 : 0; ns += sel[j]; }
    int ord = block_excl_scan_i(F, ns, tmp);
#pragma unroll
    for (int j = 0; j < KPT; ++j) { const int tok = F.tid * KPT + j; if (tok < N) { const int row = rowbase + tok; int ix = -1;
            if (sel[j]) { ix = e * EROWS_PAD + slotbase + ord; ridx[ix] = row; gatev[ix] = __uint_as_float(key[j]); ++ord; }
            inv[(size_t)row * NEXP + e] = ix; } }
}
DI void phase_topk(const Frame& F0, const Params& P, const int l) {
    const Frame F = relaunder(F0);
    const float* aff = wsp<float>(P, WS_AFF); int* ridx = wsp<int>(P, WS_RIDX); float* gatev = wsp<float>(P, WS_GATEV); int* inv = wsp<int>(P, WS_INV);
    const int nprob = NEXP * NB * ((l < DEPTH - 1) ? 2 : 1);
    for (int p = F.bid; p < nprob; p += F.G) { const int seg = p / (NEXP * NB), b = (p / NEXP) % NB, e = p % NEXP;
        if (seg == 0) topk_problem<(SEQ + 511) / 512>(F, aff, ridx, gatev, inv, e, SEQ, CAP_LAT, b * SEQ, b * CAP_LAT);
        else topk_problem<(CTX + 511) / 512>(F, aff, ridx, gatev, inv, e, CTX, CAP_CTX, R_LAT + b * CTX, NB * CAP_LAT + b * CAP_CTX); }
}

DI float softplusf_(float x) { const float t = __expf(-fabsf(x)); return fmaxf(x, 0.f) + (t < 1e-3f ? t * (1.0f - 0.5f * t) : __logf(1.0f + t)); }
DI float fexp2(float x) { return __builtin_amdgcn_exp2f(x); }
DI float rdlane(float v, int l) { return __builtin_bit_cast(float, __builtin_amdgcn_readlane(__builtin_bit_cast(int, v), l)); }

DI void phase_dn0(const Frame& F0, const Params& P, const int l) {
    const Frame F = relaunder(F0);
    const bf16_t* proj = wsp<bf16_t>(P, WS_PROJ); bf16_t* dnp = wsp<bf16_t>(P, WS_DNP); const float* ab = wsp<float>(P, WS_AB); float* gb = wsp<float>(P, WS_GB);
    const float* convw = P.in[I_CONVW] + (size_t)l * 5 * 768; const float* alog = P.in[I_ALOG] + l * 8; const float* dtb = P.in[I_DTB] + l * 8;
    const int lane = F.lane;
    constexpr int DR = 9, UL = (SEQ + DR - 1) / DR, UC = (CTX + DR - 1) / DR, NU0 = NB * (UL + UC);
    for (int u = F.gw; u < NU0; u += F.ngw) {
        int base, t0, T; if (u < NB * UL) { base = (u / UL) * SEQ; t0 = (u % UL) * DR; T = SEQ; } else { const int uu = u - NB * UL; base = R_LAT + (uu / UC) * CTX; t0 = (uu % UC) * DR; T = CTX; }
        const int row0 = base + t0;
        u32x2 w[3][DR + 4];
#pragma unroll
        for (int r = 0; r < DR + 4; ++r) { const int tt = t0 - 2 + r; const bool ok = (tt >= 0) && (tt < T);
#pragma unroll
            for (int part = 0; part < 3; ++part) w[part][r] = ok ? *(const u32x2*)(proj + (size_t)(base + tt) * PLD + 768 + part * 256 + 4 * lane) : (u32x2){0u, 0u}; }
#pragma unroll
        for (int ps = 0; ps < (DR + 7) / 8; ++ps) { const int ri = 8 * ps + (lane >> 3), k = lane & 7;
            if (ri < DR && t0 + ri < T) { const size_t row = (size_t)row0 + ri; const float av = ab[row * 16 + k], bv = ab[row * 16 + 8 + k];
                gb[row * 16 + k] = -__expf(alog[k]) * softplusf_(av + dtb[k]); gb[row * 16 + 8 + k] = __builtin_amdgcn_rcpf(1.0f + __expf(-bv)); } }
#pragma unroll
        for (int part = 0; part < 3; ++part) {
            f32x4 cw[5];
#pragma unroll
            for (int j = 0; j < 5; ++j) cw[j] = *(const f32x4*)(convw + j * 768 + part * 256 + 4 * lane);
#pragma unroll
            for (int i = 0; i < DR; ++i) {
                f32x4 a = {0.f, 0.f, 0.f, 0.f};
#pragma unroll
                for (int j = 0; j < 5; ++j) { const u32x2 x = w[part][i + j]; a += cw[j] * (f32x4){bflo(x.x), bfhi(x.x), bflo(x.y), bfhi(x.y)}; }
                a = (f32x4){siluf(a.x), siluf(a.y), siluf(a.z), siluf(a.w)};
                if (part < 2) { float ss = (a.x * a.x + a.y * a.y) + (a.z * a.z + a.w * a.w);
                    ss += __shfl_xor(ss, 1); ss += __shfl_xor(ss, 2); ss += __shfl_xor(ss, 4); ss += __shfl_xor(ss, 8);
                    const float r = (part == 0 ? 0.125f : 1.0f) * __builtin_amdgcn_rsqf(ss + 1e-6f); a = a * r; }
                u32x2 o; o.x = pk2(a.x, a.y); o.y = pk2(a.z, a.w); if (t0 + i < T) *(u32x2*)(dnp + (size_t)(row0 + i) * 768 + part * 256 + 4 * lane) = o;
            }
        }
    }
}

#define DN_TILE(jt, it) ((jt) == 0 ? ((it) == 0 ? 0 : 1) : 2)
template <int I> struct DnSolve {
    static DI void run(float (&X)[64], const f32x16 (&Lt)[3]) {
        DnSolve<I - 1>::run(X, Lt);
        float a = X[I];
#pragma unroll
        for (int j = 0; j < I; ++j) { const int jl = j & 31, reg = (jl & 3) + 4 * (jl >> 3), hj = (jl >> 2) & 1, src = (I & 31) + 32 * hj;
            a -= rdlane(Lt[DN_TILE(j >> 5, I >> 5)][reg], src) * X[j]; }
        X[I] = a;
        __builtin_amdgcn_sched_barrier(0);
    }
};
template <> struct DnSolve<-1> { static DI void run(float (&)[64], const f32x16 (&)[3]) {} };

DI void phase_dn1(const Frame& F0, const Params& P) {
    const Frame F = relaunder(F0);
    const bf16_t* dnp = wsp<bf16_t>(P, WS_DNP); const float* gb = wsp<float>(P, WS_GB);
    bf16_t* An_g = wsp<bf16_t>(P, WS_AN); bf16_t* Qe_g = wsp<bf16_t>(P, WS_QE); unsigned* Bn_g = wsp<unsigned>(P, WS_BN); float* Oi_g = wsp<float>(P, WS_OI);
    LAS unsigned char* XT = F.lds + F.wave * 16384;
    LAS float* gcs = (LAS float*)(XT + 9216); LAS float* bts = gcs + 64; LAS unsigned char* QpL = XT + 9728;
#define QP(tl, s) (*(const LAS bf16x8*)(QpL + (((tl) * 2 + (s)) * 64 + lane) * 16))
    const int nfull = (NUNIT / F.ngw) * F.ngw, nrem = NUNIT - nfull;
    for (int lin = F.gw; ; lin += F.ngw) {
        int uid, part;
        if (lin < nfull) { uid = lin; part = 2; } else { const int r = lin - nfull; if (r >= 2 * nrem) break; uid = nfull + (r >> 1); part = r & 1; }
        int lane = F.lane; LAUNDER_V(lane); const int r32 = lane & 31, hh = lane >> 5;
        const int n = uid % NCH, dir = (uid / NCH) & 1, h = (uid / (2 * NCH)) % NH, b = uid / (2 * NCH * NH);
        int seqb, T, nn; if (n < NCC) { seqb = R_LAT + b * CTX; T = CTX; nn = n; } else { seqb = b * SEQ; T = SEQ; nn = n - NCC; }
        const int rbase = dir ? seqb + T - 1 - 64 * nn : seqb + 64 * nn, sgn = dir ? -1 : 1;
#define ROWI(i) ((size_t)(rbase + sgn * (i)))
        const bf16_t* qb_ = dnp + h * 64; const bf16_t* kb_ = dnp + 256 + h * 64; const bf16_t* vb_ = dnp + 512 + h * 64;
        float gc = gb[ROWI(lane) * 16 + dir * 4 + h]; const float beta = gb[ROWI(lane) * 16 + 8 + dir * 4 + h];
#pragma unroll
        for (int o = 1; o < 64; o <<= 1) { const float t = __shfl_up(gc, o); if (lane >= o) gc += t; }
        gcs[lane] = gc; bts[lane] = beta;
        const float glast = __shfl(gc, 63), eglast = __expf(glast);
        WAIT_LGKM(0); CFENCE();
        f32x16 Lt[3];
        {
            bf16x8 Ak[2][4], Bq[2][4];
#pragma unroll
            for (int t2 = 0; t2 < 2; ++t2)
#pragma unroll
                for (int ks = 0; ks < 4; ++ks) { const size_t ro = ROWI(32 * t2 + r32) * 768 + 16 * ks + 8 * hh; Ak[t2][ks] = *(const bf16x8*)(kb_ + ro); Bq[t2][ks] = *(const bf16x8*)(qb_ + ro); }
            const float gci[2] = {gcs[r32], gcs[32 + r32]}, bti[2] = {bts[r32], bts[32 + r32]};
#pragma unroll
            for (int tl = 0; tl < 3; ++tl) { const int jt = (tl == 2) ? 1 : 0, it = (tl == 0) ? 0 : 1;
                f32x16 kk = zero16(), qk = zero16();
#pragma unroll
                for (int ks = 0; ks < 4; ++ks) { kk = MFMA32(Ak[jt][ks], Ak[it][ks], kk); qk = MFMA32(Ak[jt][ks], Bq[it][ks], qk); }
                const int i = 32 * it + r32;
#pragma unroll
                for (int reg = 0; reg < 16; ++reg) { const int j = 32 * jt + crow(reg, hh); const float dec = (i >= j) ? __expf(gci[it] - gcs[j]) : 0.f;
                    qk[reg] = qk[reg] * dec; kk[reg] = (i > j) ? bti[it] * kk[reg] * dec : 0.f; }
                Lt[tl] = kk; *(LAS bf16x8*)(QpL + ((tl * 2 + 0) * 64 + lane) * 16) = pack8(qk, 0); *(LAS bf16x8*)(QpL + ((tl * 2 + 1) * 64 + lane) * 16) = pack8(qk, 1); }
        }
        __builtin_amdgcn_sched_barrier(0);
        float X[64];
        if (part != 1) {
#pragma unroll
        for (int i = 0; i < 64; ++i) X[i] = bf2f(vb_[ROWI(i) * 768 + lane]) * rdlane(beta, i);
        __builtin_amdgcn_sched_barrier(0);
        DnSolve<63>::run(X, Lt);
#pragma unroll
        for (int q = 0; q < 8; ++q) { u32x4 w; w.x = pk2(X[8 * q], X[8 * q + 1]); w.y = pk2(X[8 * q + 2], X[8 * q + 3]); w.z = pk2(X[8 * q + 4], X[8 * q + 5]); w.w = pk2(X[8 * q + 6], X[8 * q + 7]); *(LAS u32x4*)(XT + lane * 144 + 16 * q) = w; }
        WAIT_LGKM(0); CFENCE();
        __builtin_amdgcn_sched_barrier(0);
#pragma unroll
        for (int it = 0; it < 2; ++it)
#pragma unroll
            for (int et = 0; et < 2; ++et) { f32x16 z = zero16();
#pragma unroll
                for (int jt = 0; jt <= it; ++jt)
#pragma unroll
                    for (int s = 0; s < 2; ++s) { const LAS unsigned char* p = XT + (32 * et + r32) * 144 + (32 * jt + 16 * s + 4 * hh) * 2;
                        z = MFMA32(QP(DN_TILE(jt, it), s), cat44(*(const LAS u32x2*)p, *(const LAS u32x2*)(p + 16)), z); }
                float* op = Oi_g + (size_t)uid * 4096 + 32 * et + r32;
#pragma unroll
                for (int reg = 0; reg < 16; ++reg) op[(32 * it + crow(reg, hh)) * 64] = z[reg]; }
        }
        __builtin_amdgcn_sched_barrier(0);
        bf16x8 Kd[2][4];
#pragma unroll
        for (int dt = 0; dt < 2; ++dt)
#pragma unroll
            for (int s4 = 0; s4 < 4; ++s4) { float v[8];
#pragma unroll
                for (int jj = 0; jj < 8; ++jj) { const int j = 16 * s4 + 8 * hh + jj; v[jj] = bf2f(kb_[ROWI(j) * 768 + 32 * dt + r32]) * __expf(glast - gcs[j]); }
                u32x4 w; w.x = pk2(v[0], v[1]); w.y = pk2(v[2], v[3]); w.z = pk2(v[4], v[5]); w.w = pk2(v[6], v[7]); Kd[dt][s4] = __builtin_bit_cast(bf16x8, w); }
        if (part != 1) {
#pragma unroll
        for (int dt = 0; dt < 2; ++dt)
#pragma unroll
            for (int et = 0; et < 2; ++et) { f32x16 z = zero16();
#pragma unroll
                for (int s4 = 0; s4 < 4; ++s4) z = MFMA32(Kd[dt][s4], *(const LAS bf16x8*)(XT + (32 * et + r32) * 144 + (16 * s4 + 8 * hh) * 2), z);
                u32x4* op = (u32x4*)(Bn_g + (size_t)uid * 2048 + ((dt * 2 + et) * 64 + lane) * 8);
                op[0] = (u32x4){pk2(z[0], z[1]), pk2(z[2], z[3]), pk2(z[4], z[5]), pk2(z[6], z[7])}; op[1] = (u32x4){pk2(z[8], z[9]), pk2(z[10], z[11]), pk2(z[12], z[13]), pk2(z[14], z[15])}; }
        }
        if (part != 0) {
        CFENCE();
        LAUNDER_V(Lt[0]); LAUNDER_V(Lt[1]); LAUNDER_V(Lt[2]);
        { const float bw = beta * __expf(gc);
#pragma unroll
          for (int i = 0; i < 64; ++i) X[i] = bf2f(kb_[ROWI(i) * 768 + lane]) * rdlane(bw, i); }
        __builtin_amdgcn_sched_barrier(0);
        DnSolve<63>::run(X, Lt);
#pragma unroll
        for (int q = 0; q < 8; ++q) { u32x4 w; w.x = pk2(X[8 * q], X[8 * q + 1]); w.y = pk2(X[8 * q + 2], X[8 * q + 3]); w.z = pk2(X[8 * q + 4], X[8 * q + 5]); w.w = pk2(X[8 * q + 6], X[8 * q + 7]); *(LAS u32x4*)(XT + lane * 144 + 16 * q) = w; }
        WAIT_LGKM(0); CFENCE();
        __builtin_amdgcn_sched_barrier(0);
#pragma unroll
        for (int dt = 0; dt < 2; ++dt)
#pragma unroll
            for (int et = 0; et < 2; ++et) { f32x16 z = zero16();
#pragma unroll
                for (int s4 = 0; s4 < 4; ++s4) z = MFMA32(Kd[dt][s4], *(const LAS bf16x8*)(XT + (32 * et + r32) * 144 + (16 * s4 + 8 * hh) * 2), z);
                const int x = r32 & 15, hhA = (x >> 2) & 1, jj = ((x >> 3) << 2) | (x & 3);
                bf16_t* op = An_g + (size_t)uid * 4096 + (((dt * 2 + et) * 2 + (r32 >> 4)) * 64 + 32 * hhA) * 8 + jj;
#pragma unroll
                for (int reg = 0; reg < 16; ++reg) { const int dl = crow(reg, hh); op[dl * 8] = f2bf(((32 * dt + dl == 32 * et + r32) ? eglast : 0.f) - z[reg]); } }
        __builtin_amdgcn_sched_barrier(0);
#pragma unroll
        for (int it = 0; it < 2; ++it) { const int i = 32 * it + r32; const float eg = __expf(gcs[i]);
#pragma unroll
            for (int dt = 0; dt < 2; ++dt) { f32x16 y = zero16();
#pragma unroll
                for (int jt = 0; jt <= it; ++jt)
#pragma unroll
                    for (int s = 0; s < 2; ++s) { const LAS unsigned char* p = XT + (32 * dt + r32) * 144 + (32 * jt + 16 * s + 4 * hh) * 2;
                        y = MFMA32(cat44(*(const LAS u32x2*)p, *(const LAS u32x2*)(p + 16)), QP(DN_TILE(jt, it), s), y); }
#pragma unroll
                for (int a = 0; a < 4; ++a) { const int d0 = 32 * dt + 8 * a + 4 * hh; const u32x2 qv = *(const u32x2*)(qb_ + ROWI(i) * 768 + d0);
                    u32x2 o; o.x = pk2(bflo(qv.x) * eg - y[4 * a], bfhi(qv.x) * eg - y[4 * a + 1]); o.y = pk2(bflo(qv.y) * eg - y[4 * a + 2], bfhi(qv.y) * eg - y[4 * a + 3]);
                    *(u32x2*)(Qe_g + (size_t)uid * 4096 + i * 64 + d0) = o; } } }
        }
        WAIT_LGKM(0); CFENCE();
#undef ROWI
    }
}

DI void dn2_load(const bf16_t* An_g, const unsigned* Bn_g, size_t uid, int et, int lane, u32x4 (&Ar)[8], u32x4 (&Br)[4]) {
#pragma unroll
    for (int f = 0; f < 8; ++f) Ar[f] = *(const u32x4*)(An_g + uid * 4096 + (f * 64 + lane) * 8);
#pragma unroll
    for (int dt = 0; dt < 2; ++dt) { const u32x4* bp = (const u32x4*)(Bn_g + uid * 2048 + ((dt * 2 + et) * 64 + lane) * 8); Br[2 * dt] = bp[0]; Br[2 * dt + 1] = bp[1]; }
}
DI void dn2_step(bf16_t* Sn_g, size_t uid, int et, int lane, f32x16 (&S)[2], const u32x4 (&Ar)[8], const u32x4 (&Br)[4]) {
    bf16x8 Sp[2][2];
#pragma unroll
    for (int dp = 0; dp < 2; ++dp)
#pragma unroll
        for (int s = 0; s < 2; ++s) { Sp[dp][s] = pack8(S[dp], s); *(bf16x8*)(Sn_g + uid * 4096 + (((et * 2 + dp) * 2 + s) * 64 + lane) * 8) = Sp[dp][s]; }
#pragma unroll
    for (int dt = 0; dt < 2; ++dt) { f32x16 z;
#pragma unroll
        for (int h2 = 0; h2 < 2; ++h2) { const u32x4 w = Br[2 * dt + h2]; z[8 * h2] = bflo(w.x); z[8 * h2 + 1] = bfhi(w.x); z[8 * h2 + 2] = bflo(w.y); z[8 * h2 + 3] = bfhi(w.y); z[8 * h2 + 4] = bflo(w.z); z[8 * h2 + 5] = bfhi(w.z); z[8 * h2 + 6] = bflo(w.w); z[8 * h2 + 7] = bfhi(w.w); }
#pragma unroll
        for (int dp = 0; dp < 2; ++dp)
#pragma unroll
            for (int s = 0; s < 2; ++s) z = MFMA32(__builtin_bit_cast(bf16x8, Ar[(dt * 2 + dp) * 2 + s]), Sp[dp][s], z);
        S[dt] = z; }
}
DI void phase_dn2(const Frame& F0, const Params& P) {
    const Frame F = relaunder(F0);
    const bf16_t* An_g = wsp<bf16_t>(P, WS_AN); const unsigned* Bn_g = wsp<unsigned>(P, WS_BN); bf16_t* Sn_g = wsp<bf16_t>(P, WS_SN);
    const int lane = F.lane;
    constexpr int NCHAIN = NB * NH * 2 * 2;
    if (F.wave < 4)
    for (int cid = F.bid * 4 + F.wave; cid < NCHAIN; cid += F.G * 4) {
        const int et = cid & 1; const size_t uid0 = (size_t)(cid >> 1) * NCH;
        f32x16 S[2] = {zero16(), zero16()};
        u32x4 A0[8], A1[8], A2[8], B0[4], B1[4], B2[4];
        dn2_load(An_g, Bn_g, uid0, et, lane, A0, B0);
        dn2_load(An_g, Bn_g, uid0 + (1 < NCH ? 1 : 0), et, lane, A1, B1);
        dn2_load(An_g, Bn_g, uid0 + (2 < NCH ? 2 : 0), et, lane, A2, B2);
        for (int n = 0; n < NCH; n += 3) {
            dn2_step(Sn_g, uid0 + n, et, lane, S, A0, B0);
            dn2_load(An_g, Bn_g, uid0 + (n + 3 < NCH ? n + 3 : n), et, lane, A0, B0);
            if (n + 1 < NCH) { dn2_step(Sn_g, uid0 + n + 1, et, lane, S, A1, B1); dn2_load(An_g, Bn_g, uid0 + (n + 4 < NCH ? n + 4 : n), et, lane, A1, B1); }
            if (n + 2 < NCH) { dn2_step(Sn_g, uid0 + n + 2, et, lane, S, A2, B2); dn2_load(An_g, Bn_g, uid0 + (n + 5 < NCH ? n + 5 : n), et, lane, A2, B2); }
        }
    }
}

DI void phase_dn3(const Frame& F0, const Params& P, const int l, const int pidx, const int np) {
    const Frame F = relaunder(F0);
    const bf16_t* Qe_g = wsp<bf16_t>(P, WS_QE); const bf16_t* Sn_g = wsp<bf16_t>(P, WS_SN); const float* Oi_g = wsp<float>(P, WS_OI);
    const bf16_t* proj = wsp<bf16_t>(P, WS_PROJ); bf16_t* mix = wsp<bf16_t>(P, WS_MIX); const float* ng = P.in[I_DNG] + l * 64;
    const int lane = F.lane, r32 = lane & 31, hh = lane >> 5;
    const int NC = NCL + ((l < DEPTH - 1) ? NCC : 0);
    for (int u = F.wave * np + pidx; u < NB * NH * NC; u += np * 8) {
        const int ca = u % NC, h = (u / NC) % NH, b = u / (NC * NH);
        int rowb, nf, nbk; if (ca < NCL) { rowb = b * SEQ + 64 * ca; nf = NCC + ca; nbk = NCC + (NCL - 1 - ca); } else { const int c = ca - NCL; rowb = R_LAT + b * CTX + 64 * c; nf = c; nbk = NCC - 1 - c; }
        f32x16 O[2][2] = {{zero16(), zero16()}, {zero16(), zero16()}};
#pragma unroll
        for (int dir = 0; dir < 2; ++dir) { const size_t uid = (size_t)((b * NH + h) * 2 + dir) * NCH + (dir ? nbk : nf);
#pragma unroll
            for (int it = 0; it < 2; ++it) { const int x = 32 * it + r32, xi = dir ? 63 - x : x;
                bf16x8 Bq[2][2];
#pragma unroll
                for (int dp = 0; dp < 2; ++dp)
#pragma unroll
                    for (int s = 0; s < 2; ++s) { const bf16_t* p = Qe_g + uid * 4096 + xi * 64 + 32 * dp + 16 * s + 4 * hh; Bq[dp][s] = cat44(*(const u32x2*)p, *(const u32x2*)(p + 8)); }
#pragma unroll
                for (int et = 0; et < 2; ++et) { f32x16 z = O[et][it];
#pragma unroll
                    for (int dp = 0; dp < 2; ++dp)
#pragma unroll
                        for (int s = 0; s < 2; ++s) z = MFMA32(*(const bf16x8*)(Sn_g + uid * 4096 + (((et * 2 + dp) * 2 + s) * 64 + lane) * 8), Bq[dp][s], z);
#pragma unroll
                    for (int a = 0; a < 4; ++a) { const f32x4 oi = *(const f32x4*)(Oi_g + uid * 4096 + xi * 64 + 32 * et + 8 * a + 4 * hh); z[4 * a] += oi.x; z[4 * a + 1] += oi.y; z[4 * a + 2] += oi.z; z[4 * a + 3] += oi.w; }
                    O[et][it] = z; } } }
#pragma unroll
        for (int it = 0; it < 2; ++it) { const size_t row = (size_t)rowb + 32 * it + r32; float ss = 0.f;
#pragma unroll
            for (int et = 0; et < 2; ++et)
#pragma unroll
                for (int reg = 0; reg < 16; ++reg) ss += O[et][it][reg] * O[et][it][reg];
            ss += __shfl_xor(ss, 32);
            const float r = 1.0f / sqrtf(ss * (1.0f / 64.0f) + RMS_EPS);
#pragma unroll
            for (int et = 0; et < 2; ++et)
#pragma unroll
                for (int a = 0; a < 4; ++a) { const int e0 = 32 * et + 8 * a + 4 * hh; const f32x4 g = *(const f32x4*)(ng + e0); const u32x2 gt = *(const u32x2*)(proj + row * PLD + 6 * 256 + h * 64 + e0);
                    const f32x16& z = O[et][it];
                    u32x2 o; o.x = pk2(z[4 * a] * r * g.x * siluf(bflo(gt.x)), z[4 * a + 1] * r * g.y * siluf(bfhi(gt.x))); o.y = pk2(z[4 * a + 2] * r * g.z * siluf(bflo(gt.y)), z[4 * a + 3] * r * g.w * siluf(bfhi(gt.y)));
                    *(u32x2*)(mix + row * D + 256 + h * 64 + e0) = o; } }
    }
}

struct TileInfo { int row0, dyb, kc0; };
#ifdef EMU
DI s16x4 lds_tr16(const LAS unsigned char* p) {
    emu::Wave* w = emu::cur->wave; const int lane = emu::cur->lane;
    const int slot = emu::rendezvous(&p, sizeof(p), [](emu::Wave*, int) {});
    s16x4 r; const int g = lane >> 4, i = lane & 15;
    for (int q = 0; q < 4; ++q) { const unsigned char* a; memcpy(&a, w->stage[slot][16 * g + 4 * q + (i >> 2)], sizeof(a)); short v; memcpy(&v, a + 2 * (i & 3), 2); r[q] = v; }
    emu::rendezvous(nullptr, 0, [](emu::Wave*, int) {});
    return r;
}
#else
DI s16x4 lds_tr16(const LAS unsigned char* p) { return __builtin_amdgcn_ds_read_tr16_b64_v4i16((LAS s16x4*)p); }
#endif
DI int att_off(int row, int ch) { return 256 * row + 16 * (ch ^ (((row & 3) << 2) | ((row >> 2) & 3))); }
template <int NMAP, int TC, int SUBS, class TF>
DI void attn_core(const Frame& F, LAS unsigned char* lds, const bf16_t* proj, const bool active, const int qrow, const int qcol, const int kcol, const int vcol, const int hoff,
                  const int ntiles32, const TF& tf, const float sc, const LAS float* bias, const int qc, float (&mS)[NMAP], float (&lS)[NMAP], f32x16 (&O)[NMAP][2]) {
    static_assert(SUBS == 1, "one 32-key tile per stage");
    constexpr int KS = 4 / NMAP, NIMG = TC / 64, BUFB = NIMG * 8192, PIECES = 4 * TC, PPT = (2 * PIECES + 511) / 512, CPR = TC / 8;
    constexpr bool FULL = (2 * PIECES) % 512 == 0;
    const int ntiles = ntiles32;
    const int lane = F.lane, r32 = lane & 31, hh = lane >> 5, tid = F.tid;
    const int c0q = (qc - 8 < 0) ? 0 : ((qc - 8 > 48) ? 48 : qc - 8);
    (void)sc;
    bf16x8 qf[NMAP][KS];
#pragma unroll
    for (int mi = 0; mi < NMAP; ++mi)
#pragma unroll
        for (int ks = 0; ks < KS; ++ks) qf[mi][ks] = *(const bf16x8*)(proj + (size_t)(active ? qrow : 0) * PLD + qcol + mi * 32 + ks * 16 + hh * 8);
#pragma unroll
    for (int mi = 0; mi < NMAP; ++mi) { mS[mi] = 0.f; lS[mi] = 0.f; O[mi][0] = zero16(); O[mi][1] = zero16(); }
    u32x4 stg[PPT], stg2[PPT];
#define ATT_LOAD(ti_, dst_) do { _Pragma("unroll") for (int j = 0; j < PPT; ++j) { const int idx = tid + 512 * j; if (FULL || idx < 2 * PIECES) { const bool isV = idx >= PIECES; const int p = isV ? idx - PIECES : idx; \
        dst_[j] = *(const u32x4*)(proj + (size_t)((ti_).row0 + p / CPR) * PLD + (isV ? vcol : kcol) + (p % CPR) * 8); } } } while (0)
#define ATT_STORE_FROM(buf_, src_) do { _Pragma("unroll") for (int j = 0; j < PPT; ++j) { const int idx = tid + 512 * j; if (FULL || idx < 2 * PIECES) { const bool isV = idx >= PIECES; const int p = isV ? idx - PIECES : idx; const int cc = p % CPR; \
        *(LAS u32x4*)(lds + (buf_) * BUFB + (cc >> 3) * 8192 + att_off(p / CPR, (cc & 7) + (isV ? 8 : 0))) = src_[j]; } } } while (0)
    const int img = hoff / 64 * 8192;
    int kaddr[4];
#pragma unroll
    for (int s = 0; s < 4; ++s) kaddr[s] = img + att_off(r32, 2 * s + hh);
    const int trq = (lane & 15) >> 2, trp = lane & 3, trb = (lane >> 4) & 1;
    int vaddr[2][2][2];
#pragma unroll
    for (int dt = 0; dt < 2; ++dt)
#pragma unroll
        for (int s2 = 0; s2 < 2; ++s2)
#pragma unroll
            for (int t = 0; t < 2; ++t) vaddr[dt][s2][t] = img + att_off(16 * s2 + 8 * t + 4 * hh + trq, 8 + 4 * dt + 2 * trb + (trp >> 1)) + 8 * (trp & 1);
    f32x16 negm[NMAP], Lacc[NMAP];
#pragma unroll
    for (int mi = 0; mi < NMAP; ++mi) { negm[mi] = zero16(); Lacc[mi] = zero16(); }
    const bf16x8 ones8 = {(short)0x3f80, (short)0x3f80, (short)0x3f80, (short)0x3f80, (short)0x3f80, (short)0x3f80, (short)0x3f80, (short)0x3f80};
    auto compute = [&](const int buf, const TileInfo ti, const bool first) {
        if (active) {
            const LAS unsigned char* Tb = lds + buf * BUFB;
            bf16x8 vf[2][2];
#pragma unroll
            for (int dt = 0; dt < 2; ++dt)
#pragma unroll
                for (int s2 = 0; s2 < 2; ++s2) { const s16x4 lo = lds_tr16(Tb + vaddr[dt][s2][0]), hi = lds_tr16(Tb + vaddr[dt][s2][1]);
                    vf[dt][s2] = __builtin_shufflevector(lo, hi, 0, 1, 2, 3, 4, 5, 6, 7); }
#pragma unroll
            for (int mi = 0; mi < NMAP; ++mi) {
                f32x16 st = negm[mi];
#pragma unroll
                for (int ks = 0; ks < KS; ++ks) st = MFMA32(*(const LAS bf16x8*)(Tb + kaddr[mi * KS + ks]), qf[mi][ks], st);
                float tmax = -3.0e38f;
                if (ti.dyb >= 0) {
#pragma unroll
                    for (int reg = 0; reg < 16; ++reg) { const int kc = ti.kc0 + crow(reg, hh); const bool ok = (kc >= c0q) && (kc < c0q + 16); const float bv = bias[ti.dyb + (ok ? kc - qc + 15 : 0)];
                        const float x = ok ? st[reg] + bv : -1.0e30f; st[reg] = x; tmax = fmaxf(tmax, x); }
                } else {
#pragma unroll
                    for (int reg = 0; reg < 16; ++reg) tmax = fmaxf(tmax, st[reg]);
                }
                tmax = fmaxf(tmax, __shfl_xor(tmax, 32));
                if (first || __any(tmax > 6.0f)) { const float delta = first ? tmax : fmaxf(tmax, 0.f), alpha = fexp2(-delta);
                    if (!first) { Lacc[mi] = Lacc[mi] * alpha; O[mi][0] = O[mi][0] * alpha; O[mi][1] = O[mi][1] * alpha; }
                    negm[mi] = negm[mi] - delta; st = st - delta; }
#pragma unroll
                for (int reg = 0; reg < 16; ++reg) st[reg] = fexp2(st[reg]);
#pragma unroll
                for (int s2 = 0; s2 < 2; ++s2) { const bf16x8 pf = pack8(st, s2);
                    Lacc[mi] = MFMA32(ones8, pf, Lacc[mi]);
#pragma unroll
                    for (int dt = 0; dt < 2; ++dt) O[mi][dt] = MFMA32(vf[dt][s2], pf, O[mi][dt]); }
            }
        }
    };
    constexpr int NSTG = (PPT == 1) ? 4 : 2;
    u32x4 stg3[PPT], stg4[PPT];
    { const TileInfo t0 = tf(0); ATT_LOAD(t0, stg); }
    { const TileInfo t1 = tf(1 < ntiles ? 1 : 0); ATT_LOAD(t1, stg2); }
    if (NSTG == 4) { { const TileInfo t2 = tf(2 < ntiles ? 2 : 0); ATT_LOAD(t2, stg3); } { const TileInfo t3 = tf(3 < ntiles ? 3 : 0); ATT_LOAD(t3, stg4); } }
#define ATT_STEP(k_, reg_) do { ATT_STORE_FROM((k_) & 1, reg_); \
        WAIT_LGKM(0); __builtin_amdgcn_s_barrier(); CFENCE();     \
        { const int nx = (i + (k_) + NSTG < ntiles) ? i + (k_) + NSTG : ntiles - 1; const TileInfo tn = tf(nx); ATT_LOAD(tn, reg_); } \
        compute((k_) & 1, tf(i + (k_)), i + (k_) == 0); } while (0)
    for (int i = 0; i < ntiles; i += NSTG) {
        ATT_STEP(0, stg); ATT_STEP(1, stg2);
        if (NSTG == 4) { ATT_STEP(2, stg3); ATT_STEP(3, stg4); }
    }
#undef ATT_STEP
#pragma unroll
    for (int mi = 0; mi < NMAP; ++mi) lS[mi] = 0.5f * Lacc[mi][0];
    __syncthreads();
#undef ATT_LOAD
#undef ATT_STORE_FROM
}

constexpr int NCHB = (NB * NH * 4 + 3) / 4;
DI bool chain_dedicated(int G) { return G >= 4 * NCHB; }
constexpr int NA_BUFB = 4 * 8192;
constexpr int NA_BIAS_OFF = 2 * NA_BUFB;
template <int PART> DI void phase_attn(const Frame& F0, const Params& P, const int l, const bool lat_on = true, const bool ctx_on = true, const int Gd = 0, const int cd = 0) {
    const Frame F = relaunder(F0);
    const bf16_t* proj = wsp<bf16_t>(P, WS_PROJ); bf16_t* mix = wsp<bf16_t>(P, WS_MIX);
    const bool last = (l == DEPTH - 1);
    const int lane = F.lane, r32 = lane & 31, hh = lane >> 5, wave = F.wave;
    LAS float* bias = (LAS float*)(F.lds + NA_BIAS_OFF);
    const bool dedicated = chain_dedicated(F.G); const int first = dedicated ? NCHB : 0;
    if (PART == 0 && (!dedicated || F.bid >= NCHB)) {
    for (int i = F.tid; i < 4 * 465; i += 512) bias[i] = P.in[I_RPB][(size_t)l * 4 * 465 + i] * LOG2E;
    __syncthreads();
    { const int nlat = NB * GROWS, nctx = last ? 0 : NB * (CTX / 64);
      for (int uq = F.bid - first; uq < nlat + nctx; uq += F.G - first) {
        const int u = (uq < nlat && nlat % 8 == 0) ? (uq % 8) * (nlat / 8) + uq / 8 : uq;
        const int h = wave >> 1, qh = wave & 1; int qrow, ntiles, b, r = 0, wstart = 0; const int nct = CTX / 32;
        if (u < nlat) { b = u / GROWS; r = u % GROWS; qrow = b * SEQ + r * 64 + qh * 32 + r32; int ws = r - WH / 2; ws = ws < 0 ? 0 : (ws > GROWS - WH ? GROWS - WH : ws); wstart = ws; ntiles = nct + 2 * WH; }
        else { const int uu = u - nlat; b = uu / (CTX / 64); qrow = R_LAT + b * CTX + (uu % (CTX / 64)) * 64 + qh * 32 + r32; ntiles = nct; }
        auto tf = [&](int i) { TileInfo t; if (i < nct) { t.row0 = R_LAT + b * CTX + 32 * i; t.dyb = -1; t.kc0 = 0; } else { const int w = (i - nct) >> 1, half = (i - nct) & 1, wrow = wstart + w; t.row0 = b * SEQ + wrow * 64 + 32 * half; t.dyb = (wrow - r + 7) * 31; t.kc0 = 32 * half; } return t; };
        float mS[1], lS[1]; f32x16 O[1][2];
        attn_core<1, 256, 1>(F, F.lds, proj, true, qrow, h * 64, 256, 512, 64 * h, ntiles, tf, 0.125f * LOG2E, bias + h * 465, qh * 32 + r32, mS, lS, O);
        const float inv = 1.0f / (lS[0] + __shfl_xor(lS[0], 32));
#pragma unroll
        for (int dt = 0; dt < 2; ++dt)
#pragma unroll
            for (int a = 0; a < 4; ++a) { const int d0 = 32 * dt + 8 * a + 4 * hh; u32x2 o; o.x = pk2(O[0][dt][4 * a] * inv, O[0][dt][4 * a + 1] * inv); o.y = pk2(O[0][dt][4 * a + 2] * inv, O[0][dt][4 * a + 3] * inv);
                *(u32x2*)(mix + (size_t)qrow * D + h * 64 + d0) = o; }
      } }
    }
    if (PART == 1) { const float lam_init = 0.8f - 0.6f * expf(-0.3f * (float)l);
      const float* dl = P.in[I_DFLAM] + (size_t)l * 128; const float p1 = (lane < 32) ? dl[lane] * dl[32 + lane] : 0.f, p2 = (lane < 32) ? dl[64 + lane] * dl[96 + lane] : 0.f;
      const float lam = expf(wave_sum(p1)) - expf(wave_sum(p2)) + lam_init;
      const float* dg = P.in[I_DFG] + l * 64;
      constexpr int QBL = SEQ / 256, QBC = (CTX + 255) / 256; const int nlat = lat_on ? NB * NH * QBL : 0, nctx = (last || !ctx_on) ? 0 : NB * NH * QBC; const int nct = CTX / 32;
      for (int u0 = cd; u0 < nlat + nctx; u0 += Gd) {
        const int ul = u0 - nctx, u = (u0 < nctx) ? nlat + u0 : ((nlat % 8 == 0) ? (ul % 8) * (nlat / 8) + ul / 8 : ul);
        int b, h, qrow, ntiles; bool active = true;
        if (u < nlat) { const int qb = u % QBL; h = (u / QBL) % NH; b = u / (QBL * NH); qrow = b * SEQ + qb * 256 + 32 * wave + r32; ntiles = nct + SEQ / 32; }
        else { const int uu = u - nlat, qb = uu % QBC; h = (uu / QBC) % NH; b = uu / (QBC * NH); active = (qb * 256 + 32 * wave) < CTX; qrow = R_LAT + b * CTX + qb * 256 + 32 * wave + r32; ntiles = nct; }
        auto tf = [&](int i) { TileInfo t; t.row0 = (i < nct) ? R_LAT + b * CTX + 32 * i : b * SEQ + 32 * (i - nct); t.dyb = -1; t.kc0 = 0; return t; };
        float mS[2], lS[2]; f32x16 O[2][2];
        attn_core<2, 64, 1>(F, F.lds, proj, active, qrow, 7 * 256 + h * 64, 8 * 256 + h * 64, 9 * 256 + h * 64, 0, ntiles, tf, 0.17677669529663687f * LOG2E, bias, 0, mS, lS, O);
        if (active) {
            const float i1 = 1.0f / (lS[0] + __shfl_xor(lS[0], 32)), i2 = lam / (lS[1] + __shfl_xor(lS[1], 32));
            float ss = 0.f;
#pragma unroll
            for (int dt = 0; dt < 2; ++dt)
#pragma unroll
                for (int reg = 0; reg < 16; ++reg) { const float o = O[0][dt][reg] * i1 - O[1][dt][reg] * i2; O[0][dt][reg] = o; ss += o * o; }
            ss += __shfl_xor(ss, 32);
            const float rr = (1.0f - lam_init) / sqrtf(ss * (1.0f / 64.0f) + RMS_EPS);
#pragma unroll
            for (int dt = 0; dt < 2; ++dt)
#pragma unroll
                for (int a = 0; a < 4; ++a) { const int d0 = 32 * dt + 8 * a + 4 * hh; const f32x4 g = *(const f32x4*)(dg + d0);
                    u32x2 o; o.x = pk2(O[0][dt][4 * a] * rr * g.x, O[0][dt][4 * a + 1] * rr * g.y); o.y = pk2(O[0][dt][4 * a + 2] * rr * g.z, O[0][dt][4 * a + 3] * rr * g.w);
                    *(u32x2*)(mix + (size_t)qrow * D + 512 + h * 64 + d0) = o; }
        }
      } }
}
DI void phase_ftreduce(const Frame& F0, const Params& P, const int l, const int pidx, const int np, const bool lat_on, const bool ctx_on) {
    const Frame F = relaunder(F0);
    const float* slab = wsp<float>(P, WS_SLAB); const float* slabc = wsp<float>(P, WS_SLABC); bf16_t* mix = wsp<bf16_t>(P, WS_MIX);
    const int gt = pidx * 512 + F.tid, ngt = np * 512;
    const int nl = lat_on ? R_LAT * 64 : 0, nc = (ctx_on && l < DEPTH - 1) ? R_CTX * 64 : 0;
    constexpr size_t SLABSZ = (size_t)NB * HSEQ * 64;
    for (int i = gt; i < nl + nc; i += ngt) {
        f32x4 v; int row; int c4;
        if (i < nl) { row = i / 64; c4 = i % 64; const int b = row / SEQ, k = row % SEQ;
            if (k == 0) continue;
            const int kk = (k <= HSEQ) ? k : SEQ - k; const size_t o = ((size_t)b * HSEQ + kk - 1) * 64 + c4;
            f32x4 p = *((const f32x4*)slab + o), q = *((const f32x4*)slab + (size_t)KSPLIT * SLABSZ + o);
#pragma unroll
            for (int ks = 1; ks < KSPLIT; ++ks) { p += *((const f32x4*)slab + (size_t)ks * SLABSZ + o); q += *((const f32x4*)slab + (size_t)(KSPLIT + ks) * SLABSZ + o); }
            v = (k <= HSEQ) ? p + q : p - q; }
        else { const int j = i - nl; row = R_LAT + j / 64; c4 = j % 64; v = *((const f32x4*)slabc + j); }
        u32x2 o; o.x = pk2(v.x, v.y); o.y = pk2(v.z, v.w); *(u32x2*)(mix + (size_t)row * D + 768 + 4 * c4) = o;
    }
    if (lat_on) { const bf16_t* ztl = wsp<bf16_t>(P, WS_ZTL); const float sc = 1.0f / sqrtf((float)SEQ);
      for (int u = F.wave * np + pidx; u < NB * 256; u += np * 8) { const bf16_t* zr = ztl + (size_t)u * 2 * SEQ; float s = 0.f;
          for (int t = 8 * F.lane; t < SEQ; t += 512) { const u32x4 w = *(const u32x4*)(zr + t); s += (bflo(w.x) + bfhi(w.x)) + (bflo(w.y) + bfhi(w.y)) + (bflo(w.z) + bfhi(w.z)) + (bflo(w.w) + bfhi(w.w)); }
          s = wave_sum(s);
          if (F.lane == 0) mix[((size_t)(u / 256) * SEQ) * D + 768 + (u % 256)] = f2bf(s * sc); } }
}

#define REP_P0 1
#define REP_PROJ 1
#define REP_DN0 1
#define REP_DN1 1
#define REP_CHAIN 1
#define REP_DFT 1
#define REP_ATT 1
#define REP_N2 1
#define REP_TOPK 1
#define REP_GU 1
#define REP_DOWN 1
__global__ void __launch_bounds__(512, 2) fwd_kernel(Params P) {
#ifdef EMU
    unsigned char* lds_raw = emu::cur->blk->lds;
#else
    extern __shared__ __attribute__((aligned(16))) unsigned char lds_raw[];
#endif
    Frame F; F.lds = (LAS unsigned char*)lds_raw; F.tid = threadIdx.x; F.lane = F.tid & 63; F.wave = __builtin_amdgcn_readfirstlane(F.tid >> 6);
    F.G = gridDim.x; F.bid = blockIdx.x; F.gw = F.wave * F.G + F.bid; F.ngw = F.G * 8;
    volatile LAS unsigned* misc = (volatile LAS unsigned*)(F.lds + LDS_MISC);
    if (F.tid < 64) misc[F.tid] = 0u;
    __syncthreads();
    XcdBarrier bar = xcd_barrier_post(wsp<unsigned>(P, WS_CTL) + CW_BAR, misc + 8);
#define GRID_BAR() xcd_barrier(bar)
#ifdef EMU
    const int emu_stop = getenv("EMU_STOP") ? atoi(getenv("EMU_STOP")) : -1;
#define EMU_STOP(l, ph) do { if (emu_stop == (l) * 100 + (ph)) return; } while (0)
#else
#define EMU_STOP(l, ph)
#endif

#pragma unroll
        for (int rep_ = 0; rep_ < REP_P0; ++rep_) {
    p0_weights(F, P);
    __syncthreads();
    p0_mod(F, P);
    p0_misc(F, P);
    GRID_BAR();
        }
    { SchedW S{F.G, F.bid, (const char*)wsp<bf16_t>(P, WS_MZT), (const char*)wsp<bf16_t>(P, WS_WFT)}; EpiW E{wsp<bf16_t>(P, WS_WIN)};
      g8::gemm_phase<EpiW, SchedW, false>(F.lds, 256, 256, S, E); }
    phase_norm1(F, P, 0);
    GRID_BAR();
    for (int l = 0; l < DEPTH; ++l) {
        const int last = (l == DEPTH - 1) ? 1 : 0;
        if (l > 0) { phase_norm1(F, P, l); GRID_BAR(); }
        EMU_STOP(l, 1);
#pragma unroll
        for (int rep_ = 0; rep_ < REP_PROJ; ++rep_) {
        { SchedProj S{F.G, F.bid, last, (const char*)wsp<bf16_t>(P, WS_H), (const char*)(wsp<bf16_t>(P, WS_WIN) + (size_t)l * NPROJ * D)};
          EpiProj E{wsp<bf16_t>(P, WS_PROJ), wsp<float>(P, WS_AB), wsp<bf16_t>(P, WS_ZTL), wsp<bf16_t>(P, WS_ZTC), wsp<float>(P, WS_ROPE)};
          g8::gemm_phase<EpiProj, SchedProj, false>(F.lds, D, D, S, E); }
        GRID_BAR();
        }
        EMU_STOP(l, 2);
#pragma unroll
        for (int rep_ = 0; rep_ < REP_DN0; ++rep_) {
        phase_dn0(F, P, l);
        GRID_BAR();
        }
        EMU_STOP(l, 3);
#pragma unroll
        for (int rep_ = 0; rep_ < REP_DN1; ++rep_) {
        { SchedDft S{F.G, F.bid, 1, (!last && !chain_dedicated(F.G)) ? 1 : 0, (const char*)wsp<bf16_t>(P, WS_DFTL), (const char*)wsp<bf16_t>(P, WS_DFTC), (const char*)wsp<bf16_t>(P, WS_ZTL), (const char*)wsp<bf16_t>(P, WS_ZTC)};
          EpiDft E{wsp<float>(P, WS_SLAB), wsp<float>(P, WS_SLABC)};
          g8::gemm_phase<EpiDft, SchedDft, false>(F.lds, 2 * SEQ, 2 * SEQ, S, E); }
        phase_dn1(F, P);
        GRID_BAR();
        }
        EMU_STOP(l, 4);
#pragma unroll
        for (int rep_ = 0; rep_ < REP_CHAIN; ++rep_) {
        phase_dn2(F, P);
        unsigned* chc = wsp<unsigned>(P, WS_CTL) + CW_CHC + 64 * l;
        if (chain_dedicated(F.G) && F.bid < NCHB) {
            WAIT_VM(0);
            __syncthreads();
            if (F.tid == 0) { __builtin_amdgcn_fence(__ATOMIC_RELEASE, "agent"); WAIT_VM(0); (void)xb_add(chc, 1u); }
        }
        if (chain_dedicated(F.G) && F.bid < NCHB && !last) {
            __syncthreads();
            { SchedDft S{NCHB, F.bid, 0, 1, (const char*)wsp<bf16_t>(P, WS_DFTL), (const char*)wsp<bf16_t>(P, WS_DFTC), (const char*)wsp<bf16_t>(P, WS_ZTL), (const char*)wsp<bf16_t>(P, WS_ZTC)};
              EpiDft E{wsp<float>(P, WS_SLAB), wsp<float>(P, WS_SLABC)};
              g8::gemm_phase<EpiDft, SchedDft, false>(F.lds, 2 * SEQ, 2 * SEQ, S, E); }
            phase_attn<1>(F, P, l, false, true, NCHB, F.bid);
        }
        phase_attn<0>(F, P, l);
        if (chain_dedicated(F.G) && F.bid >= NCHB) {
            const int nb_na = F.G - NCHB, units = NB * GROWS + (last ? 0 : NB * (CTX / 64)), extra = units % nb_na, idx = F.bid - NCHB;
            if (idx >= extra) { phase_ftreduce(F, P, l, idx - extra, nb_na - extra, true, false);
                { unsigned sp = 0u; while (xb_ld(chc) < (unsigned)NCHB) { __builtin_amdgcn_s_sleep(2); if (++sp > (1u << 22)) break; } }
                __builtin_amdgcn_fence(__ATOMIC_ACQUIRE, "agent");
                phase_dn3(F, P, l, idx - extra, nb_na - extra); }
        }
        GRID_BAR();
        }
        EMU_STOP(l, 5);
#pragma unroll
        for (int rep_ = 0; rep_ < REP_ATT; ++rep_) {
        if (!chain_dedicated(F.G)) phase_dn3(F, P, l, F.bid, F.G);
        phase_attn<1>(F, P, l, true, !chain_dedicated(F.G), F.G, F.bid);
        phase_ftreduce(F, P, l, F.bid, F.G, !chain_dedicated(F.G), true);
        GRID_BAR();
        }
        EMU_STOP(l, 7);
        { SchedOut S{F.G, F.bid, 0, (const char*)wsp<bf16_t>(P, WS_MIX), (const char*)(wsp<bf16_t>(P, WS_WOUT) + (size_t)l * D * D)};
          EpiOut E{wsp<bf16_t>(P, WS_DMIX), wsp<float>(P, WS_MODL) + (size_t)l * NB * 6 * D + 2 * D, wsp<float>(P, WS_MODC) + (size_t)l * 6 * D + 2 * D};
          g8::gemm_phase<EpiOut, SchedOut, false>(F.lds, D, D, S, E); }
        GRID_BAR();
        EMU_STOP(l, 8);
        {
        const int nbc = last ? 0 : (F.G / 2 < 16 ? (F.G / 2 < 1 ? 1 : F.G / 2) : 16);
        unsigned* cnt = wsp<unsigned>(P, WS_CTL) + CW_OUTC + 64 * l;
        if (F.bid < nbc) {
            { SchedOut S{nbc, F.bid, 1, (const char*)wsp<bf16_t>(P, WS_MIX), (const char*)(wsp<bf16_t>(P, WS_WOUT) + (size_t)l * D * D)};
              EpiOut E{wsp<bf16_t>(P, WS_DMIX), wsp<float>(P, WS_MODL) + (size_t)l * NB * 6 * D + 2 * D, wsp<float>(P, WS_MODC) + (size_t)l * 6 * D + 2 * D};
              g8::gemm_phase<EpiOut, SchedOut, false>(F.lds, D, D, S, E); }
            WAIT_VM(0);
            __syncthreads();
            if (F.tid == 0) { __builtin_amdgcn_fence(__ATOMIC_RELEASE, "agent"); WAIT_VM(0); (void)xb_add(cnt, 1u); }
        }
        phase_norm2(F, P, l, nbc, cnt);
        GRID_BAR();
        }
        EMU_STOP(l, 9);
#pragma unroll
        for (int rep_ = 0; rep_ < REP_TOPK; ++rep_) {
        phase_topk(F, P, l);
        GRID_BAR();
        }
        EMU_STOP(l, 10);
        const int epan = (last ? EROWS_LAT_PAD : EROWS_PAD) / 256;
#pragma unroll
        for (int rep_ = 0; rep_ < REP_GU; ++rep_) {
        { SchedGU S{F.G, F.bid, epan, (const char*)wsp<bf16_t>(P, WS_H), (const char*)(wsp<bf16_t>(P, WS_WGU) + (size_t)l * NEXP * 2 * DEXP * D), wsp<int>(P, WS_RIDX)};
          EpiGU E{wsp<bf16_t>(P, WS_HID)};
          g8::gemm_phase<EpiGU, SchedGU, true>(F.lds, D, D, S, E); }
        GRID_BAR();
        }
        EMU_STOP(l, 11);
#pragma unroll
        for (int rep_ = 0; rep_ < REP_DOWN; ++rep_) {
        { SchedDown S{F.G, F.bid, epan, (const char*)wsp<bf16_t>(P, WS_HID), (const char*)(wsp<bf16_t>(P, WS_WD) + (size_t)l * NEXP * D * DEXP)};
          EpiDown E{wsp<bf16_t>(P, WS_Y), wsp<float>(P, WS_GATEV)};
          g8::gemm_phase<EpiDown, SchedDown, false>(F.lds, DEXP, DEXP, S, E); }
        GRID_BAR();
        }
        EMU_STOP(l, 12);
    }
    phase_norm1(F, P, DEPTH);
}

extern "C" void kernel_launch(void* const* d_in, const int* in_sizes, int n_in, void* d_out, int out_size, void* d_ws, size_t ws_size, hipStream_t stream) {
    static int grid = 0;
    if (grid == 0) {
        if (n_in != 23 || ws_size < WS_END) { fprintf(stderr, "kernel_launch: expected 23 inputs and >= %zu bytes of workspace (got %d, %zu)\n", (size_t)WS_END, n_in, ws_size); grid = -1; return; }
#ifdef EMU
        const char* g = getenv("EMU_GRID"); grid = g ? atoi(g) : 3;
#else
        int dev = 0, cus = 0;
        if (hipGetDevice(&dev) != hipSuccess || hipDeviceGetAttribute(&cus, hipDeviceAttributeMultiprocessorCount, dev) != hipSuccess) { grid = -1; return; }
        if (hipFuncSetAttribute((const void*)fwd_kernel, hipFuncAttributeMaxDynamicSharedMemorySize, LDS_BYTES) != hipSuccess) { fprintf(stderr, "kernel_launch: hipFuncSetAttribute failed\n"); grid = -1; return; }
        int per_cu = 0;
        if (hipOccupancyMaxActiveBlocksPerMultiprocessor(&per_cu, (const void*)fwd_kernel, 512, LDS_BYTES) != hipSuccess || per_cu < 1) fprintf(stderr, "kernel_launch: occupancy query says %d\n", per_cu);
        (void)hipGetLastError();
        grid = cus;
#endif
    }
    if (grid < 0) return;
    (void)in_sizes; (void)out_size;
    hipMemsetAsync((char*)d_ws + WS_CTL, 0, CTL_BYTES, stream);
    Params p{};
    for (int i = 0; i < 23; ++i) p.in[i] = (const float*)d_in[i];
    p.out = (float*)d_out; p.ws = (unsigned char*)d_ws;
#ifdef EMU
    emu::launch([=]() { fwd_kernel(p); }, grid, 512, LDS_BYTES);
#else
    hipLaunchKernelGGL(fwd_kernel, dim3(grid), dim3(512), LDS_BYTES, stream, p);
#endif
}
```

```cpp
#ifdef EMU
#include "emu.h"
#define LAS
#define WAIT_VM(n)
#define WAIT_LGKM(n) emu::rendezvous(nullptr, 0, [](emu::Wave*, int) {})
#define CFENCE()
#define LAUNDER_V(x)
#define LAUNDER_S(x)
#else
#include <hip/hip_runtime.h>
#include <cstdio>
#define LAS __attribute__((address_space(3)))
#define WAIT_VM(n) asm volatile("s_waitcnt vmcnt(" #n ")" ::: "memory")
#define WAIT_LGKM(n) asm volatile("s_waitcnt lgkmcnt(" #n ")" ::: "memory")
#define CFENCE() asm volatile("" ::: "memory")
#define LAUNDER_V(x) asm volatile("" : "+v"(x))
#define LAUNDER_S(x) asm volatile("" : "+s"(x))
#endif
#define DI __device__ __forceinline__

#ifndef CFG_BATCH
#define CFG_BATCH 4
#define CFG_SEQ 4096
#define CFG_CTX 256
#define CFG_DEPTH 4
#define CFG_NEXP 16
#define CFG_DEXP 2048
#define CFG_KS 4
#endif
constexpr int NB = CFG_BATCH, SEQ = CFG_SEQ, CTX = CFG_CTX, DEPTH = CFG_DEPTH, NEXP = CFG_NEXP, DEXP = CFG_DEXP, KSPLIT = CFG_KS;
constexpr int D = 1024, GW = 256, NH = 4, HD = 64, GRIDW = 64, GROWS = SEQ / GRIDW;
constexpr int IN_W = 11 * GW + 4 * NH;
constexpr int R_LAT = NB * SEQ, R_CTX = NB * CTX, RT = R_LAT + R_CTX;
constexpr int NTILE = 13, NPROJ = NTILE * 256;
constexpr int PLD = 12 * 256;
constexpr int CAP_LAT = 2 * SEQ / NEXP, CAP_CTX = 2 * CTX / NEXP;
constexpr int EROWS = NB * (CAP_LAT + CAP_CTX), EROWS_PAD = (EROWS + 255) / 256 * 256, EROWS_LAT_PAD = (NB * CAP_LAT + 255) / 256 * 256;
constexpr int NCC = CTX / 64, NCL = SEQ / 64, NCH = NCC + NCL, NUNIT = NB * NH * 2 * NCH;
constexpr int WH = GROWS < 8 ? GROWS : 8;
constexpr float RMS_EPS = 1e-6f;
constexpr float LOG2E = 1.4426950408889634f;
static_assert(R_LAT % 256 == 0 && R_CTX % 256 == 0 && SEQ % 256 == 0 && CTX % 256 == 0, "row panels");
constexpr int KCH = SEQ / KSPLIT;
constexpr int HSEQ = SEQ / 2;
static_assert(KCH % 128 == 0 && KCH >= 256 && HSEQ % 256 == 0 && DEXP % 128 == 0 && DEXP >= 256, "gemm K");

constexpr size_t al256(size_t x) { return (x + 255) / 256 * 256; }
constexpr size_t WS_CTL = 0, CTL_BYTES = 1u << 20;
constexpr size_t WS_MODL = WS_CTL + CTL_BYTES;
constexpr size_t WS_MODC = WS_MODL + al256((size_t)DEPTH * NB * 6 * D * 4);
constexpr size_t WS_ROPE = WS_MODC + al256((size_t)DEPTH * 6 * D * 4);
constexpr size_t WS_DFTL = WS_ROPE + al256((size_t)SEQ * 32 * 4);
constexpr size_t WS_DFTC = WS_DFTL + al256((size_t)SEQ * 2 * SEQ * 2);
constexpr size_t WS_WIN = WS_DFTC + al256((size_t)CTX * 2 * SEQ * 2);
constexpr size_t WS_WOUT = WS_WIN + al256((size_t)DEPTH * NPROJ * D * 2);
constexpr size_t WS_WGU = WS_WOUT + al256((size_t)DEPTH * D * D * 2);
constexpr size_t WS_WD = WS_WGU + al256((size_t)DEPTH * NEXP * 2 * DEXP * D * 2);
constexpr size_t WS_MZT = WS_WD + al256((size_t)DEPTH * NEXP * D * DEXP * 2);
constexpr size_t WS_WFT = WS_MZT + al256((size_t)DEPTH * 512 * 256 * 2);
constexpr size_t WS_XRES = WS_WFT + al256((size_t)DEPTH * D * 256 * 2);
constexpr size_t WS_H = WS_XRES + al256((size_t)RT * D * 4);
constexpr size_t WS_PROJ = WS_H + al256((size_t)RT * D * 2);
constexpr size_t WS_AB = WS_PROJ + al256((size_t)RT * PLD * 2);
constexpr size_t WS_DNP = WS_AB + al256((size_t)RT * 16 * 4);
constexpr size_t WS_GB = WS_DNP + al256((size_t)RT * 768 * 2);
constexpr size_t WS_AN = WS_GB + al256((size_t)RT * 16 * 4);
constexpr size_t WS_QE = WS_AN + al256((size_t)NUNIT * 8192);
constexpr size_t WS_SN = WS_QE + al256((size_t)NUNIT * 8192);
constexpr size_t WS_BN = WS_SN + al256((size_t)NUNIT * 8192);
constexpr size_t WS_OI = WS_BN + al256((size_t)NUNIT * 16384);
constexpr size_t WS_ZTL = WS_OI + al256((size_t)NUNIT * 16384);
constexpr size_t WS_ZTC = WS_ZTL + al256((size_t)NB * 256 * 2 * SEQ * 2);
constexpr size_t WS_SLAB = WS_ZTC + al256((size_t)NB * 256 * 2 * SEQ * 2);
constexpr size_t WS_SLABC = WS_SLAB + al256((size_t)KSPLIT * R_LAT * 256 * 4);
constexpr size_t WS_MIX = WS_SLABC + al256((size_t)R_CTX * 256 * 4);
constexpr size_t WS_AFF = WS_MIX + al256((size_t)RT * D * 2);
constexpr size_t WS_RIDX = WS_AFF + al256((size_t)RT * NEXP * 4);
constexpr size_t WS_GATEV = WS_RIDX + al256((size_t)NEXP * EROWS_PAD * 4);
constexpr size_t WS_INV = WS_GATEV + al256((size_t)NEXP * EROWS_PAD * 4);
constexpr size_t WS_DMIX = WS_PROJ;
constexpr size_t WS_HID = WS_INV + al256((size_t)RT * NEXP * 4);
constexpr size_t WS_Y = WS_HID + al256((size_t)NEXP * EROWS_PAD * DEXP * 2);
constexpr size_t WS_END = WS_Y + al256((size_t)NEXP * EROWS_PAD * D * 2);
constexpr int CW_CHC = 2048;
constexpr int CW_BAR = 4096;

constexpr int LDS_WORK = 131072;
constexpr int LDS_MISC = LDS_WORK;
constexpr int LDS_BYTES = 147456;

typedef unsigned short bf16_t;
typedef short bf16x8 __attribute__((ext_vector_type(8)));
typedef short s16x4 __attribute__((ext_vector_type(4)));
typedef float f32x2 __attribute__((ext_vector_type(2)));
typedef float f32x4 __attribute__((ext_vector_type(4)));
typedef float f32x16 __attribute__((ext_vector_type(16)));
typedef unsigned u32x2 __attribute__((ext_vector_type(2)));
typedef unsigned u32x4 __attribute__((ext_vector_type(4)));
typedef int i32x4 __attribute__((ext_vector_type(4)));

DI float bf2f(bf16_t b) { return __builtin_bit_cast(float, ((unsigned)b) << 16); }
DI float bflo(unsigned w) { return __builtin_bit_cast(float, w << 16); }
DI float bfhi(unsigned w) { return __builtin_bit_cast(float, w & 0xffff0000u); }
#ifdef EMU
DI unsigned pk2(float lo, float hi) { return (unsigned)emu::f2bf(lo) | ((unsigned)emu::f2bf(hi) << 16); }
#else
typedef __bf16 bf16x2v __attribute__((ext_vector_type(2)));
DI unsigned pk2(float lo, float hi) { f32x2 v = {lo, hi}; return __builtin_bit_cast(unsigned, __builtin_convertvector(v, bf16x2v)); }
#endif
DI bf16_t f2bf(float f) { return (bf16_t)(pk2(f, 0.f) & 0xffffu); }
DI float siluf(float x) { return x * __builtin_amdgcn_rcpf(1.0f + __expf(-x)); }
DI float wave_sum(float v) {
#pragma unroll
    for (int o = 1; o < 64; o <<= 1) v += __shfl_xor(v, o);
    return v;
}
DI int crow(int reg, int hh) { return (reg & 3) + 8 * (reg >> 2) + 4 * hh; }
DI f32x16 zero16() { f32x16 z; for (int i = 0; i < 16; ++i) z[i] = 0.f; return z; }
DI bf16x8 pack8(const f32x16& x, int s) {
    u32x4 p; p.x = pk2(x[8 * s], x[8 * s + 1]); p.y = pk2(x[8 * s + 2], x[8 * s + 3]); p.z = pk2(x[8 * s + 4], x[8 * s + 5]); p.w = pk2(x[8 * s + 6], x[8 * s + 7]);
    return __builtin_bit_cast(bf16x8, p);
}
DI bf16x8 cat44(u32x2 lo, u32x2 hi) { u32x4 p; p.x = lo.x; p.y = lo.y; p.z = hi.x; p.w = hi.y; return __builtin_bit_cast(bf16x8, p); }
#define MFMA32(a, b, c) __builtin_amdgcn_mfma_f32_32x32x16_bf16((a), (b), (c), 0, 0, 0)
#define MFMA16(a, b, c) __builtin_amdgcn_mfma_f32_16x16x32_bf16((a), (b), (c), 0, 0, 0)

#define XB_TMO      128
#define XB_XCNT(j)  (256  + 64 * (j))
#define XB_XSUB(j)  (1280 + 64 * (j))
#define XB_XGEN(j)  (2304 + 64 * (j))
#define XB_TOP      3328
#define XB_TOPGEN   3392
#define XCD_BAR_WORDS 3456
#define XB_SPIN_CAP (1u << 18)
DI unsigned xb_ld(unsigned* p)              { return __hip_atomic_load(p, __ATOMIC_RELAXED, __HIP_MEMORY_SCOPE_AGENT); }
DI unsigned xb_add(unsigned* p, unsigned v) { return __hip_atomic_fetch_add(p, v, __ATOMIC_RELAXED, __HIP_MEMORY_SCOPE_AGENT); }
DI unsigned xb_xcc_id() { return (unsigned)__builtin_amdgcn_s_getreg((3 << 11) | 20) & 0xFu; }
#define XB_SPIN(cond, bar) do { unsigned _sp = 0; while (cond) { __builtin_amdgcn_s_sleep(1); \
    if ((++_sp & 255u) == 0u) { if (xb_ld(&(bar)[XB_TMO])) break; if (_sp > XB_SPIN_CAP) { atomicAdd(&(bar)[XB_TMO], 1u); break; } } } } while (0)
struct XcdBarrier { unsigned* bar; unsigned x; volatile LAS unsigned* st; };
DI XcdBarrier xcd_barrier_post(unsigned* bar, volatile LAS unsigned* st) {
    XcdBarrier b; b.bar = bar; b.x = (unsigned)__builtin_amdgcn_readfirstlane((int)xb_xcc_id()); b.st = st;
    if (threadIdx.x == 0) (void)xb_add(&bar[XB_XCNT(b.x)], 1u);
    return b;
}
DI void xcd_barrier_complete(unsigned* bar, unsigned x, unsigned& nloc, unsigned& nx) {
    const unsigned G = gridDim.x * gridDim.y * gridDim.z;
    unsigned sum, cnt, mine, sp = 0u;
    for (;;) {
        sum = 0u; cnt = 0u; mine = 0u;
#pragma unroll
        for (unsigned j = 0; j < 16; ++j) { const unsigned c = xb_ld(&bar[XB_XCNT(j)]); sum += c; cnt += (c > 0u) ? 1u : 0u; mine = (j == x) ? c : mine; }
        if (sum == G) break;
        __builtin_amdgcn_s_sleep(1);
        if ((++sp & 255u) == 0u) { if (xb_ld(&bar[XB_TMO])) break; if (sp > XB_SPIN_CAP) { atomicAdd(&bar[XB_TMO], 1u); break; } }
    }
    nloc = mine > 0u ? mine : 1u; nx = cnt > 0u ? cnt : 1u;
}
DI void xcd_barrier(const XcdBarrier& b) {
    WAIT_VM(0);
    __syncthreads();
    unsigned* bar = b.bar; unsigned bx = b.x; LAUNDER_S(bar); LAUNDER_S(bx);
    if (threadIdx.x == 0) {
        __builtin_amdgcn_s_waitcnt(0);
        unsigned nloc = b.st[0], nx = b.st[1];
        if (nloc == 0u) { xcd_barrier_complete(bar, bx, nloc, nx); b.st[0] = nloc; b.st[1] = nx; }
        const unsigned old = xb_add(&bar[XB_XSUB(bx)], 1u);
        const unsigned gen = old / nloc;
        if (old + 1u == (gen + 1u) * nloc) {
            __builtin_amdgcn_fence(__ATOMIC_RELEASE, "agent");
            WAIT_VM(0);
            const unsigned og = xb_add(&bar[XB_TOP], 1u);
            const unsigned tg = og / nx;
            if (og + 1u == (tg + 1u) * nx) xb_add(&bar[XB_TOPGEN], 1u);
            else XB_SPIN(xb_ld(&bar[XB_TOPGEN]) == tg, bar);
            __builtin_amdgcn_fence(__ATOMIC_ACQUIRE, "agent");
            xb_add(&bar[XB_XGEN(bx)], 1u);
            WAIT_VM(0);
        } else {
            XB_SPIN(xb_ld(&bar[XB_XGEN(bx)]) == gen, bar);
            __builtin_amdgcn_fence(__ATOMIC_ACQUIRE, "agent");
            WAIT_VM(0);
        }
    }
    __syncthreads();
}

#ifndef G8_SP2
#define G8_SP2 true
#endif
#ifndef G8_ALIGN_W
#define G8_ALIGN_W false
#endif
#ifndef G8_ALIGN_PROJ
#define G8_ALIGN_PROJ true
#endif
#ifndef G8_ALIGN_OUT
#define G8_ALIGN_OUT true
#endif
#ifndef G8_ALIGN_DFT
#define G8_ALIGN_DFT true
#endif
#ifndef G8_ALIGN_GU
#define G8_ALIGN_GU true
#endif
#ifndef G8_ALIGN_DOWN
#define G8_ALIGN_DOWN true
#endif
namespace g8 {
constexpr int BM = 256, BK = 64, HALF = 128, HTB = HALF * BK * 2, STAGE_BYTES = 8 * HTB;
DI int lds_byte(int r, int c) { const int st = (r >> 4) * 2 + (c >> 5), rr = r & 15, cc = c & 31, ob = rr * 64 + cc * 2; return st * 1024 + (ob ^ (((ob >> 9) & 1) << 5)); }
DI void stage_rc(int b, int& R, int& C) { const int st = b / 1024, sb = b % 1024, swz = sb ^ (((sb >> 9) & 1) << 5); R = (st >> 1) * 16 + swz / 64; C = (st & 1) * 32 + (swz % 64) / 2; }
DI int perm32(int rho) { const int n = rho >> 4, i = rho & 15; return 8 * (i >> 2) + 4 * n + (i & 3); }
struct Unit { const char* A; const char* B; const int* gidx; int pm, pn, aux, nt, half; };

template <class Epi, class Sched, bool GATHER>
DI void gemm_phase(LAS unsigned char* lds, const int lda, const int ldb, const Sched& S, const Epi& E) {
    int tid = threadIdx.x; LAUNDER_V(tid);
    const int wid = __builtin_amdgcn_readfirstlane(tid >> 6), lane = tid & 63, wr = wid >> 2, wc = wid & 3, fr = lane & 15, fq = lane >> 4;
    int Rr[2], Cc[2]; unsigned voffB[2];
#pragma unroll
    for (int i = 0; i < 2; ++i) { stage_rc(tid * 16 + i * 8192, Rr[i], Cc[i]); const int Rb = Epi::PERM ? ((Rr[i] & ~31) + perm32(Rr[i] & 31)) : Rr[i]; voffB[i] = (unsigned)(Rb * ldb + Cc[i]) * 2u; }
    const size_t kstep = (size_t)(BK * 2);
    const size_t hstepB = (size_t)HALF * ldb * 2;
    const unsigned ldsw = (unsigned)wid * 1024u;
    const int aoff = lds_byte(wr * 64 + fr, fq * 8), boff = lds_byte(wc * 32 + fr, fq * 8);
#define G8_SA(b, h) (((b) * 2 + (h)) * HTB)
#define G8_SB(b, h) ((4 + (b) * 2 + (h)) * HTB)
#define G8_STAGE(bufoff, gbase, v0, v1) do { \
        __builtin_amdgcn_global_load_lds((const unsigned*)((const char*)(gbase) + (v0)), (LAS unsigned*)(lds + (bufoff) + ldsw), 16, 0, 0); \
        __builtin_amdgcn_global_load_lds((const unsigned*)((const char*)(gbase) + (v1)), (LAS unsigned*)(lds + (bufoff) + ldsw + 8192), 16, 0, 0); } while (0)
#define G8_STAGE_B(bufoff, gbase) G8_STAGE(bufoff, gbase, voffB[0], voffB[1])
#define G8_LDA(dst, b, h) do { _Pragma("unroll") for (int m = 0; m < 4; ++m) _Pragma("unroll") for (int k = 0; k < 2; ++k) dst[m][k] = *(const LAS bf16x8*)(lds + G8_SA(b, h) + aoff + m * 2048 + k * 1024); } while (0)
#define G8_LDB(dst, b, h) do { _Pragma("unroll") for (int n = 0; n < 2; ++n) _Pragma("unroll") for (int k = 0; k < 2; ++k) dst[n][k] = *(const LAS bf16x8*)(lds + G8_SB(b, h) + boff + n * 2048 + k * 1024); } while (0)
#define G8_MMA(ai, bj, At, Bt) do { __builtin_amdgcn_s_setprio(1); _Pragma("unroll") for (int m = 0; m < 4; ++m) _Pragma("unroll") for (int n = 0; n < 2; ++n) _Pragma("unroll") for (int k = 0; k < 2; ++k) \
        acc[ai][bj][m][n] = MFMA16(Bt[n][k], At[m][k], acc[ai][bj][m][n]); __builtin_amdgcn_s_setprio(0); } while (0)
#define G8_BAR __builtin_amdgcn_s_barrier()
#define G8_SCHED __builtin_amdgcn_sched_barrier(0)
#define G8_VA(u, V) do { _Pragma("unroll") for (int h = 0; h < 2; ++h) _Pragma("unroll") for (int i = 0; i < 2; ++i) { \
        const int rr = GATHER ? (u).gidx[h * HALF + Rr[i]] : (h * HALF + Rr[i]); V[h][i] = (unsigned)(rr * lda + Cc[i]) * 2u; } } while (0)
    Unit cur, nxt; int ui = 0;
    if (!S.next(0, cur)) return;
    f32x4 acc[2][2][4][2];
#pragma unroll
    for (int a = 0; a < 2; ++a)
#pragma unroll
        for (int b = 0; b < 2; ++b)
#pragma unroll
            for (int m = 0; m < 4; ++m)
#pragma unroll
                for (int n = 0; n < 2; ++n) acc[a][b][m][n] = (f32x4){0.f, 0.f, 0.f, 0.f};
    bf16x8 At[4][2], B0[2][2], B1[2][2];
    unsigned vaC[2][2], vaN[2][2];
    G8_VA(cur, vaC);
    const char* cA = cur.A; const char* cB = cur.B;
    if constexpr (G8_SP2) {
        G8_STAGE_B(G8_SB(0, 0), cB); G8_STAGE_B(G8_SB(0, 1), cB + hstepB); G8_STAGE(G8_SA(0, 0), cA, vaC[0][0], vaC[0][1]); G8_STAGE(G8_SA(0, 1), cA, vaC[1][0], vaC[1][1]);
        if (wr == 1) G8_BAR;
        WAIT_VM(2); G8_BAR;
    } else {
        G8_STAGE_B(G8_SB(0, 0), cB); G8_STAGE(G8_SA(0, 0), cA, vaC[0][0], vaC[0][1]); G8_STAGE_B(G8_SB(0, 1), cB + hstepB); G8_STAGE(G8_SA(0, 1), cA, vaC[1][0], vaC[1][1]);
        if (wr == 1) G8_BAR;
        WAIT_VM(4); G8_BAR;
    }
    G8_STAGE_B(G8_SB(1, 0), cB + kstep); G8_STAGE(G8_SA(1, 0), cA + kstep, vaC[0][0], vaC[0][1]); G8_STAGE_B(G8_SB(1, 1), cB + hstepB + kstep);
    WAIT_VM(6); G8_BAR;
    for (;;) {
        const bool has_next = S.next(ui + 1, nxt);
        const int nt = cur.nt; const bool hf = cur.half != 0;
        const char* nA = has_next ? nxt.A : cA; const char* nB = has_next ? nxt.B : cB;
        if (GATHER) { if (has_next) { G8_VA(nxt, vaN); } else {
#pragma unroll
            for (int h = 0; h < 2; ++h)
#pragma unroll
                for (int i = 0; i < 2; ++i) vaN[h][i] = vaC[h][i]; } }
        for (int t = 0; t < nt; t += 2) {
            const bool last = (t == nt - 2);
            const char* a1 = cA + (size_t)(t + 1) * kstep;
            const char* a2 = last ? nA : cA + (size_t)(t + 2) * kstep; const char* b2 = last ? nB : cB + (size_t)(t + 2) * kstep;
            const char* a3 = a2 + kstep; const char* b3 = b2 + kstep;
            unsigned x00, x01, x10, x11;
            if (GATHER) { x00 = last ? vaN[0][0] : vaC[0][0]; x01 = last ? vaN[0][1] : vaC[0][1]; x10 = last ? vaN[1][0] : vaC[1][0]; x11 = last ? vaN[1][1] : vaC[1][1]; }
            else { x00 = vaC[0][0]; x01 = vaC[0][1]; x10 = vaC[1][0]; x11 = vaC[1][1]; }
            if constexpr (G8_SP2) {
            G8_LDB(B0, 0, 0); G8_LDB(B1, 0, 1); G8_SCHED; G8_LDA(At, 0, 0); G8_STAGE(G8_SA(1, 1), a1, vaC[1][0], vaC[1][1]);
            WAIT_VM(8); WAIT_LGKM(0); G8_BAR; G8_MMA(0, 0, At, B0); G8_MMA(0, 1, At, B1); G8_BAR; G8_SCHED;
            G8_LDA(At, 0, 1); G8_STAGE_B(G8_SB(0, 0), b2); G8_STAGE_B(G8_SB(0, 1), b2 + hstepB); G8_STAGE(G8_SA(0, 0), a2, x00, x01);
            WAIT_VM(8); WAIT_LGKM(0); G8_BAR; if (!hf) { G8_MMA(1, 0, At, B0); G8_MMA(1, 1, At, B1); } G8_BAR; G8_SCHED;
            G8_LDB(B0, 1, 0); G8_LDB(B1, 1, 1); G8_SCHED; G8_LDA(At, 1, 0); G8_STAGE(G8_SA(0, 1), a2, x10, x11);
            WAIT_VM(8); WAIT_LGKM(0); G8_BAR; G8_MMA(0, 0, At, B0); G8_MMA(0, 1, At, B1); G8_BAR; G8_SCHED;
            G8_LDA(At, 1, 1); G8_STAGE_B(G8_SB(1, 0), b3); G8_STAGE_B(G8_SB(1, 1), b3 + hstepB); G8_STAGE(G8_SA(1, 0), a3, x00, x01);
            WAIT_VM(8); WAIT_LGKM(0); G8_BAR; if (!hf) { G8_MMA(1, 0, At, B0); G8_MMA(1, 1, At, B1); } G8_BAR; G8_SCHED;
            } else {
            G8_LDB(B0, 0, 0); G8_SCHED; G8_LDA(At, 0, 0); G8_STAGE(G8_SA(1, 1), a1, vaC[1][0], vaC[1][1]);
            WAIT_LGKM(8); G8_BAR; WAIT_LGKM(0); G8_MMA(0, 0, At, B0); G8_BAR; G8_SCHED;
            G8_LDB(B1, 0, 1); G8_STAGE_B(G8_SB(0, 0), b2);
            G8_BAR; WAIT_LGKM(0); G8_MMA(0, 1, At, B1); G8_BAR;
            G8_LDA(At, 0, 1); G8_STAGE(G8_SA(0, 0), a2, x00, x01);
            G8_BAR; WAIT_LGKM(0); if (!hf) G8_MMA(1, 0, At, B0); G8_BAR; G8_SCHED;
            G8_STAGE_B(G8_SB(0, 1), b2 + hstepB);
            WAIT_VM(6); G8_BAR; if (!hf) G8_MMA(1, 1, At, B1); G8_BAR;
            G8_LDB(B0, 1, 0); G8_SCHED; G8_LDA(At, 1, 0); G8_STAGE(G8_SA(0, 1), a2, x10, x11);
            WAIT_LGKM(8); G8_BAR; WAIT_LGKM(0); G8_MMA(0, 0, At, B0); G8_BAR; G8_SCHED;
            G8_LDB(B1, 1, 1); G8_STAGE_B(G8_SB(1, 0), b3);
            G8_BAR; WAIT_LGKM(0); G8_MMA(0, 1, At, B1); G8_BAR;
            G8_LDA(At, 1, 1); G8_STAGE(G8_SA(1, 0), a3, x00, x01);
            G8_BAR; WAIT_LGKM(0); if (!hf) G8_MMA(1, 0, At, B0); G8_BAR; G8_SCHED;
            G8_STAGE_B(G8_SB(1, 1), b3 + hstepB);
            WAIT_VM(6); G8_BAR; if (!hf) G8_MMA(1, 1, At, B1); G8_BAR;
            }
        }
        if constexpr (Epi::ALIGN) { if (wr == 0) G8_BAR; }
        E(acc, cur, wr, wc, fr, fq);
        if (!has_next) break;
#pragma unroll
        for (int a = 0; a < 2; ++a)
#pragma unroll
            for (int b = 0; b < 2; ++b)
#pragma unroll
                for (int m = 0; m < 4; ++m)
#pragma unroll
                    for (int n = 0; n < 2; ++n) acc[a][b][m][n] = (f32x4){0.f, 0.f, 0.f, 0.f};
        cur = nxt; cA = nA; cB = nB; ++ui;
        if (GATHER) {
#pragma unroll
            for (int h = 0; h < 2; ++h)
#pragma unroll
                for (int i = 0; i < 2; ++i) vaC[h][i] = vaN[h][i]; }
        if constexpr (Epi::ALIGN) { if (wr == 1) G8_BAR; }
    }
    WAIT_VM(0);
    if constexpr (!Epi::ALIGN) { if (wr == 0) G8_BAR; }
    G8_BAR;
#undef G8_SA
#undef G8_SB
#undef G8_STAGE
#undef G8_STAGE_B
#undef G8_LDA
#undef G8_LDB
#undef G8_MMA
#undef G8_BAR
#undef G8_SCHED
#undef G8_VA
}
}

struct Params { const float* in[23]; float* out; unsigned char* ws; };
enum { I_X = 0, I_C, I_CTX, I_CCTX, I_WMOD, I_BMOD, I_N1G, I_WIN, I_RPB, I_CONVW, I_ALOG, I_DTB, I_DNG, I_DFLAM, I_DFG, I_FTW, I_WOUT, I_N2G, I_WR, I_WG, I_WU, I_WDN, I_FNG };
struct Frame { LAS unsigned char* lds; int tid, lane, wave, G, bid, gw, ngw; };
template <class T> DI T* wsp(const Params& P, size_t off) { return (T*)(P.ws + off); }
DI Frame relaunder(const Frame& F0) { Frame F = F0; LAUNDER_V(F.tid); F.lane = F.tid & 63; F.wave = __builtin_amdgcn_readfirstlane(F.tid >> 6); LAUNDER_S(F.bid); F.gw = F.wave * F.G + F.bid; return F; }
DI float cospi_(float x) { return cosf(3.14159265358979323846f * x); }
DI float sinpi_(float x) { return sinf(3.14159265358979323846f * x); }

struct TItem { const float* src; bf16_t* dst; int ldw, ldt; };
DI TItem p0_decode(const Params& P, int it) {
    constexpr int I_WINc = 10 * 16 * 8, I_ABc = 16, I_WOUTc = 16 * 32, I_Gc = NEXP * 16 * (DEXP / 32), I_Dc = NEXP * (DEXP / 64) * 32;
    constexpr int I_LAYER = I_WINc + I_ABc + I_WOUTc + 2 * I_Gc + I_Dc;
    bf16_t* WinT = wsp<bf16_t>(P, WS_WIN); bf16_t* WoutT = wsp<bf16_t>(P, WS_WOUT); bf16_t* WguT = wsp<bf16_t>(P, WS_WGU); bf16_t* WdT = wsp<bf16_t>(P, WS_WD);
    const int l = it / I_LAYER; int r = it % I_LAYER; TItem t;
    const float* w_in = P.in[I_WIN] + (size_t)l * D * IN_W;
    if (r < I_WINc) { const int g = r / 128, rr = r % 128, kb = ((rr >> 2) / 8) * 4 + (rr & 3), nb = (rr >> 2) % 8; const int so = 256 * g + (g >= 6 ? 16 : 0);
        t.src = w_in + so + nb * 32 + (size_t)64 * kb * IN_W; t.ldw = IN_W; t.dst = WinT + ((size_t)l * NPROJ + g * 256 + nb * 32) * D + 64 * kb; t.ldt = D; return t; }
    r -= I_WINc;
    if (r < I_ABc) { t.src = w_in + 1536 + (size_t)64 * r * IN_W; t.ldw = IN_W; t.dst = WinT + ((size_t)l * NPROJ + 12 * 256) * D + 64 * r; t.ldt = D; return t; }
    r -= I_ABc;
    if (r < I_WOUTc) { const int kb = ((r >> 2) / 32) * 4 + (r & 3), nb = (r >> 2) % 32; t.src = P.in[I_WOUT] + (size_t)l * D * D + nb * 32 + (size_t)64 * kb * D; t.ldw = D; t.dst = WoutT + ((size_t)l * D + nb * 32) * D + 64 * kb; t.ldt = D; return t; }
    r -= I_WOUTc;
    if (r < 2 * I_Gc) { const int up = r >= I_Gc; if (up) r -= I_Gc; const int e = r / (16 * (DEXP / 32)), rr = r % (16 * (DEXP / 32)), kb = ((rr >> 2) / (DEXP / 32)) * 4 + (rr & 3), nb = (rr >> 2) % (DEXP / 32), f0 = 32 * nb;
        t.src = P.in[up ? I_WU : I_WG] + ((size_t)l * NEXP + e) * D * DEXP + f0 + (size_t)64 * kb * DEXP; t.ldw = DEXP;
        t.dst = WguT + (((size_t)l * NEXP + e) * 2 * DEXP + (f0 / 128) * 256 + up * 128 + (f0 % 128)) * D + 64 * kb; t.ldt = D; return t; }
    r -= 2 * I_Gc;
    { const int e = r / ((DEXP / 64) * 32), rr = r % ((DEXP / 64) * 32), kb = ((rr >> 2) / 32) * 4 + (rr & 3), nb = (rr >> 2) % 32;
        t.src = P.in[I_WDN] + ((size_t)l * NEXP + e) * DEXP * D + nb * 32 + (size_t)64 * kb * D; t.ldw = D; t.dst = WdT + (((size_t)l * NEXP + e) * D + nb * 32) * DEXP + 64 * kb; t.ldt = DEXP; }
    return t;
}
DI void p0_weights(const Frame& F0, const Params& P) {
    const Frame F = relaunder(F0);
    LAS float* scr = (LAS float*)(F.lds + F.wave * 8448);
    constexpr int I_LAYER = 10 * 16 * 8 + 16 + 16 * 32 + 2 * NEXP * 16 * (DEXP / 32) + NEXP * (DEXP / 64) * 32, NIT = DEPTH * I_LAYER;
    const int lane = F.lane, lr = lane >> 3, lc = lane & 7;
    f32x4 va[8], vb[8];
#define P0_LOAD(dst_, it_) do { const int itc_ = (it_) < NIT ? (it_) : F.gw; const TItem tl_ = p0_decode(P, itc_); _Pragma("unroll") for (int i = 0; i < 8; ++i) dst_[i] = *(const f32x4*)(tl_.src + (size_t)(8 * i + lr) * tl_.ldw + 4 * lc); } while (0)
#define P0_ITEM(src_, it_, nx_) do { const TItem t_ = p0_decode(P, (it_)); \
        _Pragma("unroll") for (int i = 0; i < 8; ++i) { LAS float* s = scr + (8 * i + lr) * 33 + 4 * lc; s[0] = src_[i].x; s[1] = src_[i].y; s[2] = src_[i].z; s[3] = src_[i].w; } \
        P0_LOAD(src_, (nx_)); \
        WAIT_LGKM(0); CFENCE(); \
        _Pragma("unroll") for (int j = 0; j < 4; ++j) { const int n = lr + 8 * j; const LAS float* s = scr + (8 * lc) * 33 + n; \
            u32x4 o; o.x = pk2(s[0 * 33], s[1 * 33]); o.y = pk2(s[2 * 33], s[3 * 33]); o.z = pk2(s[4 * 33], s[5 * 33]); o.w = pk2(s[6 * 33], s[7 * 33]); \
            *(u32x4*)(t_.dst + (size_t)n * t_.ldt + 8 * lc) = o; } \
        WAIT_LGKM(0); CFENCE(); } while (0)
#define P0_SEQ(j_) ((F.gw + ((j_) >> 2) * F.ngw) * 4 + ((j_) & 3))
    if (P0_SEQ(0) < NIT) { P0_LOAD(va, P0_SEQ(0)); P0_LOAD(vb, P0_SEQ(1)); }
    for (int j = 0; P0_SEQ(j) < NIT; j += 2) {
        P0_ITEM(va, P0_SEQ(j), P0_SEQ(j + 2));
        if (P0_SEQ(j + 1) < NIT) P0_ITEM(vb, P0_SEQ(j + 1), P0_SEQ(j + 3));
    }
#undef P0_SEQ
#undef P0_LOAD
#undef P0_ITEM
}
DI void p0_mod(const Frame& F0, const Params& P) {
    const Frame F = relaunder(F0);
    LAS float* sv = (LAS float*)F.lds;
    LAS f32x2* red = (LAS f32x2*)(sv + (NB + 1) * D);
    float* modL = wsp<float>(P, WS_MODL); float* modC = wsp<float>(P, WS_MODC);
    for (int i = F.tid; i < (NB + 1) * D; i += 512) { const int s = i / D, k = i % D; sv[i] = siluf(s < NB ? P.in[I_C][s * D + k] : P.in[I_CCTX][k]); }
    __syncthreads();
    for (int it = F.bid; it < DEPTH * 48; it += F.G) {
        const int l = it / 48, n = (it % 48) * 128 + 2 * F.lane;
        const float* wm = P.in[I_WMOD] + (size_t)l * D * 6 * D + n;
        f32x2 acc[NB + 1];
#pragma unroll
        for (int s = 0; s <= NB; ++s) acc[s] = (f32x2){0.f, 0.f};
        for (int k0 = F.wave * 128; k0 < F.wave * 128 + 128; k0 += 16) { f32x2 w[16];
#pragma unroll
            for (int i = 0; i < 16; ++i) w[i] = *(const f32x2*)(wm + (size_t)(k0 + i) * 6 * D);
#pragma unroll
            for (int i = 0; i < 16; ++i)
#pragma unroll
                for (int s = 0; s <= NB; ++s) acc[s] += w[i] * sv[s * D + k0 + i]; }
#pragma unroll
        for (int s = 0; s <= NB; ++s) red[(F.wave * (NB + 1) + s) * 64 + F.lane] = acc[s];
        __syncthreads();
        if (F.tid < (NB + 1) * 64) { const int s = F.tid / 64, ln = F.tid % 64; f32x2 v = {0.f, 0.f};
            for (int w = 0; w < 8; ++w) v += red[(w * (NB + 1) + s) * 64 + ln];
            const int nn = (it % 48) * 128 + 2 * ln; v += *(const f32x2*)(P.in[I_BMOD] + (size_t)l * 6 * D + nn);
            *(f32x2*)((s < NB ? modL + ((size_t)l * NB + s) * 6 * D : modC + (size_t)l * 6 * D) + nn) = v; }
        __syncthreads();
    }
}
DI void p0_misc(const Frame& F0, const Params& P) {
    const Frame F = relaunder(F0);
    const size_t gt = (size_t)F.bid * 512 + F.tid, ngt = (size_t)F.G * 512;
    { float* rope = wsp<float>(P, WS_ROPE);
      for (size_t i = gt; i < (size_t)SEQ * 16; i += ngt) { const int t = (int)(i / 16), p = (int)(i % 16); const float pos = (p < 8) ? (float)(t / GRIDW) : (float)(t % GRIDW);
          const float inv = exp2f(-(float)(p & 7) * (13.287712379549449f / 8.0f));     const float ang = pos * inv; rope[2 * i] = cosf(ang); rope[2 * i + 1] = sinf(ang); } }
    { LAS float* ct = (LAS float*)F.lds;
      for (int m = F.tid; m < SEQ; m += 512) ct[m] = cospi_(2.0f * (float)m / (float)SEQ);
      __syncthreads();
      bf16_t* dl = wsp<bf16_t>(P, WS_DFTL); const float sc = 1.0f / sqrtf((float)SEQ);
      for (size_t i = gt; i < (size_t)(HSEQ + 1) * SEQ / 2; i += ngt) { const int k = (int)(i / (SEQ / 2)), t = 2 * (int)(i % (SEQ / 2));     const int m0 = (int)(((long long)k * t) % SEQ), m1 = (m0 + k) % SEQ;
          *(unsigned*)(dl + (size_t)k * 2 * SEQ + t) = pk2(ct[m0] * sc, ct[m1] * sc);
          *(unsigned*)(dl + (size_t)k * 2 * SEQ + SEQ + t) = pk2(ct[(m0 + 3 * SEQ / 4) % SEQ] * sc, ct[(m1 + 3 * SEQ / 4) % SEQ] * sc); }
      bf16_t* dc = wsp<bf16_t>(P, WS_DFTC); const float scc = 1.0f / sqrtf((float)CTX); constexpr int STEP = SEQ / CTX;
      for (size_t i = gt; i < (size_t)CTX * 2 * CTX; i += ngt) { const int k = (int)(i / (2 * CTX)), c = (int)(i % (2 * CTX)), t = c % CTX; const int m = ((k * t) % CTX) * STEP;
          dc[(size_t)k * 2 * SEQ + c] = f2bf((c < CTX ? ct[m] : ct[(m + 3 * SEQ / 4) % SEQ]) * scc); }
      __syncthreads(); }
    { bf16_t* mz = wsp<bf16_t>(P, WS_MZT);
      for (size_t i = gt; i < (size_t)DEPTH * 512 * 256; i += ngt) { const int l = (int)(i / (512 * 256)), np = (int)((i / 256) % 512), c = (int)(i % 256); const int n = np & 255, g0 = c & ~63;
          const float* fw = P.in[I_FTW] + (size_t)l * 256 * 256; float a = 0.f;
          for (int j = 0; j < 64; ++j) { const int m = ((c & 63) * j) & 63; const float x = 2.0f * (float)m / 64.0f; const float tr = (np < 256) ? cospi_(x) : -sinpi_(x); a += tr * fw[(size_t)(g0 + j) * 256 + n]; }
          mz[i] = f2bf(a * 0.125f); }
      bf16_t* wf = wsp<bf16_t>(P, WS_WFT);
      for (size_t i = gt; i < (size_t)DEPTH * D * 256; i += ngt) { const int l = (int)(i / (D * 256)), k = (int)((i / 256) % D), c = (int)(i % 256); wf[i] = f2bf(P.in[I_WIN][((size_t)l * D + k) * IN_W + 2576 + c]); } }
    { int* ridx = wsp<int>(P, WS_RIDX); for (size_t i = gt; i < (size_t)NEXP * EROWS_PAD; i += ngt) ridx[i] = 0; }
}

DI void phase_norm1(const Frame& F0, const Params& P, const int l) {
    const Frame F = relaunder(F0);
    float* xres = wsp<float>(P, WS_XRES); bf16_t* hb = wsp<bf16_t>(P, WS_H);
    const int* inv = wsp<int>(P, WS_INV); const bf16_t* yb = wsp<bf16_t>(P, WS_Y);
    const float* modL = wsp<float>(P, WS_MODL); const float* modC = wsp<float>(P, WS_MODC);
    const bool fin = (l == DEPTH);
    const int nrows = fin ? R_LAT : RT;
    const int R1 = (nrows + F.ngw - 1) / F.ngw;
    if (F.gw * R1 >= nrows) return;
    const int rend = (F.gw * R1 + R1 < nrows) ? F.gw * R1 + R1 : nrows;
    constexpr int NSL = 4;
#define N1_XSRC(r_) ((l <= 1) ? (const f32x4*)((r_) < R_LAT ? P.in[I_X] + (size_t)(r_) * D : P.in[I_CTX] + (size_t)((r_) - R_LAT) * D) + F.lane : (const f32x4*)(xres + (size_t)(r_) * D) + F.lane)
#define N1_LDINV(r_) do { const i32x4* ip_ = (const i32x4*)(inv + (size_t)(r_) * NEXP); _Pragma("unroll") for (int q_ = 0; q_ < NEXP / 4; ++q_) ivv[q_] = ip_[q_]; } while (0)
#define N1_ISSUE(r_) do { \
        _Pragma("unroll") for (int k_ = 0; k_ < NSL; ++k_) sl[k_] = -1; \
        if (l > 0) { int cnt_ = 0; \
            _Pragma("unroll") for (int e_ = 0; e_ < NEXP; ++e_) { const int ix_ = __builtin_amdgcn_readfirstlane(ivv[e_ >> 2][e_ & 3]); \
                if (ix_ >= 0) { _Pragma("unroll") for (int k_ = 0; k_ < NSL; ++k_) sl[k_] = (cnt_ == k_) ? ix_ : sl[k_]; ++cnt_; } } \
            nsel = cnt_; } \
        { const f32x4* xs_ = N1_XSRC(r_); _Pragma("unroll") for (int j_ = 0; j_ < 4; ++j_) xn[j_] = xs_[64 * j_]; } \
        if (l > 0) { const u32x2* dm_ = (const u32x2*)(dmix + (size_t)(r_) * D) + F.lane; _Pragma("unroll") for (int j_ = 0; j_ < 4; ++j_) dn[j_] = dm_[64 * j_]; } \
        if (l > 0) { _Pragma("unroll") for (int k_ = 0; k_ < NSL; ++k_) { const u32x2* yr_ = (const u32x2*)(yb + (size_t)(sl[k_] < 0 ? 0 : sl[k_]) * D) + F.lane; \
            _Pragma("unroll") for (int j_ = 0; j_ < 4; ++j_) yn[k_][j_] = yr_[64 * j_]; } } } while (0)
    const bf16_t* dmix = wsp<bf16_t>(P, WS_DMIX);
    i32x4 ivv[NEXP / 4]; int sl[NSL], nsel = 0; f32x4 xn[4]; u32x2 yn[NSL][4]; u32x2 dn[4];
    int row = F.gw * R1;
    if (l > 0) N1_LDINV(row);
    N1_ISSUE(row);
    { const int r1 = row + 1 < rend ? row + 1 : row; if (l > 0) N1_LDINV(r1); }
    f32x4 mg5[4], mgn[4], msh[4], mscl[4]; int bkey = -2;
    { const f32x4* g = (fin ? (const f32x4*)P.in[I_FNG] : (const f32x4*)(P.in[I_N1G] + (size_t)l * D)) + F.lane;
#pragma unroll
      for (int j = 0; j < 4; ++j) mgn[j] = g[64 * j]; }
    for (; row < rend; ++row) {
        const bool lat = row < R_LAT; const int b = lat ? row / SEQ : 0;
        if ((lat ? b : -1) != bkey) { bkey = lat ? b : -1;
            if (l > 0) { const float* mp = (lat ? modL + ((size_t)(l - 1) * NB + b) * 6 * D : modC + (size_t)(l - 1) * 6 * D) + 5 * D;
#pragma unroll
                for (int j = 0; j < 4; ++j) mg5[j] = *((const f32x4*)mp + F.lane + 64 * j); }
            if (!fin) { const float* mp = lat ? modL + ((size_t)l * NB + b) * 6 * D : modC + (size_t)l * 6 * D;
#pragma unroll
                for (int j = 0; j < 4; ++j) { msh[j] = *((const f32x4*)mp + F.lane + 64 * j); mscl[j] = *((const f32x4*)(mp + D) + F.lane + 64 * j); } } }
        f32x4* xr = (f32x4*)(xres + (size_t)row * D) + F.lane;
        f32x4 v[4]; u32x2 y[NSL][4]; int sc[NSL]; const int nc = nsel;
#pragma unroll
        for (int j = 0; j < 4; ++j) { v[j] = xn[j]; if (l > 0) { const u32x2 w = dn[j]; v[j] += (f32x4){bflo(w.x), bfhi(w.x), bflo(w.y), bfhi(w.y)}; } }
#pragma unroll
        for (int k = 0; k < NSL; ++k) { sc[k] = sl[k];
#pragma unroll
            for (int j = 0; j < 4; ++j) y[k][j] = yn[k][j]; }
        { const int r1 = row + 1 < rend ? row + 1 : row, r2 = r1 + 1 < rend ? r1 + 1 : r1;
          N1_ISSUE(r1);
          if (l > 0) N1_LDINV(r2); }
        if (l > 0) {
            f32x4 s[4];
#pragma unroll
            for (int j = 0; j < 4; ++j) s[j] = (f32x4){0.f, 0.f, 0.f, 0.f};
#pragma unroll
            for (int k = 0; k < NSL; ++k) if (sc[k] >= 0) {
#pragma unroll
                for (int j = 0; j < 4; ++j) { const u32x2 w = y[k][j]; s[j] += (f32x4){bflo(w.x), bfhi(w.x), bflo(w.y), bfhi(w.y)}; } }
            if (nc > NSL) { int seen = 0;
                for (int e = 0; e < NEXP; ++e) { const int ix = __builtin_amdgcn_readfirstlane(inv[(size_t)row * NEXP + e]);
                    if (ix >= 0) { if (seen >= NSL) { const u32x2* yr = (const u32x2*)(yb + (size_t)ix * D) + F.lane;
#pragma unroll
                            for (int j = 0; j < 4; ++j) { const u32x2 w = yr[64 * j]; s[j] += (f32x4){bflo(w.x), bfhi(w.x), bflo(w.y), bfhi(w.y)}; } }
                        ++seen; } } }
#pragma unroll
            for (int j = 0; j < 4; ++j) { v[j] += mg5[j] * s[j]; xr[64 * j] = v[j]; }
        }
        float ss = 0.f;
#pragma unroll
        for (int j = 0; j < 4; ++j) ss += (v[j].x * v[j].x + v[j].y * v[j].y) + (v[j].z * v[j].z + v[j].w * v[j].w);
        const float rstd = 1.0f / sqrtf(wave_sum(ss) * (1.0f / D) + RMS_EPS);
        if (fin) {
            f32x4* o = (f32x4*)(P.out + (size_t)row * D) + F.lane;
#pragma unroll
            for (int j = 0; j < 4; ++j) o[64 * j] = v[j] * rstd * mgn[j];
        } else {
            u32x2* ho = (u32x2*)(hb + (size_t)row * D) + F.lane;
#pragma unroll
            for (int j = 0; j < 4; ++j) { const f32x4 sh = msh[j], scl = mscl[j];
                const f32x4 hv = v[j] * rstd * mgn[j] * (scl + 1.0f) + sh; u32x2 w; w.x = pk2(hv.x, hv.y); w.y = pk2(hv.z, hv.w); ho[64 * j] = w; }
        }
    }
#undef N1_XSRC
#undef N1_LDINV
#undef N1_ISSUE
}
constexpr int lg2c(int x) { return x <= 1 ? 0 : 1 + lg2c(x / 2); }
template <int N> struct RouterRed {
    template <int OFF> static DI float run(float (&v)[N], int lane) {
        float w[N / 2];
        const bool up = (lane & OFF) != 0;
#pragma unroll
        for (int i = 0; i < N / 2; ++i) { const float send = up ? v[i] : v[i + N / 2], keep = up ? v[i + N / 2] : v[i]; w[i] = keep + __shfl_xor(send, OFF); }
        return RouterRed<N / 2>::template run<OFF / 2>(w, lane);
    }
};
template <> struct RouterRed<1> { template <int OFF> static DI float run(float (&v)[1], int) { float x = v[0];
#pragma unroll
        for (int o = OFF; o >= 1; o >>= 1) x += __shfl_xor(x, o);
        return x; } };
DI void phase_norm2(const Frame& F0, const Params& P, const int l) {
    const Frame F = relaunder(F0);
    const float* xres = wsp<float>(P, WS_XRES); bf16_t* hb = wsp<bf16_t>(P, WS_H); float* aff = wsp<float>(P, WS_AFF);
    const float* modL = wsp<float>(P, WS_MODL); const float* modC = wsp<float>(P, WS_MODC);
    const float* wr = P.in[I_WR] + (size_t)l * D * NEXP;
    constexpr int EC = NEXP / 4, LGE = lg2c(NEXP);
    LAS f32x4* wl = (LAS f32x4*)F.lds;
    for (int i = F.tid; i < 16 * EC * 64; i += 512) { const int ln = i & 63, c = (i >> 6) % EC, jq = (i >> 6) / EC, col = 4 * ln + 256 * (jq >> 2) + (jq & 3);
        wl[i] = *(const f32x4*)(wr + (size_t)col * NEXP + 4 * c); }
    __syncthreads();
    const int lane = F.lane;
    int elane = 0;
#pragma unroll
    for (int s = 0; s < LGE; ++s) elane |= ((lane >> (5 - s)) & 1) << (LGE - 1 - s);
    const int nrows = (l < DEPTH - 1) ? RT : R_LAT;
    const bf16_t* dmix = wsp<bf16_t>(P, WS_DMIX);
#define N2_XSRC(r_) ((l == 0) ? (const f32x4*)((r_) < R_LAT ? P.in[I_X] + (size_t)(r_) * D : P.in[I_CTX] + (size_t)((r_) - R_LAT) * D) + lane : (const f32x4*)(xres + (size_t)(r_) * D) + lane)
    f32x4 vn[4]; u32x2 dn[4];
    const int R2 = (nrows + F.ngw - 1) / F.ngw, rbeg = F.gw * R2, rend = (rbeg + R2 < nrows) ? rbeg + R2 : nrows;
    { const int r0 = rbeg < nrows ? rbeg : 0; const f32x4* xr = N2_XSRC(r0); const u32x2* dm = (const u32x2*)(dmix + (size_t)r0 * D) + lane;
#pragma unroll
      for (int j = 0; j < 4; ++j) { vn[j] = xr[64 * j]; dn[j] = dm[64 * j]; } }
    f32x4 mg[4], msh[4], mscl[4]; int bkey = -2;
    { const f32x4* g = (const f32x4*)(P.in[I_N2G] + (size_t)l * D) + lane;
#pragma unroll
      for (int j = 0; j < 4; ++j) mg[j] = g[64 * j]; }
    for (int row = rbeg; row < rend; ++row) {
        const bool lat = row < R_LAT; const int b = lat ? row / SEQ : 0;
        if ((lat ? b : -1) != bkey) { bkey = lat ? b : -1; const float* mp = lat ? modL + ((size_t)l * NB + b) * 6 * D : modC + (size_t)l * 6 * D;
#pragma unroll
            for (int j = 0; j < 4; ++j) { msh[j] = *((const f32x4*)(mp + 3 * D) + lane + 64 * j); mscl[j] = *((const f32x4*)(mp + 4 * D) + lane + 64 * j); } }
        const LAS f32x4* wlr = wl; LAUNDER_V(wlr);
        f32x4 v[4]; float ss = 0.f;
#pragma unroll
        for (int j = 0; j < 4; ++j) { const u32x2 w = dn[j]; v[j] = vn[j] + (f32x4){bflo(w.x), bfhi(w.x), bflo(w.y), bfhi(w.y)}; ss += (v[j].x * v[j].x + v[j].y * v[j].y) + (v[j].z * v[j].z + v[j].w * v[j].w); }
        { const int rn = row + 1 < rend ? row + 1 : row; const f32x4* xr = N2_XSRC(rn); const u32x2* dm = (const u32x2*)(dmix + (size_t)rn * D) + lane;
#pragma unroll
          for (int j = 0; j < 4; ++j) { vn[j] = xr[64 * j]; dn[j] = dm[64 * j]; } }
        const float rstd = 1.0f / sqrtf(wave_sum(ss) * (1.0f / D) + RMS_EPS);
        u32x2* ho = (u32x2*)(hb + (size_t)row * D) + lane;
        float lg[NEXP];
#pragma unroll
        for (int e = 0; e < NEXP; ++e) lg[e] = 0.f;
#pragma unroll
        for (int j = 0; j < 4; ++j) { const float* mpx = lat ? modL + ((size_t)l * NB + b) * 6 * D : modC + (size_t)l * 6 * D; const f32x4 sh = *((const f32x4*)(mpx + 3 * D) + lane + 64 * j), scl = *((const f32x4*)(mpx + 4 * D) + lane + 64 * j);
            const f32x4 hv = v[j] * rstd * mg[j] * (scl + 1.0f) + sh; u32x2 w; w.x = pk2(hv.x, hv.y); w.y = pk2(hv.z, hv.w); ho[64 * j] = w;
#pragma unroll
            for (int q = 0; q < 4; ++q)
#pragma unroll
                for (int c = 0; c < EC; ++c) { const f32x4 wv = wlr[((j * 4 + q) * EC + c) * 64 + lane]; lg[4 * c] += hv[q] * wv.x; lg[4 * c + 1] += hv[q] * wv.y; lg[4 * c + 2] += hv[q] * wv.z; lg[4 * c + 3] += hv[q] * wv.w; } }
        const float logit = RouterRed<NEXP>::template run<32>(lg, lane);
        float mx = logit;
#pragma unroll
        for (int s = 0; s < LGE; ++s) mx = fmaxf(mx, __shfl_xor(mx, 32 >> s));
        const float ex = __expf(logit - mx); float sum = ex;
#pragma unroll
        for (int s = 0; s < LGE; ++s) sum += __shfl_xor(sum, 32 >> s);
        if ((lane & ((64 >> LGE) - 1)) == 0) aff[(size_t)row * NEXP + elane] = ex / sum;
    }
    __syncthreads();
}

DI int xcd_remap(int L, int total) { const int q = total / 8, r = total % 8, x = L % 8, off = L / 8; return (x < r ? x * (q + 1) : r * (q + 1) + (x - r) * q) + off; }
DI void decode2d(int L, int nM, int nN, int& pm, int& pn) { const int nig = 8 * nN, gid = L / nig, fm = gid * 8, gsz = (nM - fm) < 8 ? (nM - fm) : 8; pm = fm + (L % nig) % gsz; pn = (L % nig) / gsz; }

struct SchedW {
    int G, c; const char* mz; const char* wf;
    DI bool next(int i, g8::Unit& u) const { const int L = i * G + c; if (L >= DEPTH * 8) return false; const int l = L / 8, pm = (L % 8) / 4, pn = L % 4;
        u.A = mz + ((size_t)l * 512 + pm * 256) * 256 * 2; u.B = wf + ((size_t)l * D + pn * 256) * 256 * 2; u.gidx = nullptr; u.pm = pm; u.pn = pn; u.aux = l; u.nt = 4; u.half = 0; return true; }
};
struct EpiW { static constexpr bool ALIGN = G8_ALIGN_W; static constexpr bool PERM = true; bf16_t* WinT;
    DI void operator()(const f32x4 (&acc)[2][2][4][2], const g8::Unit& u, int wr, int wc, int fr, int fq) const {
#pragma unroll
        for (int ai = 0; ai < 2; ++ai)
#pragma unroll
            for (int m = 0; m < 4; ++m) { const int r = u.pm * 256 + ai * 128 + wr * 64 + m * 16 + fr; bf16_t* rowp = WinT + ((size_t)u.aux * NPROJ + 2560 + r) * D + u.pn * 256 + wc * 32 + 8 * fq;
#pragma unroll
                for (int bj = 0; bj < 2; ++bj) { const f32x4 v0 = acc[ai][bj][m][0], v1 = acc[ai][bj][m][1]; u32x4 w; w.x = pk2(v0.x, v0.y); w.y = pk2(v0.z, v0.w); w.z = pk2(v1.x, v1.y); w.w = pk2(v1.z, v1.w); *(u32x4*)(rowp + bj * 128) = w; } }
    }
};
struct SchedProj {
    int G, c, last; const char* A; const char* B;
    DI bool next(int i, g8::Unit& u) const {
        constexpr int nLat = R_LAT / 256, nCtx = R_CTX / 256;
        const int ntc = last ? 8 : NTILE, total = nLat * NTILE + nCtx * ntc;
        int L = i * G + c; if (L >= total) return false; L = xcd_remap(L, total);
        int pm, pn;
        if (L < nLat * NTILE) decode2d(L, nLat, NTILE, pm, pn);
        else { L -= nLat * NTILE; pm = nLat + L / ntc; pn = L % ntc; if (last) { const int k = pn; pn = (k < 5) ? k + 1 : (k == 5 ? 8 : (k == 6 ? 9 : 12)); } }
        u.A = A + (size_t)pm * 256 * D * 2; u.B = B + (size_t)pn * 256 * D * 2; u.gidx = nullptr; u.pm = pm; u.pn = pn; u.aux = 0; u.nt = D / 64; u.half = 0; return true; }
};
struct EpiProj { static constexpr bool ALIGN = G8_ALIGN_PROJ; static constexpr bool PERM = true; bf16_t* proj; float* ab; bf16_t* ztl; bf16_t* ztc; const float* rope;
    DI void operator()(const f32x4 (&acc)[2][2][4][2], const g8::Unit& u, int wr, int wc, int fr, int fq) const {
        const int pn = u.pn; const bool lat = u.pm * 256 < R_LAT;
#pragma unroll
        for (int ai = 0; ai < 2; ++ai)
#pragma unroll
            for (int m = 0; m < 4; ++m) {
                const int row = u.pm * 256 + ai * 128 + wr * 64 + m * 16 + fr;
                int b, t; if (lat) { b = row / SEQ; t = row % SEQ; } else { const int rr = row - R_LAT; b = rr / CTX; t = rr % CTX; }
#pragma unroll
                for (int bj = 0; bj < 2; ++bj) {
                    const int c8 = 128 * bj + 32 * wc + 8 * fq; f32x4 v0 = acc[ai][bj][m][0], v1 = acc[ai][bj][m][1];
                    if (pn == 0) { v0 = v0 * (0.125f * LOG2E); v1 = v1 * (0.125f * LOG2E); }
                    if (pn == 7) { v0 = v0 * (0.17677669529663687f * LOG2E); v1 = v1 * (0.17677669529663687f * LOG2E); }
                    if (pn < 10) {
                        if ((pn == 7 || pn == 8) && lat) { const f32x4* cs = (const f32x4*)(rope + ((size_t)t * 16 + 4 * fq) * 2); const f32x4 c0 = cs[0], c1 = cs[1];
                            v0 = (f32x4){v0.x * c0.x - v0.y * c0.y, v0.x * c0.y + v0.y * c0.x, v0.z * c0.z - v0.w * c0.w, v0.z * c0.w + v0.w * c0.z};
                            v1 = (f32x4){v1.x * c1.x - v1.y * c1.y, v1.x * c1.y + v1.y * c1.x, v1.z * c1.z - v1.w * c1.w, v1.z * c1.w + v1.w * c1.z}; }
                        u32x4 w; w.x = pk2(v0.x, v0.y); w.y = pk2(v0.z, v0.w); w.z = pk2(v1.x, v1.y); w.w = pk2(v1.z, v1.w);
                        *(u32x4*)(proj + (size_t)row * PLD + pn * 256 + c8) = w;
                    } else if (pn < 12) {
                        bf16_t* base = (lat ? ztl : ztc) + ((size_t)(b * 256 + c8)) * (2 * SEQ) + (pn - 10) * (lat ? SEQ : CTX) + t;
#pragma unroll
                        for (int j = 0; j < 4; ++j) { base[(size_t)j * 2 * SEQ] = f2bf(v0[j]); base[(size_t)(j + 4) * 2 * SEQ] = f2bf(v1[j]); }
                    } else if (bj == 0 && wc == 0 && fq < 2) { f32x4* o = (f32x4*)(ab + (size_t)row * 16 + 8 * fq); o[0] = v0; o[1] = v1; }
                }
            }
    }
};
struct SchedOut {
    int G, c, last; const char* A; const char* B;
    DI bool next(int i, g8::Unit& u) const { const int nM = last ? R_LAT / 256 : RT / 256, total = nM * 4; int L = i * G + c; if (L >= total) return false; L = xcd_remap(L, total);
        int pm, pn; decode2d(L, nM, 4, pm, pn);
        u.A = A + (size_t)pm * 256 * D * 2; u.B = B + (size_t)pn * 256 * D * 2; u.gidx = nullptr; u.pm = pm; u.pn = pn; u.aux = 0; u.nt = D / 64; u.half = 0; return true; }
};
struct EpiOut { static constexpr bool ALIGN = G8_ALIGN_OUT; static constexpr bool PERM = true; bf16_t* dmix; const float* modL; const float* modC;
    DI void operator()(const f32x4 (&acc)[2][2][4][2], const g8::Unit& u, int wr, int wc, int fr, int fq) const {
        const bool lat = u.pm * 256 < R_LAT; const int b = lat ? (u.pm * 256) / SEQ : 0;
        const float* g2 = lat ? modL + (size_t)b * 6 * D : modC;
#pragma unroll
        for (int bj = 0; bj < 2; ++bj) { const int c = u.pn * 256 + 128 * bj + 32 * wc + 8 * fq; const f32x4 g0 = *(const f32x4*)(g2 + c), g1 = *(const f32x4*)(g2 + c + 4);
#pragma unroll
            for (int ai = 0; ai < 2; ++ai)
#pragma unroll
                for (int m = 0; m < 4; ++m) { const int row = u.pm * 256 + ai * 128 + wr * 64 + m * 16 + fr; const f32x4 v0 = g0 * acc[ai][bj][m][0], v1 = g1 * acc[ai][bj][m][1];
                    u32x4 w; w.x = pk2(v0.x, v0.y); w.y = pk2(v0.z, v0.w); w.z = pk2(v1.x, v1.y); w.w = pk2(v1.z, v1.w); *(u32x4*)(dmix + (size_t)row * D + c) = w; } }
    }
};
struct SchedDft {
    int G, c, lat_on, ctx_on; const char* dl; const char* dc; const char* zl; const char* zc;
    DI bool next(int i, g8::Unit& u) const { constexpr int nlatc = (HSEQ / 256) * 2 * KSPLIT * NB, nctx = (CTX / 256) * NB; const int nlat = lat_on ? nlatc : 0, nc = ctx_on ? nctx : 0, total = nlat + nc;
        int L = i * G + c; if (L >= total) return false;
        if (L >= nc) { L = xcd_remap(L - nc, nlat); const int b = L % NB, ks = (L / NB) % (2 * KSPLIT), pm = L / (NB * 2 * KSPLIT);
            const size_t ko = (ks < KSPLIT) ? (size_t)ks * KCH : (size_t)SEQ + (size_t)(ks - KSPLIT) * KCH;
            u.A = dl + ((size_t)(1 + pm * 256) * 2 * SEQ + ko) * 2; u.B = zl + ((size_t)b * 256 * 2 * SEQ + ko) * 2; u.pm = pm; u.pn = b; u.aux = ks; u.nt = KCH / 64; }
        else { const int b = L % NB, pm = L / NB; u.A = dc + (size_t)pm * 256 * 2 * SEQ * 2; u.B = zc + (size_t)b * 256 * 2 * SEQ * 2; u.pm = pm; u.pn = b; u.aux = -1; u.nt = 2 * CTX / 64; }
        u.gidx = nullptr; u.half = 0; return true; }
};
struct EpiDft { static constexpr bool ALIGN = G8_ALIGN_DFT; static constexpr bool PERM = false; float* slab; float* slabc;
    DI void operator()(const f32x4 (&acc)[2][2][4][2], const g8::Unit& u, int wr, int wc, int fr, int fq) const {
        float* base = (u.aux >= 0) ? slab + ((size_t)u.aux * (NB * HSEQ) + (size_t)u.pn * HSEQ + u.pm * 256) * 256 : slabc + ((size_t)u.pn * CTX + u.pm * 256) * 256;
#pragma unroll
        for (int ai = 0; ai < 2; ++ai)
#pragma unroll
            for (int m = 0; m < 4; ++m) { float* rowp = base + (size_t)(ai * 128 + wr * 64 + m * 16 + fr) * 256 + 32 * wc + 4 * fq;
#pragma unroll
                for (int bj = 0; bj < 2; ++bj)
#pragma unroll
                    for (int n = 0; n < 2; ++n) *(f32x4*)(rowp + 128 * bj + 16 * n) = acc[ai][bj][m][n]; }
    }
};
constexpr bool EHALF = (EROWS % 256 != 0) && (EROWS % 256 <= 128);
struct SchedGU {
    int G, c, epan; const char* A; const char* B; const int* ridx;
    DI bool next(int i, g8::Unit& u) const { constexpr int NN = 2 * DEXP / 256; const int total = NEXP * epan * NN; int L = i * G + c; if (L >= total) return false;
        const bool hp = EHALF && (epan == EROWS_PAD / 256); const int ef = hp ? epan - 1 : epan, nfull = NEXP * ef * NN;
        int e, pn, pm, hf = 0;
        if (L < nfull) { L = xcd_remap(L, nfull); e = L / (ef * NN); const int rem = L % (ef * NN); pn = rem / ef; pm = rem % ef; }
        else { L -= nfull; e = L / NN; pn = L % NN; pm = epan - 1; hf = 1; }
        u.A = A; u.gidx = ridx + (size_t)e * EROWS_PAD + pm * 256; u.B = B + ((size_t)e * 2 * DEXP + pn * 256) * D * 2; u.pm = e * (EROWS_PAD / 256) + pm; u.pn = pn; u.aux = e; u.nt = D / 64; u.half = hf; return true; }
};
struct EpiGU { static constexpr bool ALIGN = G8_ALIGN_GU; static constexpr bool PERM = true; bf16_t* hid;
    DI void operator()(const f32x4 (&acc)[2][2][4][2], const g8::Unit& u, int wr, int wc, int fr, int fq) const {
#pragma unroll
        for (int ai = 0; ai < 2; ++ai)
#pragma unroll
            for (int m = 0; m < 4; ++m) { if (ai == 1 && u.half) continue; const int row = u.pm * 256 + ai * 128 + wr * 64 + m * 16 + fr;
                const f32x4 g0 = acc[ai][0][m][0], g1 = acc[ai][0][m][1], u0 = acc[ai][1][m][0], u1 = acc[ai][1][m][1];
                u32x4 w; w.x = pk2(siluf(g0.x) * u0.x, siluf(g0.y) * u0.y); w.y = pk2(siluf(g0.z) * u0.z, siluf(g0.w) * u0.w); w.z = pk2(siluf(g1.x) * u1.x, siluf(g1.y) * u1.y); w.w = pk2(siluf(g1.z) * u1.z, siluf(g1.w) * u1.w);
                *(u32x4*)(hid + (size_t)row * DEXP + u.pn * 128 + 32 * wc + 8 * fq) = w; }
    }
};
struct SchedDown {
    int G, c, epan; const char* A; const char* B;
    DI bool next(int i, g8::Unit& u) const { const int total = NEXP * epan * 4; int L = i * G + c; if (L >= total) return false;
        const bool hp = EHALF && (epan == EROWS_PAD / 256); const int ef = hp ? epan - 1 : epan, nfull = NEXP * ef * 4;
        int e, pn, pm, hf = 0;
        if (L < nfull) { L = xcd_remap(L, nfull); e = L / (ef * 4); const int rem = L % (ef * 4); pn = rem / ef; pm = rem % ef; }
        else { L -= nfull; e = L / 4; pn = L % 4; pm = epan - 1; hf = 1; }
        u.A = A + ((size_t)e * EROWS_PAD + pm * 256) * DEXP * 2; u.gidx = nullptr; u.B = B + ((size_t)e * D + pn * 256) * DEXP * 2; u.pm = e * (EROWS_PAD / 256) + pm; u.pn = pn; u.aux = e; u.nt = DEXP / 64; u.half = hf; return true; }
};
struct EpiDown { static constexpr bool ALIGN = G8_ALIGN_DOWN; static constexpr bool PERM = true; bf16_t* y; const float* gatev;
    DI void operator()(const f32x4 (&acc)[2][2][4][2], const g8::Unit& u, int wr, int wc, int fr, int fq) const {
#pragma unroll
        for (int ai = 0; ai < 2; ++ai)
#pragma unroll
            for (int m = 0; m < 4; ++m) { if (ai == 1 && u.half) continue; const int row = u.pm * 256 + ai * 128 + wr * 64 + m * 16 + fr; const float gv = gatev[row];
#pragma unroll
                for (int bj = 0; bj < 2; ++bj) { const f32x4 v0 = acc[ai][bj][m][0] * gv, v1 = acc[ai][bj][m][1] * gv; u32x4 w; w.x = pk2(v0.x, v0.y); w.y = pk2(v0.z, v0.w); w.z = pk2(v1.x, v1.y); w.w = pk2(v1.z, v1.w);
                    *(u32x4*)(y + (size_t)row * D + u.pn * 256 + 128 * bj + 32 * wc + 8 * fq) = w; } }
    }
};

DI int block_sum_i(const Frame& F, int v, LAS int* tmp) {
#pragma unroll
    for (int o = 1; o < 64; o <<= 1) v += __shfl_xor(v, o);
    if (F.lane == 0) tmp[F.wave] = v;
    __syncthreads();
    int s = 0;
#pragma unroll
    for (int w = 0; w < 8; ++w) s += tmp[w];
    __syncthreads();
    return s;
}
DI int block_excl_scan_i(const Frame& F, int v, LAS int* tmp) {
    int inc = v;
#pragma unroll
    for (int o = 1; o < 64; o <<= 1) { const int t = __shfl_up(inc, o); if (F.lane >= o) inc += t; }
    if (F.lane == 63) tmp[F.wave] = inc;
    __syncthreads();
    int base = 0;
#pragma unroll
    for (int w = 0; w < 8; ++w) base += (w < F.wave) ? tmp[w] : 0;
    __syncthreads();
    return base + inc - v;
}
template <int KPT>
DI void topk_problem(const Frame& F, const float* aff, int* ridx, float* gatev, int* inv, int e, int N, int cap, int rowbase, int slotbase) {
    LAS int* tmp = (LAS int*)F.lds;
    unsigned key[KPT];
#pragma unroll
    for (int j = 0; j < KPT; ++j) { const int tok = F.tid * KPT + j; key[j] = (tok < N) ? __float_as_uint(aff[(size_t)(rowbase + tok) * NEXP + e]) : 0u; }
    unsigned T = 0u;
    for (int bit = 31; bit >= 0; --bit) { const unsigned cand = T | (1u << bit); int c = 0;
#pragma unroll
        for (int j = 0; j < KPT; ++j) c += (key[j] >= cand) ? 1 : 0;
        if (block_sum_i(F, c, tmp) >= cap) T = cand; }
    int cg = 0, ce = 0;
#pragma unroll
    for (int j = 0; j < KPT; ++j) { cg += (key[j] > T) ? 1 : 0; ce += (key[j] == T) ? 1 : 0; }
    const int need_eq = cap - block_sum_i(F, cg, tmp);
    int eqb = block_excl_scan_i(F, ce, tmp);
    int sel[KPT]; int ns = 0;
#pragma unroll
    for (int j = 0; j < KPT; ++j) { const bool s = (key[j] > T) || (key[j] == T && eqb < need_eq); if (key[j] == T) ++eqb; sel[j] = s ? 1 : 0; ns += sel[j]; }
    int ord = block_excl_scan_i(F, ns, tmp);
#pragma unroll
    for (int j = 0; j < KPT; ++j) { const int tok = F.tid * KPT + j; if (tok < N) { const int row = rowbase + tok; int ix = -1;
            if (sel[j]) { ix = e * EROWS_PAD + slotbase + ord; ridx[ix] = row; gatev[ix] = __uint_as_float(key[j]); ++ord; }
            inv[(size_t)row * NEXP + e] = ix; } }
}
DI void phase_topk(const Frame& F0, const Params& P, const int l) {
    const Frame F = relaunder(F0);
    const float* aff = wsp<float>(P, WS_AFF); int* ridx = wsp<int>(P, WS_RIDX); float* gatev = wsp<float>(P, WS_GATEV); int* inv = wsp<int>(P, WS_INV);
    const int nprob = NEXP * NB * ((l < DEPTH - 1) ? 2 : 1);
    for (int p = F.bid; p < nprob; p += F.G) { const int seg = p / (NEXP * NB), b = (p / NEXP) % NB, e = p % NEXP;
        if (seg == 0) topk_problem<(SEQ + 511) / 512>(F, aff, ridx, gatev, inv, e, SEQ, CAP_LAT, b * SEQ, b * CAP_LAT);
        else topk_problem<(CTX + 511) / 512>(F, aff, ridx, gatev, inv, e, CTX, CAP_CTX, R_LAT + b * CTX, NB * CAP_LAT + b * CAP_CTX); }
}

DI float softplusf_(float x) { const float t = __expf(-fabsf(x)); return fmaxf(x, 0.f) + (t < 1e-3f ? t * (1.0f - 0.5f * t) : __logf(1.0f + t)); }
DI float fexp2(float x) { return __builtin_amdgcn_exp2f(x); }
DI float rdlane(float v, int l) { return __builtin_bit_cast(float, __builtin_amdgcn_readlane(__builtin_bit_cast(int, v), l)); }

DI void phase_dn0(const Frame& F0, const Params& P, const int l) {
    const Frame F = relaunder(F0);
    const bf16_t* proj = wsp<bf16_t>(P, WS_PROJ); bf16_t* dnp = wsp<bf16_t>(P, WS_DNP); const float* ab = wsp<float>(P, WS_AB); float* gb = wsp<float>(P, WS_GB);
    const float* convw = P.in[I_CONVW] + (size_t)l * 5 * 768; const float* alog = P.in[I_ALOG] + l * 8; const float* dtb = P.in[I_DTB] + l * 8;
    const int lane = F.lane;
    constexpr int DR = 9, UL = (SEQ + DR - 1) / DR, UC = (CTX + DR - 1) / DR, NU0 = NB * (UL + UC);
    for (int u = F.gw; u < NU0; u += F.ngw) {
        int base, t0, T; if (u < NB * UL) { base = (u / UL) * SEQ; t0 = (u % UL) * DR; T = SEQ; } else { const int uu = u - NB * UL; base = R_LAT + (uu / UC) * CTX; t0 = (uu % UC) * DR; T = CTX; }
        const int row0 = base + t0;
        u32x2 w[3][DR + 4];
#pragma unroll
        for (int r = 0; r < DR + 4; ++r) { const int tt = t0 - 2 + r; const bool ok = (tt >= 0) && (tt < T);
#pragma unroll
            for (int part = 0; part < 3; ++part) w[part][r] = ok ? *(const u32x2*)(proj + (size_t)(base + tt) * PLD + 768 + part * 256 + 4 * lane) : (u32x2){0u, 0u}; }
#pragma unroll
        for (int ps = 0; ps < (DR + 7) / 8; ++ps) { const int ri = 8 * ps + (lane >> 3), k = lane & 7;
            if (ri < DR && t0 + ri < T) { const size_t row = (size_t)row0 + ri; const float av = ab[row * 16 + k], bv = ab[row * 16 + 8 + k];
                gb[row * 16 + k] = -__expf(alog[k]) * softplusf_(av + dtb[k]); gb[row * 16 + 8 + k] = __builtin_amdgcn_rcpf(1.0f + __expf(-bv)); } }
#pragma unroll
        for (int part = 0; part < 3; ++part) {
            f32x4 cw[5];
#pragma unroll
            for (int j = 0; j < 5; ++j) cw[j] = *(const f32x4*)(convw + j * 768 + part * 256 + 4 * lane);
#pragma unroll
            for (int i = 0; i < DR; ++i) {
                f32x4 a = {0.f, 0.f, 0.f, 0.f};
#pragma unroll
                for (int j = 0; j < 5; ++j) { const u32x2 x = w[part][i + j]; a += cw[j] * (f32x4){bflo(x.x), bfhi(x.x), bflo(x.y), bfhi(x.y)}; }
                a = (f32x4){siluf(a.x), siluf(a.y), siluf(a.z), siluf(a.w)};
                if (part < 2) { float ss = (a.x * a.x + a.y * a.y) + (a.z * a.z + a.w * a.w);
                    ss += __shfl_xor(ss, 1); ss += __shfl_xor(ss, 2); ss += __shfl_xor(ss, 4); ss += __shfl_xor(ss, 8);
                    const float r = (part == 0 ? 0.125f : 1.0f) * __builtin_amdgcn_rsqf(ss + 1e-6f); a = a * r; }
                u32x2 o; o.x = pk2(a.x, a.y); o.y = pk2(a.z, a.w); if (t0 + i < T) *(u32x2*)(dnp + (size_t)(row0 + i) * 768 + part * 256 + 4 * lane) = o;
            }
        }
    }
}

#define DN_TILE(jt, it) ((jt) == 0 ? ((it) == 0 ? 0 : 1) : 2)
template <int I> struct DnSolve {
    static DI void run(float (&X)[64], const f32x16 (&Lt)[3]) {
        DnSolve<I - 1>::run(X, Lt);
        float a = X[I];
#pragma unroll
        for (int j = 0; j < I; ++j) { const int jl = j & 31, reg = (jl & 3) + 4 * (jl >> 3), hj = (jl >> 2) & 1, src = (I & 31) + 32 * hj;
            a -= rdlane(Lt[DN_TILE(j >> 5, I >> 5)][reg], src) * X[j]; }
        X[I] = a;
        __builtin_amdgcn_sched_barrier(0);
    }
};
template <> struct DnSolve<-1> { static DI void run(float (&)[64], const f32x16 (&)[3]) {} };

DI void phase_dn1(const Frame& F0, const Params& P) {
    const Frame F = relaunder(F0);
    const bf16_t* dnp = wsp<bf16_t>(P, WS_DNP); const float* gb = wsp<float>(P, WS_GB);
    bf16_t* An_g = wsp<bf16_t>(P, WS_AN); bf16_t* Qe_g = wsp<bf16_t>(P, WS_QE); unsigned* Bn_g = wsp<unsigned>(P, WS_BN); float* Oi_g = wsp<float>(P, WS_OI);
    LAS unsigned char* XT = F.lds + F.wave * 16384;
    LAS float* gcs = (LAS float*)(XT + 9216); LAS float* bts = gcs + 64; LAS unsigned char* QpL = XT + 9728;
#define QP(tl, s) (*(const LAS bf16x8*)(QpL + (((tl) * 2 + (s)) * 64 + lane) * 16))
    const int nfull = (NUNIT / F.ngw) * F.ngw, nrem = NUNIT - nfull;
    for (int lin = F.gw; ; lin += F.ngw) {
        int uid, part;
        if (lin < nfull) { uid = lin; part = 2; } else { const int r = lin - nfull; if (r >= 2 * nrem) break; uid = nfull + (r >> 1); part = r & 1; }
        int lane = F.lane; LAUNDER_V(lane); const int r32 = lane & 31, hh = lane >> 5;
        const int n = uid % NCH, dir = (uid / NCH) & 1, h = (uid / (2 * NCH)) % NH, b = uid / (2 * NCH * NH);
        int seqb, T, nn; if (n < NCC) { seqb = R_LAT + b * CTX; T = CTX; nn = n; } else { seqb = b * SEQ; T = SEQ; nn = n - NCC; }
        const int rbase = dir ? seqb + T - 1 - 64 * nn : seqb + 64 * nn, sgn = dir ? -1 : 1;
#define ROWI(i) ((size_t)(rbase + sgn * (i)))
        const bf16_t* qb_ = dnp + h * 64; const bf16_t* kb_ = dnp + 256 + h * 64; const bf16_t* vb_ = dnp + 512 + h * 64;
        float gc = gb[ROWI(lane) * 16 + dir * 4 + h]; const float beta = gb[ROWI(lane) * 16 + 8 + dir * 4 + h];
#pragma unroll
        for (int o = 1; o < 64; o <<= 1) { const float t = __shfl_up(gc, o); if (lane >= o) gc += t; }
        gcs[lane] = gc; bts[lane] = beta;
        const float glast = __shfl(gc, 63), eglast = __expf(glast);
        WAIT_LGKM(0); CFENCE();
        f32x16 Lt[3];
        {
            bf16x8 Ak[2][4], Bq[2][4];
#pragma unroll
            for (int t2 = 0; t2 < 2; ++t2)
#pragma unroll
                for (int ks = 0; ks < 4; ++ks) { const size_t ro = ROWI(32 * t2 + r32) * 768 + 16 * ks + 8 * hh; Ak[t2][ks] = *(const bf16x8*)(kb_ + ro); Bq[t2][ks] = *(const bf16x8*)(qb_ + ro); }
            const float gci[2] = {gcs[r32], gcs[32 + r32]}, bti[2] = {bts[r32], bts[32 + r32]};
#pragma unroll
            for (int tl = 0; tl < 3; ++tl) { const int jt = (tl == 2) ? 1 : 0, it = (tl == 0) ? 0 : 1;
                f32x16 kk = zero16(), qk = zero16();
#pragma unroll
                for (int ks = 0; ks < 4; ++ks) { kk = MFMA32(Ak[jt][ks], Ak[it][ks], kk); qk = MFMA32(Ak[jt][ks], Bq[it][ks], qk); }
                const int i = 32 * it + r32;
#pragma unroll
                for (int reg = 0; reg < 16; ++reg) { const int j = 32 * jt + crow(reg, hh); const float dec = (i >= j) ? __expf(gci[it] - gcs[j]) : 0.f;
                    qk[reg] = qk[reg] * dec; kk[reg] = (i > j) ? bti[it] * kk[reg] * dec : 0.f; }
                Lt[tl] = kk; *(LAS bf16x8*)(QpL + ((tl * 2 + 0) * 64 + lane) * 16) = pack8(qk, 0); *(LAS bf16x8*)(QpL + ((tl * 2 + 1) * 64 + lane) * 16) = pack8(qk, 1); }
        }
        __builtin_amdgcn_sched_barrier(0);
        float X[64];
        if (part != 1) {
#pragma unroll
        for (int i = 0; i < 64; ++i) X[i] = bf2f(vb_[ROWI(i) * 768 + lane]) * rdlane(beta, i);
        __builtin_amdgcn_sched_barrier(0);
        DnSolve<63>::run(X, Lt);
#pragma unroll
        for (int q = 0; q < 8; ++q) { u32x4 w; w.x = pk2(X[8 * q], X[8 * q + 1]); w.y = pk2(X[8 * q + 2], X[8 * q + 3]); w.z = pk2(X[8 * q + 4], X[8 * q + 5]); w.w = pk2(X[8 * q + 6], X[8 * q + 7]); *(LAS u32x4*)(XT + lane * 144 + 16 * q) = w; }
        WAIT_LGKM(0); CFENCE();
        __builtin_amdgcn_sched_barrier(0);
#pragma unroll
        for (int it = 0; it < 2; ++it)
#pragma unroll
            for (int et = 0; et < 2; ++et) { f32x16 z = zero16();
#pragma unroll
                for (int jt = 0; jt <= it; ++jt)
#pragma unroll
                    for (int s = 0; s < 2; ++s) { const LAS unsigned char* p = XT + (32 * et + r32) * 144 + (32 * jt + 16 * s + 4 * hh) * 2;
                        z = MFMA32(QP(DN_TILE(jt, it), s), cat44(*(const LAS u32x2*)p, *(const LAS u32x2*)(p + 16)), z); }
                float* op = Oi_g + (size_t)uid * 4096 + 32 * et + r32;
#pragma unroll
                for (int reg = 0; reg < 16; ++reg) op[(32 * it + crow(reg, hh)) * 64] = z[reg]; }
        }
        __builtin_amdgcn_sched_barrier(0);
        bf16x8 Kd[2][4];
#pragma unroll
        for (int dt = 0; dt < 2; ++dt)
#pragma unroll
            for (int s4 = 0; s4 < 4; ++s4) { float v[8];
#pragma unroll
                for (int jj = 0; jj < 8; ++jj) { const int j = 16 * s4 + 8 * hh + jj; v[jj] = bf2f(kb_[ROWI(j) * 768 + 32 * dt + r32]) * __expf(glast - gcs[j]); }
                u32x4 w; w.x = pk2(v[0], v[1]); w.y = pk2(v[2], v[3]); w.z = pk2(v[4], v[5]); w.w = pk2(v[6], v[7]); Kd[dt][s4] = __builtin_bit_cast(bf16x8, w); }
        if (part != 1) {
#pragma unroll
        for (int dt = 0; dt < 2; ++dt)
#pragma unroll
            for (int et = 0; et < 2; ++et) { f32x16 z = zero16();
#pragma unroll
                for (int s4 = 0; s4 < 4; ++s4) z = MFMA32(Kd[dt][s4], *(const LAS bf16x8*)(XT + (32 * et + r32) * 144 + (16 * s4 + 8 * hh) * 2), z);
                u32x4* op = (u32x4*)(Bn_g + (size_t)uid * 2048 + ((dt * 2 + et) * 64 + lane) * 8);
                op[0] = (u32x4){pk2(z[0], z[1]), pk2(z[2], z[3]), pk2(z[4], z[5]), pk2(z[6], z[7])}; op[1] = (u32x4){pk2(z[8], z[9]), pk2(z[10], z[11]), pk2(z[12], z[13]), pk2(z[14], z[15])}; }
        }
        if (part != 0) {
        CFENCE();
        LAUNDER_V(Lt[0]); LAUNDER_V(Lt[1]); LAUNDER_V(Lt[2]);
        { const float bw = beta * __expf(gc);
#pragma unroll
          for (int i = 0; i < 64; ++i) X[i] = bf2f(kb_[ROWI(i) * 768 + lane]) * rdlane(bw, i); }
        __builtin_amdgcn_sched_barrier(0);
        DnSolve<63>::run(X, Lt);
#pragma unroll
        for (int q = 0; q < 8; ++q) { u32x4 w; w.x = pk2(X[8 * q], X[8 * q + 1]); w.y = pk2(X[8 * q + 2], X[8 * q + 3]); w.z = pk2(X[8 * q + 4], X[8 * q + 5]); w.w = pk2(X[8 * q + 6], X[8 * q + 7]); *(LAS u32x4*)(XT + lane * 144 + 16 * q) = w; }
        WAIT_LGKM(0); CFENCE();
        __builtin_amdgcn_sched_barrier(0);
#pragma unroll
        for (int dt = 0; dt < 2; ++dt)
#pragma unroll
            for (int et = 0; et < 2; ++et) { f32x16 z = zero16();
#pragma unroll
                for (int s4 = 0; s4 < 4; ++s4) z = MFMA32(Kd[dt][s4], *(const LAS bf16x8*)(XT + (32 * et + r32) * 144 + (16 * s4 + 8 * hh) * 2), z);
                const int x = r32 & 15, hhA = (x >> 2) & 1, jj = ((x >> 3) << 2) | (x & 3);
                bf16_t* op = An_g + (size_t)uid * 4096 + (((dt * 2 + et) * 2 + (r32 >> 4)) * 64 + 32 * hhA) * 8 + jj;
#pragma unroll
                for (int reg = 0; reg < 16; ++reg) { const int dl = crow(reg, hh); op[dl * 8] = f2bf(((32 * dt + dl == 32 * et + r32) ? eglast : 0.f) - z[reg]); } }
        __builtin_amdgcn_sched_barrier(0);
#pragma unroll
        for (int it = 0; it < 2; ++it) { const int i = 32 * it + r32; const float eg = __expf(gcs[i]);
#pragma unroll
            for (int dt = 0; dt < 2; ++dt) { f32x16 y = zero16();
#pragma unroll
                for (int jt = 0; jt <= it; ++jt)
#pragma unroll
                    for (int s = 0; s < 2; ++s) { const LAS unsigned char* p = XT + (32 * dt + r32) * 144 + (32 * jt + 16 * s + 4 * hh) * 2;
                        y = MFMA32(cat44(*(const LAS u32x2*)p, *(const LAS u32x2*)(p + 16)), QP(DN_TILE(jt, it), s), y); }
#pragma unroll
                for (int a = 0; a < 4; ++a) { const int d0 = 32 * dt + 8 * a + 4 * hh; const u32x2 qv = *(const u32x2*)(qb_ + ROWI(i) * 768 + d0);
                    u32x2 o; o.x = pk2(bflo(qv.x) * eg - y[4 * a], bfhi(qv.x) * eg - y[4 * a + 1]); o.y = pk2(bflo(qv.y) * eg - y[4 * a + 2], bfhi(qv.y) * eg - y[4 * a + 3]);
                    *(u32x2*)(Qe_g + (size_t)uid * 4096 + i * 64 + d0) = o; } } }
        }
        WAIT_LGKM(0); CFENCE();
#undef ROWI
    }
}

DI void dn2_load(const bf16_t* An_g, const unsigned* Bn_g, size_t uid, int et, int lane, u32x4 (&Ar)[8], u32x4 (&Br)[4]) {
#pragma unroll
    for (int f = 0; f < 8; ++f) Ar[f] = *(const u32x4*)(An_g + uid * 4096 + (f * 64 + lane) * 8);
#pragma unroll
    for (int dt = 0; dt < 2; ++dt) { const u32x4* bp = (const u32x4*)(Bn_g + uid * 2048 + ((dt * 2 + et) * 64 + lane) * 8); Br[2 * dt] = bp[0]; Br[2 * dt + 1] = bp[1]; }
}
DI void dn2_step(bf16_t* Sn_g, size_t uid, int et, int lane, f32x16 (&S)[2], const u32x4 (&Ar)[8], const u32x4 (&Br)[4]) {
    bf16x8 Sp[2][2];
#pragma unroll
    for (int dp = 0; dp < 2; ++dp)
#pragma unroll
        for (int s = 0; s < 2; ++s) { Sp[dp][s] = pack8(S[dp], s); *(bf16x8*)(Sn_g + uid * 4096 + (((et * 2 + dp) * 2 + s) * 64 + lane) * 8) = Sp[dp][s]; }
#pragma unroll
    for (int dt = 0; dt < 2; ++dt) { f32x16 z;
#pragma unroll
        for (int h2 = 0; h2 < 2; ++h2) { const u32x4 w = Br[2 * dt + h2]; z[8 * h2] = bflo(w.x); z[8 * h2 + 1] = bfhi(w.x); z[8 * h2 + 2] = bflo(w.y); z[8 * h2 + 3] = bfhi(w.y); z[8 * h2 + 4] = bflo(w.z); z[8 * h2 + 5] = bfhi(w.z); z[8 * h2 + 6] = bflo(w.w); z[8 * h2 + 7] = bfhi(w.w); }
#pragma unroll
        for (int dp = 0; dp < 2; ++dp)
#pragma unroll
            for (int s = 0; s < 2; ++s) z = MFMA32(__builtin_bit_cast(bf16x8, Ar[(dt * 2 + dp) * 2 + s]), Sp[dp][s], z);
        S[dt] = z; }
}
DI void phase_dn2(const Frame& F0, const Params& P) {
    const Frame F = relaunder(F0);
    const bf16_t* An_g = wsp<bf16_t>(P, WS_AN); const unsigned* Bn_g = wsp<unsigned>(P, WS_BN); bf16_t* Sn_g = wsp<bf16_t>(P, WS_SN);
    const int lane = F.lane;
    constexpr int NCHAIN = NB * NH * 2 * 2;
    if (F.wave < 4)
    for (int cid = F.bid * 4 + F.wave; cid < NCHAIN; cid += F.G * 4) {
        const int et = cid & 1; const size_t uid0 = (size_t)(cid >> 1) * NCH;
        f32x16 S[2] = {zero16(), zero16()};
        u32x4 A0[8], A1[8], A2[8], B0[4], B1[4], B2[4];
        dn2_load(An_g, Bn_g, uid0, et, lane, A0, B0);
        dn2_load(An_g, Bn_g, uid0 + (1 < NCH ? 1 : 0), et, lane, A1, B1);
        dn2_load(An_g, Bn_g, uid0 + (2 < NCH ? 2 : 0), et, lane, A2, B2);
        for (int n = 0; n < NCH; n += 3) {
            dn2_step(Sn_g, uid0 + n, et, lane, S, A0, B0);
            dn2_load(An_g, Bn_g, uid0 + (n + 3 < NCH ? n + 3 : n), et, lane, A0, B0);
            if (n + 1 < NCH) { dn2_step(Sn_g, uid0 + n + 1, et, lane, S, A1, B1); dn2_load(An_g, Bn_g, uid0 + (n + 4 < NCH ? n + 4 : n), et, lane, A1, B1); }
            if (n + 2 < NCH) { dn2_step(Sn_g, uid0 + n + 2, et, lane, S, A2, B2); dn2_load(An_g, Bn_g, uid0 + (n + 5 < NCH ? n + 5 : n), et, lane, A2, B2); }
        }
    }
}

DI void phase_dn3(const Frame& F0, const Params& P, const int l, const int pidx, const int np) {
    const Frame F = relaunder(F0);
    const bf16_t* Qe_g = wsp<bf16_t>(P, WS_QE); const bf16_t* Sn_g = wsp<bf16_t>(P, WS_SN); const float* Oi_g = wsp<float>(P, WS_OI);
    const bf16_t* proj = wsp<bf16_t>(P, WS_PROJ); bf16_t* mix = wsp<bf16_t>(P, WS_MIX); const float* ng = P.in[I_DNG] + l * 64;
    const int lane = F.lane, r32 = lane & 31, hh = lane >> 5;
    const int NC = NCL + ((l < DEPTH - 1) ? NCC : 0);
    for (int u = F.wave * np + pidx; u < NB * NH * NC; u += np * 8) {
        const int ca = u % NC, h = (u / NC) % NH, b = u / (NC * NH);
        int rowb, nf, nbk; if (ca < NCL) { rowb = b * SEQ + 64 * ca; nf = NCC + ca; nbk = NCC + (NCL - 1 - ca); } else { const int c = ca - NCL; rowb = R_LAT + b * CTX + 64 * c; nf = c; nbk = NCC - 1 - c; }
        f32x16 O[2][2] = {{zero16(), zero16()}, {zero16(), zero16()}};
#pragma unroll
        for (int dir = 0; dir < 2; ++dir) { const size_t uid = (size_t)((b * NH + h) * 2 + dir) * NCH + (dir ? nbk : nf);
#pragma unroll
            for (int it = 0; it < 2; ++it) { const int x = 32 * it + r32, xi = dir ? 63 - x : x;
                bf16x8 Bq[2][2];
#pragma unroll
                for (int dp = 0; dp < 2; ++dp)
#pragma unroll
                    for (int s = 0; s < 2; ++s) { const bf16_t* p = Qe_g + uid * 4096 + xi * 64 + 32 * dp + 16 * s + 4 * hh; Bq[dp][s] = cat44(*(const u32x2*)p, *(const u32x2*)(p + 8)); }
#pragma unroll
                for (int et = 0; et < 2; ++et) { f32x16 z = O[et][it];
#pragma unroll
                    for (int dp = 0; dp < 2; ++dp)
#pragma unroll
                        for (int s = 0; s < 2; ++s) z = MFMA32(*(const bf16x8*)(Sn_g + uid * 4096 + (((et * 2 + dp) * 2 + s) * 64 + lane) * 8), Bq[dp][s], z);
#pragma unroll
                    for (int a = 0; a < 4; ++a) { const f32x4 oi = *(const f32x4*)(Oi_g + uid * 4096 + xi * 64 + 32 * et + 8 * a + 4 * hh); z[4 * a] += oi.x; z[4 * a + 1] += oi.y; z[4 * a + 2] += oi.z; z[4 * a + 3] += oi.w; }
                    O[et][it] = z; } } }
#pragma unroll
        for (int it = 0; it < 2; ++it) { const size_t row = (size_t)rowb + 32 * it + r32; float ss = 0.f;
#pragma unroll
            for (int et = 0; et < 2; ++et)
#pragma unroll
                for (int reg = 0; reg < 16; ++reg) ss += O[et][it][reg] * O[et][it][reg];
            ss += __shfl_xor(ss, 32);
            const float r = 1.0f / sqrtf(ss * (1.0f / 64.0f) + RMS_EPS);
#pragma unroll
            for (int et = 0; et < 2; ++et)
#pragma unroll
                for (int a = 0; a < 4; ++a) { const int e0 = 32 * et + 8 * a + 4 * hh; const f32x4 g = *(const f32x4*)(ng + e0); const u32x2 gt = *(const u32x2*)(proj + row * PLD + 6 * 256 + h * 64 + e0);
                    const f32x16& z = O[et][it];
                    u32x2 o; o.x = pk2(z[4 * a] * r * g.x * siluf(bflo(gt.x)), z[4 * a + 1] * r * g.y * siluf(bfhi(gt.x))); o.y = pk2(z[4 * a + 2] * r * g.z * siluf(bflo(gt.y)), z[4 * a + 3] * r * g.w * siluf(bfhi(gt.y)));
                    *(u32x2*)(mix + row * D + 256 + h * 64 + e0) = o; } }
    }
}

struct TileInfo { int row0, dyb, kc0; };
#ifdef EMU
DI s16x4 lds_tr16(const LAS unsigned char* p) {
    emu::Wave* w = emu::cur->wave; const int lane = emu::cur->lane;
    const int slot = emu::rendezvous(&p, sizeof(p), [](emu::Wave*, int) {});
    s16x4 r; const int g = lane >> 4, i = lane & 15;
    for (int q = 0; q < 4; ++q) { const unsigned char* a; memcpy(&a, w->stage[slot][16 * g + 4 * q + (i >> 2)], sizeof(a)); short v; memcpy(&v, a + 2 * (i & 3), 2); r[q] = v; }
    emu::rendezvous(nullptr, 0, [](emu::Wave*, int) {});
    return r;
}
#else
DI s16x4 lds_tr16(const LAS unsigned char* p) { return __builtin_amdgcn_ds_read_tr16_b64_v4i16((LAS s16x4*)p); }
#endif
DI int att_off(int row, int ch) { return 256 * row + 16 * (ch ^ (((row & 3) << 2) | ((row >> 2) & 3))); }
template <int NMAP, int TC, int SUBS, class TF>
DI void attn_core(const Frame& F, LAS unsigned char* lds, const bf16_t* proj, const bool active, const int qrow, const int qcol, const int kcol, const int vcol, const int hoff,
                  const int ntiles32, const TF& tf, const float sc, const LAS float* bias, const int qc, float (&mS)[NMAP], float (&lS)[NMAP], f32x16 (&O)[NMAP][2]) {
    static_assert(SUBS == 1, "one 32-key tile per stage");
    constexpr int KS = 4 / NMAP, NIMG = TC / 64, BUFB = NIMG * 8192, PIECES = 4 * TC, PPT = (2 * PIECES + 511) / 512, CPR = TC / 8;
    constexpr bool FULL = (2 * PIECES) % 512 == 0;
    const int ntiles = ntiles32;
    const int lane = F.lane, r32 = lane & 31, hh = lane >> 5, tid = F.tid;
    const int c0q = (qc - 8 < 0) ? 0 : ((qc - 8 > 48) ? 48 : qc - 8);
    (void)sc;
    bf16x8 qf[NMAP][KS];
#pragma unroll
    for (int mi = 0; mi < NMAP; ++mi)
#pragma unroll
        for (int ks = 0; ks < KS; ++ks) qf[mi][ks] = *(const bf16x8*)(proj + (size_t)(active ? qrow : 0) * PLD + qcol + mi * 32 + ks * 16 + hh * 8);
#pragma unroll
    for (int mi = 0; mi < NMAP; ++mi) { mS[mi] = 0.f; lS[mi] = 0.f; O[mi][0] = zero16(); O[mi][1] = zero16(); }
    u32x4 stg[PPT], stg2[PPT];
#define ATT_LOAD(ti_, dst_) do { _Pragma("unroll") for (int j = 0; j < PPT; ++j) { const int idx = tid + 512 * j; if (FULL || idx < 2 * PIECES) { const bool isV = idx >= PIECES; const int p = isV ? idx - PIECES : idx; \
        dst_[j] = *(const u32x4*)(proj + (size_t)((ti_).row0 + p / CPR) * PLD + (isV ? vcol : kcol) + (p % CPR) * 8); } } } while (0)
#define ATT_STORE_FROM(buf_, src_) do { _Pragma("unroll") for (int j = 0; j < PPT; ++j) { const int idx = tid + 512 * j; if (FULL || idx < 2 * PIECES) { const bool isV = idx >= PIECES; const int p = isV ? idx - PIECES : idx; const int cc = p % CPR; \
        *(LAS u32x4*)(lds + (buf_) * BUFB + (cc >> 3) * 8192 + att_off(p / CPR, (cc & 7) + (isV ? 8 : 0))) = src_[j]; } } } while (0)
    const int img = hoff / 64 * 8192;
    int kaddr[4];
#pragma unroll
    for (int s = 0; s < 4; ++s) kaddr[s] = img + att_off(r32, 2 * s + hh);
    const int trq = (lane & 15) >> 2, trp = lane & 3, trb = (lane >> 4) & 1;
    int vaddr[2][2][2];
#pragma unroll
    for (int dt = 0; dt < 2; ++dt)
#pragma unroll
        for (int s2 = 0; s2 < 2; ++s2)
#pragma unroll
            for (int t = 0; t < 2; ++t) vaddr[dt][s2][t] = img + att_off(16 * s2 + 8 * t + 4 * hh + trq, 8 + 4 * dt + 2 * trb + (trp >> 1)) + 8 * (trp & 1);
    f32x16 negm[NMAP], Lacc[NMAP];
#pragma unroll
    for (int mi = 0; mi < NMAP; ++mi) { negm[mi] = zero16(); Lacc[mi] = zero16(); }
    const bf16x8 ones8 = {(short)0x3f80, (short)0x3f80, (short)0x3f80, (short)0x3f80, (short)0x3f80, (short)0x3f80, (short)0x3f80, (short)0x3f80};
    auto compute = [&](const int buf, const TileInfo ti, const bool first) {
        if (active) {
            const LAS unsigned char* Tb = lds + buf * BUFB;
            bf16x8 vf[2][2];
#pragma unroll
            for (int dt = 0; dt < 2; ++dt)
#pragma unroll
                for (int s2 = 0; s2 < 2; ++s2) { const s16x4 lo = lds_tr16(Tb + vaddr[dt][s2][0]), hi = lds_tr16(Tb + vaddr[dt][s2][1]);
                    vf[dt][s2] = __builtin_shufflevector(lo, hi, 0, 1, 2, 3, 4, 5, 6, 7); }
#pragma unroll
            for (int mi = 0; mi < NMAP; ++mi) {
                f32x16 st = negm[mi];
#pragma unroll
                for (int ks = 0; ks < KS; ++ks) st = MFMA32(*(const LAS bf16x8*)(Tb + kaddr[mi * KS + ks]), qf[mi][ks], st);
                float tmax = -3.0e38f;
                if (ti.dyb >= 0) {
#pragma unroll
                    for (int reg = 0; reg < 16; ++reg) { const int kc = ti.kc0 + crow(reg, hh); const bool ok = (kc >= c0q) && (kc < c0q + 16); const float bv = bias[ti.dyb + (ok ? kc - qc + 15 : 0)];
                        const float x = ok ? st[reg] + bv : -1.0e30f; st[reg] = x; tmax = fmaxf(tmax, x); }
                } else {
#pragma unroll
                    for (int reg = 0; reg < 16; ++reg) tmax = fmaxf(tmax, st[reg]);
                }
                tmax = fmaxf(tmax, __shfl_xor(tmax, 32));
                if (first || __any(tmax > 6.0f)) { const float delta = first ? tmax : fmaxf(tmax, 0.f), alpha = fexp2(-delta);
                    if (!first) { Lacc[mi] = Lacc[mi] * alpha; O[mi][0] = O[mi][0] * alpha; O[mi][1] = O[mi][1] * alpha; }
                    negm[mi] = negm[mi] - delta; st = st - delta; }
#pragma unroll
                for (int reg = 0; reg < 16; ++reg) st[reg] = fexp2(st[reg]);
#pragma unroll
                for (int s2 = 0; s2 < 2; ++s2) { const bf16x8 pf = pack8(st, s2);
                    Lacc[mi] = MFMA32(ones8, pf, Lacc[mi]);
#pragma unroll
                    for (int dt = 0; dt < 2; ++dt) O[mi][dt] = MFMA32(vf[dt][s2], pf, O[mi][dt]); }
            }
        }
    };
    constexpr int NSTG = (PPT == 1) ? 4 : 2;
    u32x4 stg3[PPT], stg4[PPT];
    { const TileInfo t0 = tf(0); ATT_LOAD(t0, stg); }
    { const TileInfo t1 = tf(1 < ntiles ? 1 : 0); ATT_LOAD(t1, stg2); }
    if (NSTG == 4) { { const TileInfo t2 = tf(2 < ntiles ? 2 : 0); ATT_LOAD(t2, stg3); } { const TileInfo t3 = tf(3 < ntiles ? 3 : 0); ATT_LOAD(t3, stg4); } }
#define ATT_STEP(k_, reg_) do { ATT_STORE_FROM((k_) & 1, reg_); \
        WAIT_LGKM(0); __builtin_amdgcn_s_barrier(); CFENCE();     \
        { const int nx = (i + (k_) + NSTG < ntiles) ? i + (k_) + NSTG : ntiles - 1; const TileInfo tn = tf(nx); ATT_LOAD(tn, reg_); } \
        compute((k_) & 1, tf(i + (k_)), i + (k_) == 0); } while (0)
    for (int i = 0; i < ntiles; i += NSTG) {
        ATT_STEP(0, stg); ATT_STEP(1, stg2);
        if (NSTG == 4) { ATT_STEP(2, stg3); ATT_STEP(3, stg4); }
    }
#undef ATT_STEP
#pragma unroll
    for (int mi = 0; mi < NMAP; ++mi) lS[mi] = 0.5f * Lacc[mi][0];
    __syncthreads();
#undef ATT_LOAD
#undef ATT_STORE_FROM
}

constexpr int NCHB = (NB * NH * 4 + 3) / 4;
DI bool chain_dedicated(int G) { return G >= 4 * NCHB; }
constexpr int NA_BUFB = 4 * 8192;
constexpr int NA_BIAS_OFF = 2 * NA_BUFB;
template <int PART> DI void phase_attn(const Frame& F0, const Params& P, const int l, const bool lat_on = true, const bool ctx_on = true, const int Gd = 0, const int cd = 0) {
    const Frame F = relaunder(F0);
    const bf16_t* proj = wsp<bf16_t>(P, WS_PROJ); bf16_t* mix = wsp<bf16_t>(P, WS_MIX);
    const bool last = (l == DEPTH - 1);
    const int lane = F.lane, r32 = lane & 31, hh = lane >> 5, wave = F.wave;
    LAS float* bias = (LAS float*)(F.lds + NA_BIAS_OFF);
    const bool dedicated = chain_dedicated(F.G); const int first = dedicated ? NCHB : 0;
    if (PART == 0 && (!dedicated || F.bid >= NCHB)) {
    for (int i = F.tid; i < 4 * 465; i += 512) bias[i] = P.in[I_RPB][(size_t)l * 4 * 465 + i] * LOG2E;
    __syncthreads();
    { const int nlat = NB * GROWS, nctx = last ? 0 : NB * (CTX / 64);
      for (int uq = F.bid - first; uq < nlat + nctx; uq += F.G - first) {
        const int u = (uq < nlat && nlat % 8 == 0) ? (uq % 8) * (nlat / 8) + uq / 8 : uq;
        const int h = wave >> 1, qh = wave & 1; int qrow, ntiles, b, r = 0, wstart = 0; const int nct = CTX / 32;
        if (u < nlat) { b = u / GROWS; r = u % GROWS; qrow = b * SEQ + r * 64 + qh * 32 + r32; int ws = r - WH / 2; ws = ws < 0 ? 0 : (ws > GROWS - WH ? GROWS - WH : ws); wstart = ws; ntiles = nct + 2 * WH; }
        else { const int uu = u - nlat; b = uu / (CTX / 64); qrow = R_LAT + b * CTX + (uu % (CTX / 64)) * 64 + qh * 32 + r32; ntiles = nct; }
        auto tf = [&](int i) { TileInfo t; if (i < nct) { t.row0 = R_LAT + b * CTX + 32 * i; t.dyb = -1; t.kc0 = 0; } else { const int w = (i - nct) >> 1, half = (i - nct) & 1, wrow = wstart + w; t.row0 = b * SEQ + wrow * 64 + 32 * half; t.dyb = (wrow - r + 7) * 31; t.kc0 = 32 * half; } return t; };
        float mS[1], lS[1]; f32x16 O[1][2];
        attn_core<1, 256, 1>(F, F.lds, proj, true, qrow, h * 64, 256, 512, 64 * h, ntiles, tf, 0.125f * LOG2E, bias + h * 465, qh * 32 + r32, mS, lS, O);
        const float inv = 1.0f / (lS[0] + __shfl_xor(lS[0], 32));
#pragma unroll
        for (int dt = 0; dt < 2; ++dt)
#pragma unroll
            for (int a = 0; a < 4; ++a) { const int d0 = 32 * dt + 8 * a + 4 * hh; u32x2 o; o.x = pk2(O[0][dt][4 * a] * inv, O[0][dt][4 * a + 1] * inv); o.y = pk2(O[0][dt][4 * a + 2] * inv, O[0][dt][4 * a + 3] * inv);
                *(u32x2*)(mix + (size_t)qrow * D + h * 64 + d0) = o; }
      } }
    }
    if (PART == 1) { const float lam_init = 0.8f - 0.6f * expf(-0.3f * (float)l);
      const float* dl = P.in[I_DFLAM] + (size_t)l * 128; const float p1 = (lane < 32) ? dl[lane] * dl[32 + lane] : 0.f, p2 = (lane < 32) ? dl[64 + lane] * dl[96 + lane] : 0.f;
      const float lam = expf(wave_sum(p1)) - expf(wave_sum(p2)) + lam_init;
      const float* dg = P.in[I_DFG] + l * 64;
      constexpr int QBL = SEQ / 256, QBC = (CTX + 255) / 256; const int nlat = lat_on ? NB * NH * QBL : 0, nctx = (last || !ctx_on) ? 0 : NB * NH * QBC; const int nct = CTX / 32;
      for (int u0 = cd; u0 < nlat + nctx; u0 += Gd) {
        const int ul = u0 - nctx, u = (u0 < nctx) ? nlat + u0 : ((nlat % 8 == 0) ? (ul % 8) * (nlat / 8) + ul / 8 : ul);
        int b, h, qrow, ntiles; bool active = true;
        if (u < nlat) { const int qb = u % QBL; h = (u / QBL) % NH; b = u / (QBL * NH); qrow = b * SEQ + qb * 256 + 32 * wave + r32; ntiles = nct + SEQ / 32; }
        else { const int uu = u - nlat, qb = uu % QBC; h = (uu / QBC) % NH; b = uu / (QBC * NH); active = (qb * 256 + 32 * wave) < CTX; qrow = R_LAT + b * CTX + qb * 256 + 32 * wave + r32; ntiles = nct; }
        auto tf = [&](int i) { TileInfo t; t.row0 = (i < nct) ? R_LAT + b * CTX + 32 * i : b * SEQ + 32 * (i - nct); t.dyb = -1; t.kc0 = 0; return t; };
        float mS[2], lS[2]; f32x16 O[2][2];
        attn_core<2, 64, 1>(F, F.lds, proj, active, qrow, 7 * 256 + h * 64, 8 * 256 + h * 64, 9 * 256 + h * 64, 0, ntiles, tf, 0.17677669529663687f * LOG2E, bias, 0, mS, lS, O);
        if (active) {
            const float i1 = 1.0f / (lS[0] + __shfl_xor(lS[0], 32)), i2 = lam / (lS[1] + __shfl_xor(lS[1], 32));
            float ss = 0.f;
#pragma unroll
            for (int dt = 0; dt < 2; ++dt)
#pragma unroll
                for (int reg = 0; reg < 16; ++reg) { const float o = O[0][dt][reg] * i1 - O[1][dt][reg] * i2; O[0][dt][reg] = o; ss += o * o; }
            ss += __shfl_xor(ss, 32);
            const float rr = (1.0f - lam_init) / sqrtf(ss * (1.0f / 64.0f) + RMS_EPS);
#pragma unroll
            for (int dt = 0; dt < 2; ++dt)
#pragma unroll
                for (int a = 0; a < 4; ++a) { const int d0 = 32 * dt + 8 * a + 4 * hh; const f32x4 g = *(const f32x4*)(dg + d0);
                    u32x2 o; o.x = pk2(O[0][dt][4 * a] * rr * g.x, O[0][dt][4 * a + 1] * rr * g.y); o.y = pk2(O[0][dt][4 * a + 2] * rr * g.z, O[0][dt][4 * a + 3] * rr * g.w);
                    *(u32x2*)(mix + (size_t)qrow * D + 512 + h * 64 + d0) = o; }
        }
      } }
}
DI void phase_ftreduce(const Frame& F0, const Params& P, const int l, const int pidx, const int np, const bool lat_on, const bool ctx_on) {
    const Frame F = relaunder(F0);
    const float* slab = wsp<float>(P, WS_SLAB); const float* slabc = wsp<float>(P, WS_SLABC); bf16_t* mix = wsp<bf16_t>(P, WS_MIX);
    const int gt = pidx * 512 + F.tid, ngt = np * 512;
    const int nl = lat_on ? R_LAT * 64 : 0, nc = (ctx_on && l < DEPTH - 1) ? R_CTX * 64 : 0;
    constexpr size_t SLABSZ = (size_t)NB * HSEQ * 64;
    for (int i = gt; i < nl + nc; i += ngt) {
        f32x4 v; int row; int c4;
        if (i < nl) { row = i / 64; c4 = i % 64; const int b = row / SEQ, k = row % SEQ;
            if (k == 0) continue;
            const int kk = (k <= HSEQ) ? k : SEQ - k; const size_t o = ((size_t)b * HSEQ + kk - 1) * 64 + c4;
            f32x4 p = *((const f32x4*)slab + o), q = *((const f32x4*)slab + (size_t)KSPLIT * SLABSZ + o);
#pragma unroll
            for (int ks = 1; ks < KSPLIT; ++ks) { p += *((const f32x4*)slab + (size_t)ks * SLABSZ + o); q += *((const f32x4*)slab + (size_t)(KSPLIT + ks) * SLABSZ + o); }
            v = (k <= HSEQ) ? p + q : p - q; }
        else { const int j = i - nl; row = R_LAT + j / 64; c4 = j % 64; v = *((const f32x4*)slabc + j); }
        u32x2 o; o.x = pk2(v.x, v.y); o.y = pk2(v.z, v.w); *(u32x2*)(mix + (size_t)row * D + 768 + 4 * c4) = o;
    }
    if (lat_on) { const bf16_t* ztl = wsp<bf16_t>(P, WS_ZTL); const float sc = 1.0f / sqrtf((float)SEQ);
      for (int u = F.wave * np + pidx; u < NB * 256; u += np * 8) { const bf16_t* zr = ztl + (size_t)u * 2 * SEQ; float s = 0.f;
          for (int t = 8 * F.lane; t < SEQ; t += 512) { const u32x4 w = *(const u32x4*)(zr + t); s += (bflo(w.x) + bfhi(w.x)) + (bflo(w.y) + bfhi(w.y)) + (bflo(w.z) + bfhi(w.z)) + (bflo(w.w) + bfhi(w.w)); }
          s = wave_sum(s);
          if (F.lane == 0) mix[((size_t)(u / 256) * SEQ) * D + 768 + (u % 256)] = f2bf(s * sc); } }
}

#define REP_P0 1
#define REP_PROJ 1
#define REP_DN0 1
#define REP_DN1 1
#define REP_CHAIN 1
#define REP_DFT 1
#define REP_ATT 1
#define REP_N2 1
#define REP_TOPK 1
#define REP_GU 1
#define REP_DOWN 1
__global__ void __launch_bounds__(512, 2) fwd_kernel(Params P) {
#ifdef EMU
    unsigned char* lds_raw = emu::cur->blk->lds;
#else
    extern __shared__ __attribute__((aligned(16))) unsigned char lds_raw[];
#endif
    Frame F; F.lds = (LAS unsigned char*)lds_raw; F.tid = threadIdx.x; F.lane = F.tid & 63; F.wave = __builtin_amdgcn_readfirstlane(F.tid >> 6);
    F.G = gridDim.x; F.bid = blockIdx.x; F.gw = F.wave * F.G + F.bid; F.ngw = F.G * 8;
    volatile LAS unsigned* misc = (volatile LAS unsigned*)(F.lds + LDS_MISC);
    if (F.tid < 64) misc[F.tid] = 0u;
    __syncthreads();
    XcdBarrier bar = xcd_barrier_post(wsp<unsigned>(P, WS_CTL) + CW_BAR, misc + 8);
#define GRID_BAR() xcd_barrier(bar)
#ifdef EMU
    const int emu_stop = getenv("EMU_STOP") ? atoi(getenv("EMU_STOP")) : -1;
#define EMU_STOP(l, ph) do { if (emu_stop == (l) * 100 + (ph)) return; } while (0)
#else
#define EMU_STOP(l, ph)
#endif

#pragma unroll
        for (int rep_ = 0; rep_ < REP_P0; ++rep_) {
    p0_weights(F, P);
    __syncthreads();
    p0_mod(F, P);
    p0_misc(F, P);
    GRID_BAR();
        }
    { SchedW S{F.G, F.bid, (const char*)wsp<bf16_t>(P, WS_MZT), (const char*)wsp<bf16_t>(P, WS_WFT)}; EpiW E{wsp<bf16_t>(P, WS_WIN)};
      g8::gemm_phase<EpiW, SchedW, false>(F.lds, 256, 256, S, E); }
    phase_norm1(F, P, 0);
    GRID_BAR();
    for (int l = 0; l < DEPTH; ++l) {
        const int last = (l == DEPTH - 1) ? 1 : 0;
        if (l > 0) { phase_norm1(F, P, l); GRID_BAR(); }
        EMU_STOP(l, 1);
#pragma unroll
        for (int rep_ = 0; rep_ < REP_PROJ; ++rep_) {
        { SchedProj S{F.G, F.bid, last, (const char*)wsp<bf16_t>(P, WS_H), (const char*)(wsp<bf16_t>(P, WS_WIN) + (size_t)l * NPROJ * D)};
          EpiProj E{wsp<bf16_t>(P, WS_PROJ), wsp<float>(P, WS_AB), wsp<bf16_t>(P, WS_ZTL), wsp<bf16_t>(P, WS_ZTC), wsp<float>(P, WS_ROPE)};
          g8::gemm_phase<EpiProj, SchedProj, false>(F.lds, D, D, S, E); }
        GRID_BAR();
        }
        EMU_STOP(l, 2);
#pragma unroll
        for (int rep_ = 0; rep_ < REP_DN0; ++rep_) {
        phase_dn0(F, P, l);
        GRID_BAR();
        }
        EMU_STOP(l, 3);
#pragma unroll
        for (int rep_ = 0; rep_ < REP_DN1; ++rep_) {
        { SchedDft S{F.G, F.bid, 1, (!last && !chain_dedicated(F.G)) ? 1 : 0, (const char*)wsp<bf16_t>(P, WS_DFTL), (const char*)wsp<bf16_t>(P, WS_DFTC), (const char*)wsp<bf16_t>(P, WS_ZTL), (const char*)wsp<bf16_t>(P, WS_ZTC)};
          EpiDft E{wsp<float>(P, WS_SLAB), wsp<float>(P, WS_SLABC)};
          g8::gemm_phase<EpiDft, SchedDft, false>(F.lds, 2 * SEQ, 2 * SEQ, S, E); }
        phase_dn1(F, P);
        GRID_BAR();
        }
        EMU_STOP(l, 4);
#pragma unroll
        for (int rep_ = 0; rep_ < REP_CHAIN; ++rep_) {
        phase_dn2(F, P);
        unsigned* chc = wsp<unsigned>(P, WS_CTL) + CW_CHC + 64 * l;
        if (chain_dedicated(F.G) && F.bid < NCHB) {
            WAIT_VM(0);
            __syncthreads();
            if (F.tid == 0) { __builtin_amdgcn_fence(__ATOMIC_RELEASE, "agent"); WAIT_VM(0); (void)xb_add(chc, 1u); }
        }
        if (chain_dedicated(F.G) && F.bid < NCHB && !last) {
            __syncthreads();
            { SchedDft S{NCHB, F.bid, 0, 1, (const char*)wsp<bf16_t>(P, WS_DFTL), (const char*)wsp<bf16_t>(P, WS_DFTC), (const char*)wsp<bf16_t>(P, WS_ZTL), (const char*)wsp<bf16_t>(P, WS_ZTC)};
              EpiDft E{wsp<float>(P, WS_SLAB), wsp<float>(P, WS_SLABC)};
              g8::gemm_phase<EpiDft, SchedDft, false>(F.lds, 2 * SEQ, 2 * SEQ, S, E); }
            phase_attn<1>(F, P, l, false, true, NCHB, F.bid);
        }
        phase_attn<0>(F, P, l);
        if (chain_dedicated(F.G) && F.bid >= NCHB) {
            const int nb_na = F.G - NCHB, units = NB * GROWS + (last ? 0 : NB * (CTX / 64)), extra = units % nb_na, idx = F.bid - NCHB;
            if (idx >= extra) { phase_ftreduce(F, P, l, idx - extra, nb_na - extra, true, false);
                { unsigned sp = 0u; while (xb_ld(chc) < (unsigned)NCHB) { __builtin_amdgcn_s_sleep(2); if (++sp > (1u << 22)) break; } }
                __builtin_amdgcn_fence(__ATOMIC_ACQUIRE, "agent");
                phase_dn3(F, P, l, idx - extra, nb_na - extra); }
        }
        GRID_BAR();
        }
        EMU_STOP(l, 5);
#pragma unroll
        for (int rep_ = 0; rep_ < REP_ATT; ++rep_) {
        if (!chain_dedicated(F.G)) phase_dn3(F, P, l, F.bid, F.G);
        phase_attn<1>(F, P, l, true, !chain_dedicated(F.G), F.G, F.bid);
        phase_ftreduce(F, P, l, F.bid, F.G, !chain_dedicated(F.G), true);
        GRID_BAR();
        }
        EMU_STOP(l, 7);
        { SchedOut S{F.G, F.bid, last, (const char*)wsp<bf16_t>(P, WS_MIX), (const char*)(wsp<bf16_t>(P, WS_WOUT) + (size_t)l * D * D)};
          EpiOut E{wsp<bf16_t>(P, WS_DMIX), wsp<float>(P, WS_MODL) + (size_t)l * NB * 6 * D + 2 * D, wsp<float>(P, WS_MODC) + (size_t)l * 6 * D + 2 * D};
          g8::gemm_phase<EpiOut, SchedOut, false>(F.lds, D, D, S, E); }
        GRID_BAR();
        EMU_STOP(l, 8);
#pragma unroll
        for (int rep_ = 0; rep_ < REP_N2; ++rep_) {
        phase_norm2(F, P, l);
        GRID_BAR();
        }
        EMU_STOP(l, 9);
#pragma unroll
        for (int rep_ = 0; rep_ < REP_TOPK; ++rep_) {
        phase_topk(F, P, l);
        GRID_BAR();
        }
        EMU_STOP(l, 10);
        const int epan = (last ? EROWS_LAT_PAD : EROWS_PAD) / 256;
#pragma unroll
        for (int rep_ = 0; rep_ < REP_GU; ++rep_) {
        { SchedGU S{F.G, F.bid, epan, (const char*)wsp<bf16_t>(P, WS_H), (const char*)(wsp<bf16_t>(P, WS_WGU) + (size_t)l * NEXP * 2 * DEXP * D), wsp<int>(P, WS_RIDX)};
          EpiGU E{wsp<bf16_t>(P, WS_HID)};
          g8::gemm_phase<EpiGU, SchedGU, true>(F.lds, D, D, S, E); }
        GRID_BAR();
        }
        EMU_STOP(l, 11);
#pragma unroll
        for (int rep_ = 0; rep_ < REP_DOWN; ++rep_) {
        { SchedDown S{F.G, F.bid, epan, (const char*)wsp<bf16_t>(P, WS_HID), (const char*)(wsp<bf16_t>(P, WS_WD) + (size_t)l * NEXP * D * DEXP)};
          EpiDown E{wsp<bf16_t>(P, WS_Y), wsp<float>(P, WS_GATEV)};
          g8::gemm_phase<EpiDown, SchedDown, false>(F.lds, DEXP, DEXP, S, E); }
        GRID_BAR();
        }
        EMU_STOP(l, 12);
    }
    phase_norm1(F, P, DEPTH);
}

extern "C" void kernel_launch(void* const* d_in, const int* in_sizes, int n_in, void* d_out, int out_size, void* d_ws, size_t ws_size, hipStream_t stream) {
    static int grid = 0;
    if (grid == 0) {
        if (n_in != 23 || ws_size < WS_END) { fprintf(stderr, "kernel_launch: expected 23 inputs and >= %zu bytes of workspace (got %d, %zu)\n", (size_t)WS_END, n_in, ws_size); grid = -1; return; }
#ifdef EMU
        const char* g = getenv("EMU_GRID"); grid = g ? atoi(g) : 3;
#else
        int dev = 0, cus = 0;
        if (hipGetDevice(&dev) != hipSuccess || hipDeviceGetAttribute(&cus, hipDeviceAttributeMultiprocessorCount, dev) != hipSuccess) { grid = -1; return; }
        if (hipFuncSetAttribute((const void*)fwd_kernel, hipFuncAttributeMaxDynamicSharedMemorySize, LDS_BYTES) != hipSuccess) { fprintf(stderr, "kernel_launch: hipFuncSetAttribute failed\n"); grid = -1; return; }
        int per_cu = 0;
        if (hipOccupancyMaxActiveBlocksPerMultiprocessor(&per_cu, (const void*)fwd_kernel, 512, LDS_BYTES) != hipSuccess || per_cu < 1) fprintf(stderr, "kernel_launch: occupancy query says %d\n", per_cu);
        (void)hipGetLastError();
        grid = cus;
#endif
    }
    if (grid < 0) return;
    (void)in_sizes; (void)out_size;
    hipMemsetAsync((char*)d_ws + WS_CTL, 0, CTL_BYTES, stream);
    Params p{};
    for (int i = 0; i < 23; ++i) p.in[i] = (const float*)d_in[i];
    p.out = (float*)d_out; p.ws = (unsigned char*)d_ws;
#ifdef EMU
    emu::launch([=]() { fwd_kernel(p); }, grid, 512, LDS_BYTES);
#else
    hipLaunchKernelGGL(fwd_kernel, dim3(grid), dim3(512), LDS_BYTES, stream, p);
#endif
}
```

```cpp
#ifdef EMU
#include "emu.h"
#define LAS
#define WAIT_VM(n)
#define WAIT_LGKM(n) emu::rendezvous(nullptr, 0, [](emu::Wave*, int) {})
#define CFENCE()
#define LAUNDER_V(x)
#define LAUNDER_S(x)
#else
#include <hip/hip_runtime.h>
#include <cstdio>
#define LAS __attribute__((address_space(3)))
#define WAIT_VM(n) asm volatile("s_waitcnt vmcnt(" #n ")" ::: "memory")
#define WAIT_LGKM(n) asm volatile("s_waitcnt lgkmcnt(" #n ")" ::: "memory")
#define CFENCE() asm volatile("" ::: "memory")
#define LAUNDER_V(x) asm volatile("" : "+v"(x))
#define LAUNDER_S(x) asm volatile("" : "+s"(x))
#endif
#define DI __device__ __forceinline__

#ifndef CFG_BATCH
#define CFG_BATCH 4
#define CFG_SEQ 4096
#define CFG_CTX 256
#define CFG_DEPTH 4
#define CFG_NEXP 16
#define CFG_DEXP 2048
#define CFG_KS 4
#endif
constexpr int NB = CFG_BATCH, SEQ = CFG_SEQ, CTX = CFG_CTX, DEPTH = CFG_DEPTH, NEXP = CFG_NEXP, DEXP = CFG_DEXP, KSPLIT = CFG_KS;
constexpr int D = 1024, GW = 256, NH = 4, HD = 64, GRIDW = 64, GROWS = SEQ / GRIDW;
constexpr int IN_W = 11 * GW + 4 * NH;
constexpr int R_LAT = NB * SEQ, R_CTX = NB * CTX, RT = R_LAT + R_CTX;
constexpr int NTILE = 13, NPROJ = NTILE * 256;
constexpr int PLD = 12 * 256;
constexpr int CAP_LAT = 2 * SEQ / NEXP, CAP_CTX = 2 * CTX / NEXP;
constexpr int EROWS = NB * (CAP_LAT + CAP_CTX), EROWS_PAD = (EROWS + 255) / 256 * 256, EROWS_LAT_PAD = (NB * CAP_LAT + 255) / 256 * 256;
constexpr int NCC = CTX / 64, NCL = SEQ / 64, NCH = NCC + NCL, NUNIT = NB * NH * 2 * NCH;
constexpr int WH = GROWS < 8 ? GROWS : 8;
constexpr float RMS_EPS = 1e-6f;
constexpr float LOG2E = 1.4426950408889634f;
static_assert(R_LAT % 256 == 0 && R_CTX % 256 == 0 && SEQ % 256 == 0 && CTX % 256 == 0, "row panels");
constexpr int KCH = SEQ / KSPLIT;
constexpr int HSEQ = SEQ / 2;
static_assert(KCH % 128 == 0 && KCH >= 256 && HSEQ % 256 == 0 && DEXP % 128 == 0 && DEXP >= 256, "gemm K");

constexpr size_t al256(size_t x) { return (x + 255) / 256 * 256; }
constexpr size_t WS_CTL = 0, CTL_BYTES = 1u << 20;
constexpr size_t WS_MODL = WS_CTL + CTL_BYTES;
constexpr size_t WS_MODC = WS_MODL + al256((size_t)DEPTH * NB * 6 * D * 4);
constexpr size_t WS_ROPE = WS_MODC + al256((size_t)DEPTH * 6 * D * 4);
constexpr size_t WS_DFTL = WS_ROPE + al256((size_t)SEQ * 32 * 4);
constexpr size_t WS_DFTC = WS_DFTL + al256((size_t)SEQ * 2 * SEQ * 2);
constexpr size_t WS_WIN = WS_DFTC + al256((size_t)CTX * 2 * SEQ * 2);
constexpr size_t WS_WOUT = WS_WIN + al256((size_t)DEPTH * NPROJ * D * 2);
constexpr size_t WS_WGU = WS_WOUT + al256((size_t)DEPTH * D * D * 2);
constexpr size_t WS_WD = WS_WGU + al256((size_t)DEPTH * NEXP * 2 * DEXP * D * 2);
constexpr size_t WS_MZT = WS_WD + al256((size_t)DEPTH * NEXP * D * DEXP * 2);
constexpr size_t WS_WFT = WS_MZT + al256((size_t)DEPTH * 512 * 256 * 2);
constexpr size_t WS_XRES = WS_WFT + al256((size_t)DEPTH * D * 256 * 2);
constexpr size_t WS_H = WS_XRES + al256((size_t)RT * D * 4);
constexpr size_t WS_PROJ = WS_H + al256((size_t)RT * D * 2);
constexpr size_t WS_AB = WS_PROJ + al256((size_t)RT * PLD * 2);
constexpr size_t WS_DNP = WS_AB + al256((size_t)RT * 16 * 4);
constexpr size_t WS_GB = WS_DNP + al256((size_t)RT * 768 * 2);
constexpr size_t WS_AN = WS_GB + al256((size_t)RT * 16 * 4);
constexpr size_t WS_QE = WS_AN + al256((size_t)NUNIT * 8192);
constexpr size_t WS_SN = WS_QE + al256((size_t)NUNIT * 8192);
constexpr size_t WS_BN = WS_SN + al256((size_t)NUNIT * 8192);
constexpr size_t WS_OI = WS_BN + al256((size_t)NUNIT * 16384);
constexpr size_t WS_ZTL = WS_OI + al256((size_t)NUNIT * 16384);
constexpr size_t WS_ZTC = WS_ZTL + al256((size_t)NB * 256 * 2 * SEQ * 2);
constexpr size_t WS_SLAB = WS_ZTC + al256((size_t)NB * 256 * 2 * SEQ * 2);
constexpr size_t WS_SLABC = WS_SLAB + al256((size_t)KSPLIT * R_LAT * 256 * 4);
constexpr size_t WS_MIX = WS_SLABC + al256((size_t)R_CTX * 256 * 4);
constexpr size_t WS_AFF = WS_MIX + al256((size_t)RT * D * 2);
constexpr size_t WS_RIDX = WS_AFF + al256((size_t)RT * NEXP * 4);
constexpr size_t WS_GATEV = WS_RIDX + al256((size_t)NEXP * EROWS_PAD * 4);
constexpr size_t WS_INV = WS_GATEV + al256((size_t)NEXP * EROWS_PAD * 4);
constexpr size_t WS_DMIX = WS_PROJ;
constexpr size_t WS_HID = WS_INV + al256((size_t)RT * NEXP * 4);
constexpr size_t WS_Y = WS_HID + al256((size_t)NEXP * EROWS_PAD * DEXP * 2);
constexpr size_t WS_END = WS_Y + al256((size_t)NEXP * EROWS_PAD * D * 2);
constexpr int CW_CHC = 2048;
constexpr int CW_BAR = 4096;

constexpr int LDS_WORK = 131072;
constexpr int LDS_MISC = LDS_WORK;
constexpr int LDS_BYTES = 147456;

typedef unsigned short bf16_t;
typedef short bf16x8 __attribute__((ext_vector_type(8)));
typedef short s16x4 __attribute__((ext_vector_type(4)));
typedef float f32x2 __attribute__((ext_vector_type(2)));
typedef float f32x4 __attribute__((ext_vector_type(4)));
typedef float f32x16 __attribute__((ext_vector_type(16)));
typedef unsigned u32x2 __attribute__((ext_vector_type(2)));
typedef unsigned u32x4 __attribute__((ext_vector_type(4)));
typedef int i32x4 __attribute__((ext_vector_type(4)));

DI float bf2f(bf16_t b) { return __builtin_bit_cast(float, ((unsigned)b) << 16); }
DI float bflo(unsigned w) { return __builtin_bit_cast(float, w << 16); }
DI float bfhi(unsigned w) { return __builtin_bit_cast(float, w & 0xffff0000u); }
#ifdef EMU
DI unsigned pk2(float lo, float hi) { return (unsigned)emu::f2bf(lo) | ((unsigned)emu::f2bf(hi) << 16); }
#else
typedef __bf16 bf16x2v __attribute__((ext_vector_type(2)));
DI unsigned pk2(float lo, float hi) { f32x2 v = {lo, hi}; return __builtin_bit_cast(unsigned, __builtin_convertvector(v, bf16x2v)); }
#endif
DI bf16_t f2bf(float f) { return (bf16_t)(pk2(f, 0.f) & 0xffffu); }
DI float siluf(float x) { return x * __builtin_amdgcn_rcpf(1.0f + __expf(-x)); }
DI float wave_sum(float v) {
#pragma unroll
    for (int o = 1; o < 64; o <<= 1) v += __shfl_xor(v, o);
    return v;
}
DI int crow(int reg, int hh) { return (reg & 3) + 8 * (reg >> 2) + 4 * hh; }
DI f32x16 zero16() { f32x16 z; for (int i = 0; i < 16; ++i) z[i] = 0.f; return z; }
DI bf16x8 pack8(const f32x16& x, int s) {
    u32x4 p; p.x = pk2(x[8 * s], x[8 * s + 1]); p.y = pk2(x[8 * s + 2], x[8 * s + 3]); p.z = pk2(x[8 * s + 4], x[8 * s + 5]); p.w = pk2(x[8 * s + 6], x[8 * s + 7]);
    return __builtin_bit_cast(bf16x8, p);
}
DI bf16x8 cat44(u32x2 lo, u32x2 hi) { u32x4 p; p.x = lo.x; p.y = lo.y; p.z = hi.x; p.w = hi.y; return __builtin_bit_cast(bf16x8, p); }
#define MFMA32(a, b, c) __builtin_amdgcn_mfma_f32_32x32x16_bf16((a), (b), (c), 0, 0, 0)
#define MFMA16(a, b, c) __builtin_amdgcn_mfma_f32_16x16x32_bf16((a), (b), (c), 0, 0, 0)

#define XB_TMO      128
#define XB_XCNT(j)  (256  + 64 * (j))
#define XB_XSUB(j)  (1280 + 64 * (j))
#define XB_XGEN(j)  (2304 + 64 * (j))
#define XB_TOP      3328
#define XB_TOPGEN   3392
#define XCD_BAR_WORDS 3456
#define XB_SPIN_CAP (1u << 18)
DI unsigned xb_ld(unsigned* p)              { return __hip_atomic_load(p, __ATOMIC_RELAXED, __HIP_MEMORY_SCOPE_AGENT); }
DI unsigned xb_add(unsigned* p, unsigned v) { return __hip_atomic_fetch_add(p, v, __ATOMIC_RELAXED, __HIP_MEMORY_SCOPE_AGENT); }
DI unsigned xb_xcc_id() { return (unsigned)__builtin_amdgcn_s_getreg((3 << 11) | 20) & 0xFu; }
#define XB_SPIN(cond, bar) do { unsigned _sp = 0; while (cond) { __builtin_amdgcn_s_sleep(1); \
    if ((++_sp & 255u) == 0u) { if (xb_ld(&(bar)[XB_TMO])) break; if (_sp > XB_SPIN_CAP) { atomicAdd(&(bar)[XB_TMO], 1u); break; } } } } while (0)
struct XcdBarrier { unsigned* bar; unsigned x; volatile LAS unsigned* st; };
DI XcdBarrier xcd_barrier_post(unsigned* bar, volatile LAS unsigned* st) {
    XcdBarrier b; b.bar = bar; b.x = (unsigned)__builtin_amdgcn_readfirstlane((int)xb_xcc_id()); b.st = st;
    if (threadIdx.x == 0) (void)xb_add(&bar[XB_XCNT(b.x)], 1u);
    return b;
}
DI void xcd_barrier_complete(unsigned* bar, unsigned x, unsigned& nloc, unsigned& nx) {
    const unsigned G = gridDim.x * gridDim.y * gridDim.z;
    unsigned sum, cnt, mine, sp = 0u;
    for (;;) {
        sum = 0u; cnt = 0u; mine = 0u;
#pragma unroll
        for (unsigned j = 0; j < 16; ++j) { const unsigned c = xb_ld(&bar[XB_XCNT(j)]); sum += c; cnt += (c > 0u) ? 1u : 0u; mine = (j == x) ? c : mine; }
        if (sum == G) break;
        __builtin_amdgcn_s_sleep(1);
        if ((++sp & 255u) == 0u) { if (xb_ld(&bar[XB_TMO])) break; if (sp > XB_SPIN_CAP) { atomicAdd(&bar[XB_TMO], 1u); break; } }
    }
    nloc = mine > 0u ? mine : 1u; nx = cnt > 0u ? cnt : 1u;
}
DI void xcd_barrier(const XcdBarrier& b) {
    WAIT_VM(0);
    __syncthreads();
    unsigned* bar = b.bar; unsigned bx = b.x; LAUNDER_S(bar); LAUNDER_S(bx);
    if (threadIdx.x == 0) {
        __builtin_amdgcn_s_waitcnt(0);
        unsigned nloc = b.st[0], nx = b.st[1];
        if (nloc == 0u) { xcd_barrier_complete(bar, bx, nloc, nx); b.st[0] = nloc; b.st[1] = nx; }
        const unsigned old = xb_add(&bar[XB_XSUB(bx)], 1u);
        const unsigned gen = old / nloc;
        if (old + 1u == (gen + 1u) * nloc) {
            __builtin_amdgcn_fence(__ATOMIC_RELEASE, "agent");
            WAIT_VM(0);
            const unsigned og = xb_add(&bar[XB_TOP], 1u);
            const unsigned tg = og / nx;
            if (og + 1u == (tg + 1u) * nx) xb_add(&bar[XB_TOPGEN], 1u);
            else XB_SPIN(xb_ld(&bar[XB_TOPGEN]) == tg, bar);
            __builtin_amdgcn_fence(__ATOMIC_ACQUIRE, "agent");
            xb_add(&bar[XB_XGEN(bx)], 1u);
            WAIT_VM(0);
        } else {
            XB_SPIN(xb_ld(&bar[XB_XGEN(bx)]) == gen, bar);
            __builtin_amdgcn_fence(__ATOMIC_ACQUIRE, "agent");
            WAIT_VM(0);
        }
    }
    __syncthreads();
}

#ifndef G8_SP2
#define G8_SP2 true
#endif
#ifndef G8_ALIGN_W
#define G8_ALIGN_W false
#endif
#ifndef G8_ALIGN_PROJ
#define G8_ALIGN_PROJ true
#endif
#ifndef G8_ALIGN_OUT
#define G8_ALIGN_OUT true
#endif
#ifndef G8_ALIGN_DFT
#define G8_ALIGN_DFT true
#endif
#ifndef G8_ALIGN_GU
#define G8_ALIGN_GU true
#endif
#ifndef G8_ALIGN_DOWN
#define G8_ALIGN_DOWN true
#endif
namespace g8 {
constexpr int BM = 256, BK = 64, HALF = 128, HTB = HALF * BK * 2, STAGE_BYTES = 8 * HTB;
DI int lds_byte(int r, int c) { const int st = (r >> 4) * 2 + (c >> 5), rr = r & 15, cc = c & 31, ob = rr * 64 + cc * 2; return st * 1024 + (ob ^ (((ob >> 9) & 1) << 5)); }
DI void stage_rc(int b, int& R, int& C) { const int st = b / 1024, sb = b % 1024, swz = sb ^ (((sb >> 9) & 1) << 5); R = (st >> 1) * 16 + swz / 64; C = (st & 1) * 32 + (swz % 64) / 2; }
DI int perm32(int rho) { const int n = rho >> 4, i = rho & 15; return 8 * (i >> 2) + 4 * n + (i & 3); }
struct Unit { const char* A; const char* B; const int* gidx; int pm, pn, aux, nt, half; };

template <class Epi, class Sched, bool GATHER>
DI void gemm_phase(LAS unsigned char* lds, const int lda, const int ldb, const Sched& S, const Epi& E) {
    int tid = threadIdx.x; LAUNDER_V(tid);
    const int wid = __builtin_amdgcn_readfirstlane(tid >> 6), lane = tid & 63, wr = wid >> 2, wc = wid & 3, fr = lane & 15, fq = lane >> 4;
    int Rr[2], Cc[2]; unsigned voffB[2];
#pragma unroll
    for (int i = 0; i < 2; ++i) { stage_rc(tid * 16 + i * 8192, Rr[i], Cc[i]); const int Rb = Epi::PERM ? ((Rr[i] & ~31) + perm32(Rr[i] & 31)) : Rr[i]; voffB[i] = (unsigned)(Rb * ldb + Cc[i]) * 2u; }
    const size_t kstep = (size_t)(BK * 2);
    const size_t hstepB = (size_t)HALF * ldb * 2;
    const unsigned ldsw = (unsigned)wid * 1024u;
    const int aoff = lds_byte(wr * 64 + fr, fq * 8), boff = lds_byte(wc * 32 + fr, fq * 8);
#define G8_SA(b, h) (((b) * 2 + (h)) * HTB)
#define G8_SB(b, h) ((4 + (b) * 2 + (h)) * HTB)
#define G8_STAGE(bufoff, gbase, v0, v1) do { \
        __builtin_amdgcn_global_load_lds((const unsigned*)((const char*)(gbase) + (v0)), (LAS unsigned*)(lds + (bufoff) + ldsw), 16, 0, 0); \
        __builtin_amdgcn_global_load_lds((const unsigned*)((const char*)(gbase) + (v1)), (LAS unsigned*)(lds + (bufoff) + ldsw + 8192), 16, 0, 0); } while (0)
#define G8_STAGE_B(bufoff, gbase) G8_STAGE(bufoff, gbase, voffB[0], voffB[1])
#define G8_LDA(dst, b, h) do { _Pragma("unroll") for (int m = 0; m < 4; ++m) _Pragma("unroll") for (int k = 0; k < 2; ++k) dst[m][k] = *(const LAS bf16x8*)(lds + G8_SA(b, h) + aoff + m * 2048 + k * 1024); } while (0)
#define G8_LDB(dst, b, h) do { _Pragma("unroll") for (int n = 0; n < 2; ++n) _Pragma("unroll") for (int k = 0; k < 2; ++k) dst[n][k] = *(const LAS bf16x8*)(lds + G8_SB(b, h) + boff + n * 2048 + k * 1024); } while (0)
#define G8_MMA(ai, bj, At, Bt) do { __builtin_amdgcn_s_setprio(1); _Pragma("unroll") for (int m = 0; m < 4; ++m) _Pragma("unroll") for (int n = 0; n < 2; ++n) _Pragma("unroll") for (int k = 0; k < 2; ++k) \
        acc[ai][bj][m][n] = MFMA16(Bt[n][k], At[m][k], acc[ai][bj][m][n]); __builtin_amdgcn_s_setprio(0); } while (0)
#define G8_BAR __builtin_amdgcn_s_barrier()
#define G8_SCHED __builtin_amdgcn_sched_barrier(0)
#define G8_VA(u, V) do { _Pragma("unroll") for (int h = 0; h < 2; ++h) _Pragma("unroll") for (int i = 0; i < 2; ++i) { \
        const int rr = GATHER ? (u).gidx[h * HALF + Rr[i]] : (h * HALF + Rr[i]); V[h][i] = (unsigned)(rr * lda + Cc[i]) * 2u; } } while (0)
    Unit cur, nxt; int ui = 0;
    if (!S.next(0, cur)) return;
    f32x4 acc[2][2][4][2];
#pragma unroll
    for (int a = 0; a < 2; ++a)
#pragma unroll
        for (int b = 0; b < 2; ++b)
#pragma unroll
            for (int m = 0; m < 4; ++m)
#pragma unroll
                for (int n = 0; n < 2; ++n) acc[a][b][m][n] = (f32x4){0.f, 0.f, 0.f, 0.f};
    bf16x8 At[4][2], B0[2][2], B1[2][2];
    unsigned vaC[2][2], vaN[2][2];
    G8_VA(cur, vaC);
    const char* cA = cur.A; const char* cB = cur.B;
    if constexpr (G8_SP2) {
        G8_STAGE_B(G8_SB(0, 0), cB); G8_STAGE_B(G8_SB(0, 1), cB + hstepB); G8_STAGE(G8_SA(0, 0), cA, vaC[0][0], vaC[0][1]); G8_STAGE(G8_SA(0, 1), cA, vaC[1][0], vaC[1][1]);
        if (wr == 1) G8_BAR;
        WAIT_VM(2); G8_BAR;
    } else {
        G8_STAGE_B(G8_SB(0, 0), cB); G8_STAGE(G8_SA(0, 0), cA, vaC[0][0], vaC[0][1]); G8_STAGE_B(G8_SB(0, 1), cB + hstepB); G8_STAGE(G8_SA(0, 1), cA, vaC[1][0], vaC[1][1]);
        if (wr == 1) G8_BAR;
        WAIT_VM(4); G8_BAR;
    }
    G8_STAGE_B(G8_SB(1, 0), cB + kstep); G8_STAGE(G8_SA(1, 0), cA + kstep, vaC[0][0], vaC[0][1]); G8_STAGE_B(G8_SB(1, 1), cB + hstepB + kstep);
    WAIT_VM(6); G8_BAR;
    for (;;) {
        const bool has_next = S.next(ui + 1, nxt);
        const int nt = cur.nt; const bool hf = cur.half != 0;
        const char* nA = has_next ? nxt.A : cA; const char* nB = has_next ? nxt.B : cB;
        if (GATHER) { if (has_next) { G8_VA(nxt, vaN); } else {
#pragma unroll
            for (int h = 0; h < 2; ++h)
#pragma unroll
                for (int i = 0; i < 2; ++i) vaN[h][i] = vaC[h][i]; } }
        for (int t = 0; t < nt; t += 2) {
            const bool last = (t == nt - 2);
            const char* a1 = cA + (size_t)(t + 1) * kstep;
            const char* a2 = last ? nA : cA + (size_t)(t + 2) * kstep; const char* b2 = last ? nB : cB + (size_t)(t + 2) * kstep;
            const char* a3 = a2 + kstep; const char* b3 = b2 + kstep;
            unsigned x00, x01, x10, x11;
            if (GATHER) { x00 = last ? vaN[0][0] : vaC[0][0]; x01 = last ? vaN[0][1] : vaC[0][1]; x10 = last ? vaN[1][0] : vaC[1][0]; x11 = last ? vaN[1][1] : vaC[1][1]; }
            else { x00 = vaC[0][0]; x01 = vaC[0][1]; x10 = vaC[1][0]; x11 = vaC[1][1]; }
            if constexpr (G8_SP2) {
            G8_LDB(B0, 0, 0); G8_LDB(B1, 0, 1); G8_SCHED; G8_LDA(At, 0, 0); G8_STAGE(G8_SA(1, 1), a1, vaC[1][0], vaC[1][1]);
            WAIT_VM(8); WAIT_LGKM(0); G8_BAR; G8_MMA(0, 0, At, B0); G8_MMA(0, 1, At, B1); G8_BAR; G8_SCHED;
            G8_LDA(At, 0, 1); G8_STAGE_B(G8_SB(0, 0), b2); G8_STAGE_B(G8_SB(0, 1), b2 + hstepB); G8_STAGE(G8_SA(0, 0), a2, x00, x01);
            WAIT_VM(8); WAIT_LGKM(0); G8_BAR; if (!hf) { G8_MMA(1, 0, At, B0); G8_MMA(1, 1, At, B1); } G8_BAR; G8_SCHED;
            G8_LDB(B0, 1, 0); G8_LDB(B1, 1, 1); G8_SCHED; G8_LDA(At, 1, 0); G8_STAGE(G8_SA(0, 1), a2, x10, x11);
            WAIT_VM(8); WAIT_LGKM(0); G8_BAR; G8_MMA(0, 0, At, B0); G8_MMA(0, 1, At, B1); G8_BAR; G8_SCHED;
            G8_LDA(At, 1, 1); G8_STAGE_B(G8_SB(1, 0), b3); G8_STAGE_B(G8_SB(1, 1), b3 + hstepB); G8_STAGE(G8_SA(1, 0), a3, x00, x01);
            WAIT_VM(8); WAIT_LGKM(0); G8_BAR; if (!hf) { G8_MMA(1, 0, At, B0); G8_MMA(1, 1, At, B1); } G8_BAR; G8_SCHED;
            } else {
            G8_LDB(B0, 0, 0); G8_SCHED; G8_LDA(At, 0, 0); G8_STAGE(G8_SA(1, 1), a1, vaC[1][0], vaC[1][1]);
            WAIT_LGKM(8); G8_BAR; WAIT_LGKM(0); G8_MMA(0, 0, At, B0); G8_BAR; G8_SCHED;
            G8_LDB(B1, 0, 1); G8_STAGE_B(G8_SB(0, 0), b2);
            G8_BAR; WAIT_LGKM(0); G8_MMA(0, 1, At, B1); G8_BAR;
            G8_LDA(At, 0, 1); G8_STAGE(G8_SA(0, 0), a2, x00, x01);
            G8_BAR; WAIT_LGKM(0); if (!hf) G8_MMA(1, 0, At, B0); G8_BAR; G8_SCHED;
            G8_STAGE_B(G8_SB(0, 1), b2 + hstepB);
            WAIT_VM(6); G8_BAR; if (!hf) G8_MMA(1, 1, At, B1); G8_BAR;
            G8_LDB(B0, 1, 0); G8_SCHED; G8_LDA(At, 1, 0); G8_STAGE(G8_SA(0, 1), a2, x10, x11);
            WAIT_LGKM(8); G8_BAR; WAIT_LGKM(0); G8_MMA(0, 0, At, B0); G8_BAR; G8_SCHED;
            G8_LDB(B1, 1, 1); G8_STAGE_B(G8_SB(1, 0), b3);
            G8_BAR; WAIT_LGKM(0); G8_MMA(0, 1, At, B1); G8_BAR;
            G8_LDA(At, 1, 1); G8_STAGE(G8_SA(1, 0), a3, x00, x01);
            G8_BAR; WAIT_LGKM(0); if (!hf) G8_MMA(1, 0, At, B0); G8_BAR; G8_SCHED;
            G8_STAGE_B(G8_SB(1, 1), b3 + hstepB);
            WAIT_VM(6); G8_BAR; if (!hf) G8_MMA(1, 1, At, B1); G8_BAR;
            }
        }
        if constexpr (Epi::ALIGN) { if (wr == 0) G8_BAR; }
        E(acc, cur, wr, wc, fr, fq);
        if (!has_next) break;
#pragma unroll
        for (int a = 0; a < 2; ++a)
#pragma unroll
            for (int b = 0; b < 2; ++b)
#pragma unroll
                for (int m = 0; m < 4; ++m)
#pragma unroll
                    for (int n = 0; n < 2; ++n) acc[a][b][m][n] = (f32x4){0.f, 0.f, 0.f, 0.f};
        cur = nxt; cA = nA; cB = nB; ++ui;
        if (GATHER) {
#pragma unroll
            for (int h = 0; h < 2; ++h)
#pragma unroll
                for (int i = 0; i < 2; ++i) vaC[h][i] = vaN[h][i]; }
        if constexpr (Epi::ALIGN) { if (wr == 1) G8_BAR; }
    }
    WAIT_VM(0);
    if constexpr (!Epi::ALIGN) { if (wr == 0) G8_BAR; }
    G8_BAR;
#undef G8_SA
#undef G8_SB
#undef G8_STAGE
#undef G8_STAGE_B
#undef G8_LDA
#undef G8_LDB
#undef G8_MMA
#undef G8_BAR
#undef G8_SCHED
#undef G8_VA
}
}

struct Params { const float* in[23]; float* out; unsigned char* ws; };
enum { I_X = 0, I_C, I_CTX, I_CCTX, I_WMOD, I_BMOD, I_N1G, I_WIN, I_RPB, I_CONVW, I_ALOG, I_DTB, I_DNG, I_DFLAM, I_DFG, I_FTW, I_WOUT, I_N2G, I_WR, I_WG, I_WU, I_WDN, I_FNG };
struct Frame { LAS unsigned char* lds; int tid, lane, wave, G, bid, gw, ngw; };
template <class T> DI T* wsp(const Params& P, size_t off) { return (T*)(P.ws + off); }
DI Frame relaunder(const Frame& F0) { Frame F = F0; LAUNDER_V(F.tid); F.lane = F.tid & 63; F.wave = __builtin_amdgcn_readfirstlane(F.tid >> 6); LAUNDER_S(F.bid); F.gw = F.wave * F.G + F.bid; return F; }
DI float cospi_(float x) { return cosf(3.14159265358979323846f * x); }
DI float sinpi_(float x) { return sinf(3.14159265358979323846f * x); }

struct TItem { const float* src; bf16_t* dst; int ldw, ldt; };
DI TItem p0_decode(const Params& P, int it) {
    constexpr int I_WINc = 10 * 16 * 8, I_ABc = 16, I_WOUTc = 16 * 32, I_Gc = NEXP * 16 * (DEXP / 32), I_Dc = NEXP * (DEXP / 64) * 32;
    constexpr int I_LAYER = I_WINc + I_ABc + I_WOUTc + 2 * I_Gc + I_Dc;
    bf16_t* WinT = wsp<bf16_t>(P, WS_WIN); bf16_t* WoutT = wsp<bf16_t>(P, WS_WOUT); bf16_t* WguT = wsp<bf16_t>(P, WS_WGU); bf16_t* WdT = wsp<bf16_t>(P, WS_WD);
    const int l = it / I_LAYER; int r = it % I_LAYER; TItem t;
    const float* w_in = P.in[I_WIN] + (size_t)l * D * IN_W;
    if (r < I_WINc) { const int g = r / 128, rr = r % 128, kb = ((rr >> 2) / 8) * 4 + (rr & 3), nb = (rr >> 2) % 8; const int so = 256 * g + (g >= 6 ? 16 : 0);
        t.src = w_in + so + nb * 32 + (size_t)64 * kb * IN_W; t.ldw = IN_W; t.dst = WinT + ((size_t)l * NPROJ + g * 256 + nb * 32) * D + 64 * kb; t.ldt = D; return t; }
    r -= I_WINc;
    if (r < I_ABc) { t.src = w_in + 1536 + (size_t)64 * r * IN_W; t.ldw = IN_W; t.dst = WinT + ((size_t)l * NPROJ + 12 * 256) * D + 64 * r; t.ldt = D; return t; }
    r -= I_ABc;
    if (r < I_WOUTc) { const int kb = ((r >> 2) / 32) * 4 + (r & 3), nb = (r >> 2) % 32; t.src = P.in[I_WOUT] + (size_t)l * D * D + nb * 32 + (size_t)64 * kb * D; t.ldw = D; t.dst = WoutT + ((size_t)l * D + nb * 32) * D + 64 * kb; t.ldt = D; return t; }
    r -= I_WOUTc;
    if (r < 2 * I_Gc) { const int up = r >= I_Gc; if (up) r -= I_Gc; const int e = r / (16 * (DEXP / 32)), rr = r % (16 * (DEXP / 32)), kb = ((rr >> 2) / (DEXP / 32)) * 4 + (rr & 3), nb = (rr >> 2) % (DEXP / 32), f0 = 32 * nb;
        t.src = P.in[up ? I_WU : I_WG] + ((size_t)l * NEXP + e) * D * DEXP + f0 + (size_t)64 * kb * DEXP; t.ldw = DEXP;
        t.dst = WguT + (((size_t)l * NEXP + e) * 2 * DEXP + (f0 / 128) * 256 + up * 128 + (f0 % 128)) * D + 64 * kb; t.ldt = D; return t; }
    r -= 2 * I_Gc;
    { const int e = r / ((DEXP / 64) * 32), rr = r % ((DEXP / 64) * 32), kb = ((rr >> 2) / 32) * 4 + (rr & 3), nb = (rr >> 2) % 32;
        t.src = P.in[I_WDN] + ((size_t)l * NEXP + e) * DEXP * D + nb * 32 + (size_t)64 * kb * D; t.ldw = D; t.dst = WdT + (((size_t)l * NEXP + e) * D + nb * 32) * DEXP + 64 * kb; t.ldt = DEXP; }
    return t;
}
DI void p0_weights(const Frame& F0, const Params& P) {
    const Frame F = relaunder(F0);
    LAS float* scr = (LAS float*)(F.lds + F.wave * 8448);
    constexpr int I_LAYER = 10 * 16 * 8 + 16 + 16 * 32 + 2 * NEXP * 16 * (DEXP / 32) + NEXP * (DEXP / 64) * 32, NIT = DEPTH * I_LAYER;
    const int lane = F.lane, lr = lane >> 3, lc = lane & 7;
    f32x4 va[8], vb[8];
#define P0_LOAD(dst_, it_) do { const int itc_ = (it_) < NIT ? (it_) : F.gw; const TItem tl_ = p0_decode(P, itc_); _Pragma("unroll") for (int i = 0; i < 8; ++i) dst_[i] = *(const f32x4*)(tl_.src + (size_t)(8 * i + lr) * tl_.ldw + 4 * lc); } while (0)
#define P0_ITEM(src_, it_, nx_) do { const TItem t_ = p0_decode(P, (it_)); \
        _Pragma("unroll") for (int i = 0; i < 8; ++i) { LAS float* s = scr + (8 * i + lr) * 33 + 4 * lc; s[0] = src_[i].x; s[1] = src_[i].y; s[2] = src_[i].z; s[3] = src_[i].w; } \
        P0_LOAD(src_, (nx_)); \
        WAIT_LGKM(0); CFENCE(); \
        _Pragma("unroll") for (int j = 0; j < 4; ++j) { const int n = lr + 8 * j; const LAS float* s = scr + (8 * lc) * 33 + n; \
            u32x4 o; o.x = pk2(s[0 * 33], s[1 * 33]); o.y = pk2(s[2 * 33], s[3 * 33]); o.z = pk2(s[4 * 33], s[5 * 33]); o.w = pk2(s[6 * 33], s[7 * 33]); \
            *(u32x4*)(t_.dst + (size_t)n * t_.ldt + 8 * lc) = o; } \
        WAIT_LGKM(0); CFENCE(); } while (0)
#define P0_SEQ(j_) ((F.gw + ((j_) >> 2) * F.ngw) * 4 + ((j_) & 3))
    if (P0_SEQ(0) < NIT) { P0_LOAD(va, P0_SEQ(0)); P0_LOAD(vb, P0_SEQ(1)); }
    for (int j = 0; P0_SEQ(j) < NIT; j += 2) {
        P0_ITEM(va, P0_SEQ(j), P0_SEQ(j + 2));
        if (P0_SEQ(j + 1) < NIT) P0_ITEM(vb, P0_SEQ(j + 1), P0_SEQ(j + 3));
    }
#undef P0_SEQ
#undef P0_LOAD
#undef P0_ITEM
}
DI void p0_mod(const Frame& F0, const Params& P) {
    const Frame F = relaunder(F0);
    LAS float* sv = (LAS float*)F.lds;
    LAS f32x2* red = (LAS f32x2*)(sv + (NB + 1) * D);
    float* modL = wsp<float>(P, WS_MODL); float* modC = wsp<float>(P, WS_MODC);
    for (int i = F.tid; i < (NB + 1) * D; i += 512) { const int s = i / D, k = i % D; sv[i] = siluf(s < NB ? P.in[I_C][s * D + k] : P.in[I_CCTX][k]); }
    __syncthreads();
    for (int it = F.bid; it < DEPTH * 48; it += F.G) {
        const int l = it / 48, n = (it % 48) * 128 + 2 * F.lane;
        const float* wm = P.in[I_WMOD] + (size_t)l * D * 6 * D + n;
        f32x2 acc[NB + 1];
#pragma unroll
        for (int s = 0; s <= NB; ++s) acc[s] = (f32x2){0.f, 0.f};
        for (int k0 = F.wave * 128; k0 < F.wave * 128 + 128; k0 += 16) { f32x2 w[16];
#pragma unroll
            for (int i = 0; i < 16; ++i) w[i] = *(const f32x2*)(wm + (size_t)(k0 + i) * 6 * D);
#pragma unroll
            for (int i = 0; i < 16; ++i)
#pragma unroll
                for (int s = 0; s <= NB; ++s) acc[s] += w[i] * sv[s * D + k0 + i]; }
#pragma unroll
        for (int s = 0; s <= NB; ++s) red[(F.wave * (NB + 1) + s) * 64 + F.lane] = acc[s];
        __syncthreads();
        if (F.tid < (NB + 1) * 64) { const int s = F.tid / 64, ln = F.tid % 64; f32x2 v = {0.f, 0.f};
            for (int w = 0; w < 8; ++w) v += red[(w * (NB + 1) + s) * 64 + ln];
            const int nn = (it % 48) * 128 + 2 * ln; v += *(const f32x2*)(P.in[I_BMOD] + (size_t)l * 6 * D + nn);
            *(f32x2*)((s < NB ? modL + ((size_t)l * NB + s) * 6 * D : modC + (size_t)l * 6 * D) + nn) = v; }
        __syncthreads();
    }
}
DI void p0_misc(const Frame& F0, const Params& P) {
    const Frame F = relaunder(F0);
    const size_t gt = (size_t)F.bid * 512 + F.tid, ngt = (size_t)F.G * 512;
    { float* rope = wsp<float>(P, WS_ROPE);
      for (size_t i = gt; i < (size_t)SEQ * 16; i += ngt) { const int t = (int)(i / 16), p = (int)(i % 16); const float pos = (p < 8) ? (float)(t / GRIDW) : (float)(t % GRIDW);
          const float inv = exp2f(-(float)(p & 7) * (13.287712379549449f / 8.0f));     const float ang = pos * inv; rope[2 * i] = cosf(ang); rope[2 * i + 1] = sinf(ang); } }
    { LAS float* ct = (LAS float*)F.lds;
      for (int m = F.tid; m < SEQ; m += 512) ct[m] = cospi_(2.0f * (float)m / (float)SEQ);
      __syncthreads();
      bf16_t* dl = wsp<bf16_t>(P, WS_DFTL); const float sc = 1.0f / sqrtf((float)SEQ);
      for (size_t i = gt; i < (size_t)(HSEQ + 1) * SEQ / 2; i += ngt) { const int k = (int)(i / (SEQ / 2)), t = 2 * (int)(i % (SEQ / 2));     const int m0 = (int)(((long long)k * t) % SEQ), m1 = (m0 + k) % SEQ;
          *(unsigned*)(dl + (size_t)k * 2 * SEQ + t) = pk2(ct[m0] * sc, ct[m1] * sc);
          *(unsigned*)(dl + (size_t)k * 2 * SEQ + SEQ + t) = pk2(ct[(m0 + 3 * SEQ / 4) % SEQ] * sc, ct[(m1 + 3 * SEQ / 4) % SEQ] * sc); }
      bf16_t* dc = wsp<bf16_t>(P, WS_DFTC); const float scc = 1.0f / sqrtf((float)CTX); constexpr int STEP = SEQ / CTX;
      for (size_t i = gt; i < (size_t)CTX * 2 * CTX; i += ngt) { const int k = (int)(i / (2 * CTX)), c = (int)(i % (2 * CTX)), t = c % CTX; const int m = ((k * t) % CTX) * STEP;
          dc[(size_t)k * 2 * SEQ + c] = f2bf((c < CTX ? ct[m] : ct[(m + 3 * SEQ / 4) % SEQ]) * scc); }
      __syncthreads(); }
    { bf16_t* mz = wsp<bf16_t>(P, WS_MZT);
      for (size_t i = gt; i < (size_t)DEPTH * 512 * 256; i += ngt) { const int l = (int)(i / (512 * 256)), np = (int)((i / 256) % 512), c = (int)(i % 256); const int n = np & 255, g0 = c & ~63;
          const float* fw = P.in[I_FTW] + (size_t)l * 256 * 256; float a = 0.f;
          for (int j = 0; j < 64; ++j) { const int m = ((c & 63) * j) & 63; const float x = 2.0f * (float)m / 64.0f; const float tr = (np < 256) ? cospi_(x) : -sinpi_(x); a += tr * fw[(size_t)(g0 + j) * 256 + n]; }
          mz[i] = f2bf(a * 0.125f); }
      bf16_t* wf = wsp<bf16_t>(P, WS_WFT);
      for (size_t i = gt; i < (size_t)DEPTH * D * 256; i += ngt) { const int l = (int)(i / (D * 256)), k = (int)((i / 256) % D), c = (int)(i % 256); wf[i] = f2bf(P.in[I_WIN][((size_t)l * D + k) * IN_W + 2576 + c]); } }
    { int* ridx = wsp<int>(P, WS_RIDX); for (size_t i = gt; i < (size_t)NEXP * EROWS_PAD; i += ngt) ridx[i] = 0; }
}

DI void phase_norm1(const Frame& F0, const Params& P, const int l) {
    const Frame F = relaunder(F0);
    float* xres = wsp<float>(P, WS_XRES); bf16_t* hb = wsp<bf16_t>(P, WS_H);
    const int* inv = wsp<int>(P, WS_INV); const bf16_t* yb = wsp<bf16_t>(P, WS_Y);
    const float* modL = wsp<float>(P, WS_MODL); const float* modC = wsp<float>(P, WS_MODC);
    const bool fin = (l == DEPTH);
    const int nrows = fin ? R_LAT : RT;
    const int R1 = (nrows + F.ngw - 1) / F.ngw;
    if (F.gw * R1 >= nrows) return;
    const int rend = (F.gw * R1 + R1 < nrows) ? F.gw * R1 + R1 : nrows;
    constexpr int NSL = 4;
#define N1_XSRC(r_) ((l <= 1) ? (const f32x4*)((r_) < R_LAT ? P.in[I_X] + (size_t)(r_) * D : P.in[I_CTX] + (size_t)((r_) - R_LAT) * D) + F.lane : (const f32x4*)(xres + (size_t)(r_) * D) + F.lane)
#define N1_LDINV(r_) do { _Pragma("unroll") for (int e_ = 0; e_ < NEXP; ++e_) ivv[e_ >> 2][e_ & 3] = inv[(size_t)e_ * RT + (r_)]; } while (0)
#define N1_ISSUE(r_) do { \
        _Pragma("unroll") for (int k_ = 0; k_ < NSL; ++k_) sl[k_] = -1; \
        if (l > 0) { int cnt_ = 0; \
            _Pragma("unroll") for (int e_ = 0; e_ < NEXP; ++e_) { const int ix_ = __builtin_amdgcn_readfirstlane(ivv[e_ >> 2][e_ & 3]); \
                if (ix_ >= 0) { _Pragma("unroll") for (int k_ = 0; k_ < NSL; ++k_) sl[k_] = (cnt_ == k_) ? ix_ : sl[k_]; ++cnt_; } } \
            nsel = cnt_; } \
        { const f32x4* xs_ = N1_XSRC(r_); _Pragma("unroll") for (int j_ = 0; j_ < 4; ++j_) xn[j_] = xs_[64 * j_]; } \
        if (l > 0) { const u32x2* dm_ = (const u32x2*)(dmix + (size_t)(r_) * D) + F.lane; _Pragma("unroll") for (int j_ = 0; j_ < 4; ++j_) dn[j_] = dm_[64 * j_]; } \
        if (l > 0) { _Pragma("unroll") for (int k_ = 0; k_ < NSL; ++k_) { const u32x2* yr_ = (const u32x2*)(yb + (size_t)(sl[k_] < 0 ? 0 : sl[k_]) * D) + F.lane; \
            _Pragma("unroll") for (int j_ = 0; j_ < 4; ++j_) yn[k_][j_] = yr_[64 * j_]; } } } while (0)
    const bf16_t* dmix = wsp<bf16_t>(P, WS_DMIX);
    i32x4 ivv[NEXP / 4]; int sl[NSL], nsel = 0; f32x4 xn[4]; u32x2 yn[NSL][4]; u32x2 dn[4];
    int row = F.gw * R1;
    if (l > 0) N1_LDINV(row);
    N1_ISSUE(row);
    { const int r1 = row + 1 < rend ? row + 1 : row; if (l > 0) N1_LDINV(r1); }
    f32x4 mg5[4], mgn[4], msh[4], mscl[4]; int bkey = -2;
    { const f32x4* g = (fin ? (const f32x4*)P.in[I_FNG] : (const f32x4*)(P.in[I_N1G] + (size_t)l * D)) + F.lane;
#pragma unroll
      for (int j = 0; j < 4; ++j) mgn[j] = g[64 * j]; }
    for (; row < rend; ++row) {
        const bool lat = row < R_LAT; const int b = lat ? row / SEQ : 0;
        if ((lat ? b : -1) != bkey) { bkey = lat ? b : -1;
            if (l > 0) { const float* mp = (lat ? modL + ((size_t)(l - 1) * NB + b) * 6 * D : modC + (size_t)(l - 1) * 6 * D) + 5 * D;
#pragma unroll
                for (int j = 0; j < 4; ++j) mg5[j] = *((const f32x4*)mp + F.lane + 64 * j); }
            if (!fin) { const float* mp = lat ? modL + ((size_t)l * NB + b) * 6 * D : modC + (size_t)l * 6 * D;
#pragma unroll
                for (int j = 0; j < 4; ++j) { msh[j] = *((const f32x4*)mp + F.lane + 64 * j); mscl[j] = *((const f32x4*)(mp + D) + F.lane + 64 * j); } } }
        f32x4* xr = (f32x4*)(xres + (size_t)row * D) + F.lane;
        f32x4 v[4]; u32x2 y[NSL][4]; int sc[NSL]; const int nc = nsel;
#pragma unroll
        for (int j = 0; j < 4; ++j) { v[j] = xn[j]; if (l > 0) { const u32x2 w = dn[j]; v[j] += (f32x4){bflo(w.x), bfhi(w.x), bflo(w.y), bfhi(w.y)}; } }
#pragma unroll
        for (int k = 0; k < NSL; ++k) { sc[k] = sl[k];
#pragma unroll
            for (int j = 0; j < 4; ++j) y[k][j] = yn[k][j]; }
        { const int r1 = row + 1 < rend ? row + 1 : row, r2 = r1 + 1 < rend ? r1 + 1 : r1;
          N1_ISSUE(r1);
          if (l > 0) N1_LDINV(r2); }
        if (l > 0) {
            f32x4 s[4];
#pragma unroll
            for (int j = 0; j < 4; ++j) s[j] = (f32x4){0.f, 0.f, 0.f, 0.f};
#pragma unroll
            for (int k = 0; k < NSL; ++k) if (sc[k] >= 0) {
#pragma unroll
                for (int j = 0; j < 4; ++j) { const u32x2 w = y[k][j]; s[j] += (f32x4){bflo(w.x), bfhi(w.x), bflo(w.y), bfhi(w.y)}; } }
            if (nc > NSL) { int seen = 0;
                for (int e = 0; e < NEXP; ++e) { const int ix = __builtin_amdgcn_readfirstlane(inv[(size_t)e * RT + row]);
                    if (ix >= 0) { if (seen >= NSL) { const u32x2* yr = (const u32x2*)(yb + (size_t)ix * D) + F.lane;
#pragma unroll
                            for (int j = 0; j < 4; ++j) { const u32x2 w = yr[64 * j]; s[j] += (f32x4){bflo(w.x), bfhi(w.x), bflo(w.y), bfhi(w.y)}; } }
                        ++seen; } } }
#pragma unroll
            for (int j = 0; j < 4; ++j) { v[j] += mg5[j] * s[j]; xr[64 * j] = v[j]; }
        }
        float ss = 0.f;
#pragma unroll
        for (int j = 0; j < 4; ++j) ss += (v[j].x * v[j].x + v[j].y * v[j].y) + (v[j].z * v[j].z + v[j].w * v[j].w);
        const float rstd = 1.0f / sqrtf(wave_sum(ss) * (1.0f / D) + RMS_EPS);
        if (fin) {
            f32x4* o = (f32x4*)(P.out + (size_t)row * D) + F.lane;
#pragma unroll
            for (int j = 0; j < 4; ++j) o[64 * j] = v[j] * rstd * mgn[j];
        } else {
            u32x2* ho = (u32x2*)(hb + (size_t)row * D) + F.lane;
#pragma unroll
            for (int j = 0; j < 4; ++j) { const f32x4 sh = msh[j], scl = mscl[j];
                const f32x4 hv = v[j] * rstd * mgn[j] * (scl + 1.0f) + sh; u32x2 w; w.x = pk2(hv.x, hv.y); w.y = pk2(hv.z, hv.w); ho[64 * j] = w; }
        }
    }
#undef N1_XSRC
#undef N1_LDINV
#undef N1_ISSUE
}
constexpr int lg2c(int x) { return x <= 1 ? 0 : 1 + lg2c(x / 2); }
template <int N> struct RouterRed {
    template <int OFF> static DI float run(float (&v)[N], int lane) {
        float w[N / 2];
        const bool up = (lane & OFF) != 0;
#pragma unroll
        for (int i = 0; i < N / 2; ++i) { const float send = up ? v[i] : v[i + N / 2], keep = up ? v[i + N / 2] : v[i]; w[i] = keep + __shfl_xor(send, OFF); }
        return RouterRed<N / 2>::template run<OFF / 2>(w, lane);
    }
};
template <> struct RouterRed<1> { template <int OFF> static DI float run(float (&v)[1], int) { float x = v[0];
#pragma unroll
        for (int o = OFF; o >= 1; o >>= 1) x += __shfl_xor(x, o);
        return x; } };
DI void phase_norm2(const Frame& F0, const Params& P, const int l) {
    const Frame F = relaunder(F0);
    const float* xres = wsp<float>(P, WS_XRES); bf16_t* hb = wsp<bf16_t>(P, WS_H); float* aff = wsp<float>(P, WS_AFF);
    const float* modL = wsp<float>(P, WS_MODL); const float* modC = wsp<float>(P, WS_MODC);
    const float* wr = P.in[I_WR] + (size_t)l * D * NEXP;
    constexpr int EC = NEXP / 4, LGE = lg2c(NEXP);
    LAS f32x4* wl = (LAS f32x4*)F.lds;
    for (int i = F.tid; i < 16 * EC * 64; i += 512) { const int ln = i & 63, c = (i >> 6) % EC, jq = (i >> 6) / EC, col = 4 * ln + 256 * (jq >> 2) + (jq & 3);
        wl[i] = *(const f32x4*)(wr + (size_t)col * NEXP + 4 * c); }
    __syncthreads();
    const int lane = F.lane;
    int elane = 0;
#pragma unroll
    for (int s = 0; s < LGE; ++s) elane |= ((lane >> (5 - s)) & 1) << (LGE - 1 - s);
    const int nrows = (l < DEPTH - 1) ? RT : R_LAT;
    const bf16_t* dmix = wsp<bf16_t>(P, WS_DMIX);
#define N2_XSRC(r_) ((l == 0) ? (const f32x4*)((r_) < R_LAT ? P.in[I_X] + (size_t)(r_) * D : P.in[I_CTX] + (size_t)((r_) - R_LAT) * D) + lane : (const f32x4*)(xres + (size_t)(r_) * D) + lane)
    f32x4 vn[4]; u32x2 dn[4];
    const int R2 = (nrows + F.ngw - 1) / F.ngw, rbeg = F.gw * R2, rend = (rbeg + R2 < nrows) ? rbeg + R2 : nrows;
    { const int r0 = rbeg < nrows ? rbeg : 0; const f32x4* xr = N2_XSRC(r0); const u32x2* dm = (const u32x2*)(dmix + (size_t)r0 * D) + lane;
#pragma unroll
      for (int j = 0; j < 4; ++j) { vn[j] = xr[64 * j]; dn[j] = dm[64 * j]; } }
    f32x4 mg[4], msh[4], mscl[4]; int bkey = -2;
    { const f32x4* g = (const f32x4*)(P.in[I_N2G] + (size_t)l * D) + lane;
#pragma unroll
      for (int j = 0; j < 4; ++j) mg[j] = g[64 * j]; }
    for (int row = rbeg; row < rend; ++row) {
        const bool lat = row < R_LAT; const int b = lat ? row / SEQ : 0;
        if ((lat ? b : -1) != bkey) { bkey = lat ? b : -1; const float* mp = lat ? modL + ((size_t)l * NB + b) * 6 * D : modC + (size_t)l * 6 * D;
#pragma unroll
            for (int j = 0; j < 4; ++j) { msh[j] = *((const f32x4*)(mp + 3 * D) + lane + 64 * j); mscl[j] = *((const f32x4*)(mp + 4 * D) + lane + 64 * j); } }
        const LAS f32x4* wlr = wl; LAUNDER_V(wlr);
        f32x4 v[4]; float ss = 0.f;
#pragma unroll
        for (int j = 0; j < 4; ++j) { const u32x2 w = dn[j]; v[j] = vn[j] + (f32x4){bflo(w.x), bfhi(w.x), bflo(w.y), bfhi(w.y)}; ss += (v[j].x * v[j].x + v[j].y * v[j].y) + (v[j].z * v[j].z + v[j].w * v[j].w); }
        { const int rn = row + 1 < rend ? row + 1 : row; const f32x4* xr = N2_XSRC(rn); const u32x2* dm = (const u32x2*)(dmix + (size_t)rn * D) + lane;
#pragma unroll
          for (int j = 0; j < 4; ++j) { vn[j] = xr[64 * j]; dn[j] = dm[64 * j]; } }
        const float rstd = 1.0f / sqrtf(wave_sum(ss) * (1.0f / D) + RMS_EPS);
        u32x2* ho = (u32x2*)(hb + (size_t)row * D) + lane;
        float lg[NEXP];
#pragma unroll
        for (int e = 0; e < NEXP; ++e) lg[e] = 0.f;
#pragma unroll
        for (int j = 0; j < 4; ++j) { const float* mpx = lat ? modL + ((size_t)l * NB + b) * 6 * D : modC + (size_t)l * 6 * D; const f32x4 sh = *((const f32x4*)(mpx + 3 * D) + lane + 64 * j), scl = *((const f32x4*)(mpx + 4 * D) + lane + 64 * j);
            const f32x4 hv = v[j] * rstd * mg[j] * (scl + 1.0f) + sh; u32x2 w; w.x = pk2(hv.x, hv.y); w.y = pk2(hv.z, hv.w); ho[64 * j] = w;
#pragma unroll
            for (int q = 0; q < 4; ++q)
#pragma unroll
                for (int c = 0; c < EC; ++c) { const f32x4 wv = wlr[((j * 4 + q) * EC + c) * 64 + lane]; lg[4 * c] += hv[q] * wv.x; lg[4 * c + 1] += hv[q] * wv.y; lg[4 * c + 2] += hv[q] * wv.z; lg[4 * c + 3] += hv[q] * wv.w; } }
        const float logit = RouterRed<NEXP>::template run<32>(lg, lane);
        float mx = logit;
#pragma unroll
        for (int s = 0; s < LGE; ++s) mx = fmaxf(mx, __shfl_xor(mx, 32 >> s));
        const float ex = __expf(logit - mx); float sum = ex;
#pragma unroll
        for (int s = 0; s < LGE; ++s) sum += __shfl_xor(sum, 32 >> s);
        if ((lane & ((64 >> LGE) - 1)) == 0) aff[(size_t)row * NEXP + elane] = ex / sum;
    }
    __syncthreads();
}

DI int xcd_remap(int L, int total) { const int q = total / 8, r = total % 8, x = L % 8, off = L / 8; return (x < r ? x * (q + 1) : r * (q + 1) + (x - r) * q) + off; }
DI void decode2d(int L, int nM, int nN, int& pm, int& pn) { const int nig = 8 * nN, gid = L / nig, fm = gid * 8, gsz = (nM - fm) < 8 ? (nM - fm) : 8; pm = fm + (L % nig) % gsz; pn = (L % nig) / gsz; }

struct SchedW {
    int G, c; const char* mz; const char* wf;
    DI bool next(int i, g8::Unit& u) const { const int L = i * G + c; if (L >= DEPTH * 8) return false; const int l = L / 8, pm = (L % 8) / 4, pn = L % 4;
        u.A = mz + ((size_t)l * 512 + pm * 256) * 256 * 2; u.B = wf + ((size_t)l * D + pn * 256) * 256 * 2; u.gidx = nullptr; u.pm = pm; u.pn = pn; u.aux = l; u.nt = 4; u.half = 0; return true; }
};
struct EpiW { static constexpr bool ALIGN = G8_ALIGN_W; static constexpr bool PERM = true; bf16_t* WinT;
    DI void operator()(const f32x4 (&acc)[2][2][4][2], const g8::Unit& u, int wr, int wc, int fr, int fq) const {
#pragma unroll
        for (int ai = 0; ai < 2; ++ai)
#pragma unroll
            for (int m = 0; m < 4; ++m) { const int r = u.pm * 256 + ai * 128 + wr * 64 + m * 16 + fr; bf16_t* rowp = WinT + ((size_t)u.aux * NPROJ + 2560 + r) * D + u.pn * 256 + wc * 32 + 8 * fq;
#pragma unroll
                for (int bj = 0; bj < 2; ++bj) { const f32x4 v0 = acc[ai][bj][m][0], v1 = acc[ai][bj][m][1]; u32x4 w; w.x = pk2(v0.x, v0.y); w.y = pk2(v0.z, v0.w); w.z = pk2(v1.x, v1.y); w.w = pk2(v1.z, v1.w); *(u32x4*)(rowp + bj * 128) = w; } }
    }
};
struct SchedProj {
    int G, c, last; const char* A; const char* B;
    DI bool next(int i, g8::Unit& u) const {
        constexpr int nLat = R_LAT / 256, nCtx = R_CTX / 256;
        const int ntc = last ? 8 : NTILE, total = nLat * NTILE + nCtx * ntc;
        int L = i * G + c; if (L >= total) return false; L = xcd_remap(L, total);
        int pm, pn;
        if (L < nLat * NTILE) decode2d(L, nLat, NTILE, pm, pn);
        else { L -= nLat * NTILE; pm = nLat + L / ntc; pn = L % ntc; if (last) { const int k = pn; pn = (k < 5) ? k + 1 : (k == 5 ? 8 : (k == 6 ? 9 : 12)); } }
        u.A = A + (size_t)pm * 256 * D * 2; u.B = B + (size_t)pn * 256 * D * 2; u.gidx = nullptr; u.pm = pm; u.pn = pn; u.aux = 0; u.nt = D / 64; u.half = 0; return true; }
};
struct EpiProj { static constexpr bool ALIGN = G8_ALIGN_PROJ; static constexpr bool PERM = true; bf16_t* proj; float* ab; bf16_t* ztl; bf16_t* ztc; const float* rope;
    DI void operator()(const f32x4 (&acc)[2][2][4][2], const g8::Unit& u, int wr, int wc, int fr, int fq) const {
        const int pn = u.pn; const bool lat = u.pm * 256 < R_LAT;
#pragma unroll
        for (int ai = 0; ai < 2; ++ai)
#pragma unroll
            for (int m = 0; m < 4; ++m) {
                const int row = u.pm * 256 + ai * 128 + wr * 64 + m * 16 + fr;
                int b, t; if (lat) { b = row / SEQ; t = row % SEQ; } else { const int rr = row - R_LAT; b = rr / CTX; t = rr % CTX; }
#pragma unroll
                for (int bj = 0; bj < 2; ++bj) {
                    const int c8 = 128 * bj + 32 * wc + 8 * fq; f32x4 v0 = acc[ai][bj][m][0], v1 = acc[ai][bj][m][1];
                    if (pn == 0) { v0 = v0 * (0.125f * LOG2E); v1 = v1 * (0.125f * LOG2E); }
                    if (pn == 7) { v0 = v0 * (0.17677669529663687f * LOG2E); v1 = v1 * (0.17677669529663687f * LOG2E); }
                    if (pn < 10) {
                        if ((pn == 7 || pn == 8) && lat) { const f32x4* cs = (const f32x4*)(rope + ((size_t)t * 16 + 4 * fq) * 2); const f32x4 c0 = cs[0], c1 = cs[1];
                            v0 = (f32x4){v0.x * c0.x - v0.y * c0.y, v0.x * c0.y + v0.y * c0.x, v0.z * c0.z - v0.w * c0.w, v0.z * c0.w + v0.w * c0.z};
                            v1 = (f32x4){v1.x * c1.x - v1.y * c1.y, v1.x * c1.y + v1.y * c1.x, v1.z * c1.z - v1.w * c1.w, v1.z * c1.w + v1.w * c1.z}; }
                        u32x4 w; w.x = pk2(v0.x, v0.y); w.y = pk2(v0.z, v0.w); w.z = pk2(v1.x, v1.y); w.w = pk2(v1.z, v1.w);
                        *(u32x4*)(proj + (size_t)row * PLD + pn * 256 + c8) = w;
                    } else if (pn < 12) {
                        bf16_t* base = (lat ? ztl : ztc) + ((size_t)(b * 256 + c8)) * (2 * SEQ) + (pn - 10) * (lat ? SEQ : CTX) + t;
#pragma unroll
                        for (int j = 0; j < 4; ++j) { base[(size_t)j * 2 * SEQ] = f2bf(v0[j]); base[(size_t)(j + 4) * 2 * SEQ] = f2bf(v1[j]); }
                    } else if (bj == 0 && wc == 0 && fq < 2) { f32x4* o = (f32x4*)(ab + (size_t)row * 16 + 8 * fq); o[0] = v0; o[1] = v1; }
                }
            }
    }
};
struct SchedOut {
    int G, c, last; const char* A; const char* B;
    DI bool next(int i, g8::Unit& u) const { const int nM = last ? R_LAT / 256 : RT / 256, total = nM * 4; int L = i * G + c; if (L >= total) return false; L = xcd_remap(L, total);
        int pm, pn; decode2d(L, nM, 4, pm, pn);
        u.A = A + (size_t)pm * 256 * D * 2; u.B = B + (size_t)pn * 256 * D * 2; u.gidx = nullptr; u.pm = pm; u.pn = pn; u.aux = 0; u.nt = D / 64; u.half = 0; return true; }
};
struct EpiOut { static constexpr bool ALIGN = G8_ALIGN_OUT; static constexpr bool PERM = true; bf16_t* dmix; const float* modL; const float* modC;
    DI void operator()(const f32x4 (&acc)[2][2][4][2], const g8::Unit& u, int wr, int wc, int fr, int fq) const {
        const bool lat = u.pm * 256 < R_LAT; const int b = lat ? (u.pm * 256) / SEQ : 0;
        const float* g2 = lat ? modL + (size_t)b * 6 * D : modC;
#pragma unroll
        for (int bj = 0; bj < 2; ++bj) { const int c = u.pn * 256 + 128 * bj + 32 * wc + 8 * fq; const f32x4 g0 = *(const f32x4*)(g2 + c), g1 = *(const f32x4*)(g2 + c + 4);
#pragma unroll
            for (int ai = 0; ai < 2; ++ai)
#pragma unroll
                for (int m = 0; m < 4; ++m) { const int row = u.pm * 256 + ai * 128 + wr * 64 + m * 16 + fr; const f32x4 v0 = g0 * acc[ai][bj][m][0], v1 = g1 * acc[ai][bj][m][1];
                    u32x4 w; w.x = pk2(v0.x, v0.y); w.y = pk2(v0.z, v0.w); w.z = pk2(v1.x, v1.y); w.w = pk2(v1.z, v1.w); *(u32x4*)(dmix + (size_t)row * D + c) = w; } }
    }
};
struct SchedDft {
    int G, c, lat_on, ctx_on; const char* dl; const char* dc; const char* zl; const char* zc;
    DI bool next(int i, g8::Unit& u) const { constexpr int nlatc = (HSEQ / 256) * 2 * KSPLIT * NB, nctx = (CTX / 256) * NB; const int nlat = lat_on ? nlatc : 0, nc = ctx_on ? nctx : 0, total = nlat + nc;
        int L = i * G + c; if (L >= total) return false;
        if (L >= nc) { L = xcd_remap(L - nc, nlat); const int b = L % NB, ks = (L / NB) % (2 * KSPLIT), pm = L / (NB * 2 * KSPLIT);
            const size_t ko = (ks < KSPLIT) ? (size_t)ks * KCH : (size_t)SEQ + (size_t)(ks - KSPLIT) * KCH;
            u.A = dl + ((size_t)(1 + pm * 256) * 2 * SEQ + ko) * 2; u.B = zl + ((size_t)b * 256 * 2 * SEQ + ko) * 2; u.pm = pm; u.pn = b; u.aux = ks; u.nt = KCH / 64; }
        else { const int b = L % NB, pm = L / NB; u.A = dc + (size_t)pm * 256 * 2 * SEQ * 2; u.B = zc + (size_t)b * 256 * 2 * SEQ * 2; u.pm = pm; u.pn = b; u.aux = -1; u.nt = 2 * CTX / 64; }
        u.gidx = nullptr; u.half = 0; return true; }
};
struct EpiDft { static constexpr bool ALIGN = G8_ALIGN_DFT; static constexpr bool PERM = false; float* slab; float* slabc;
    DI void operator()(const f32x4 (&acc)[2][2][4][2], const g8::Unit& u, int wr, int wc, int fr, int fq) const {
        float* base = (u.aux >= 0) ? slab + ((size_t)u.aux * (NB * HSEQ) + (size_t)u.pn * HSEQ + u.pm * 256) * 256 : slabc + ((size_t)u.pn * CTX + u.pm * 256) * 256;
#pragma unroll
        for (int ai = 0; ai < 2; ++ai)
#pragma unroll
            for (int m = 0; m < 4; ++m) { float* rowp = base + (size_t)(ai * 128 + wr * 64 + m * 16 + fr) * 256 + 32 * wc + 4 * fq;
#pragma unroll
                for (int bj = 0; bj < 2; ++bj)
#pragma unroll
                    for (int n = 0; n < 2; ++n) *(f32x4*)(rowp + 128 * bj + 16 * n) = acc[ai][bj][m][n]; }
    }
};
constexpr bool EHALF = (EROWS % 256 != 0) && (EROWS % 256 <= 128);
struct SchedGU {
    int G, c, epan; const char* A; const char* B; const int* ridx;
    DI bool next(int i, g8::Unit& u) const { constexpr int NN = 2 * DEXP / 256; const int total = NEXP * epan * NN; int L = i * G + c; if (L >= total) return false;
        const bool hp = EHALF && (epan == EROWS_PAD / 256); const int ef = hp ? epan - 1 : epan, nfull = NEXP * ef * NN;
        int e, pn, pm, hf = 0;
        if (L < nfull) { L = xcd_remap(L, nfull); e = L / (ef * NN); const int rem = L % (ef * NN); pn = rem / ef; pm = rem % ef; }
        else { L -= nfull; e = L / NN; pn = L % NN; pm = epan - 1; hf = 1; }
        u.A = A; u.gidx = ridx + (size_t)e * EROWS_PAD + pm * 256; u.B = B + ((size_t)e * 2 * DEXP + pn * 256) * D * 2; u.pm = e * (EROWS_PAD / 256) + pm; u.pn = pn; u.aux = e; u.nt = D / 64; u.half = hf; return true; }
};
struct EpiGU { static constexpr bool ALIGN = G8_ALIGN_GU; static constexpr bool PERM = true; bf16_t* hid;
    DI void operator()(const f32x4 (&acc)[2][2][4][2], const g8::Unit& u, int wr, int wc, int fr, int fq) const {
#pragma unroll
        for (int ai = 0; ai < 2; ++ai)
#pragma unroll
            for (int m = 0; m < 4; ++m) { if (ai == 1 && u.half) continue; const int row = u.pm * 256 + ai * 128 + wr * 64 + m * 16 + fr;
                const f32x4 g0 = acc[ai][0][m][0], g1 = acc[ai][0][m][1], u0 = acc[ai][1][m][0], u1 = acc[ai][1][m][1];
                u32x4 w; w.x = pk2(siluf(g0.x) * u0.x, siluf(g0.y) * u0.y); w.y = pk2(siluf(g0.z) * u0.z, siluf(g0.w) * u0.w); w.z = pk2(siluf(g1.x) * u1.x, siluf(g1.y) * u1.y); w.w = pk2(siluf(g1.z) * u1.z, siluf(g1.w) * u1.w);
                *(u32x4*)(hid + (size_t)row * DEXP + u.pn * 128 + 32 * wc + 8 * fq) = w; }
    }
};
struct SchedDown {
    int G, c, epan; const char* A; const char* B;
    DI bool next(int i, g8::Unit& u) const { const int total = NEXP * epan * 4; int L = i * G + c; if (L >= total) return false;
        const bool hp = EHALF && (epan == EROWS_PAD / 256); const int ef = hp ? epan - 1 : epan, nfull = NEXP * ef * 4;
        int e, pn, pm, hf = 0;
        if (L < nfull) { L = xcd_remap(L, nfull); e = L / (ef * 4); const int rem = L % (ef * 4); pn = rem / ef; pm = rem % ef; }
        else { L -= nfull; e = L / 4; pn = L % 4; pm = epan - 1; hf = 1; }
        u.A = A + ((size_t)e * EROWS_PAD + pm * 256) * DEXP * 2; u.gidx = nullptr; u.B = B + ((size_t)e * D + pn * 256) * DEXP * 2; u.pm = e * (EROWS_PAD / 256) + pm; u.pn = pn; u.aux = e; u.nt = DEXP / 64; u.half = hf; return true; }
};
struct EpiDown { static constexpr bool ALIGN = G8_ALIGN_DOWN; static constexpr bool PERM = true; bf16_t* y; const float* gatev;
    DI void operator()(const f32x4 (&acc)[2][2][4][2], const g8::Unit& u, int wr, int wc, int fr, int fq) const {
#pragma unroll
        for (int ai = 0; ai < 2; ++ai)
#pragma unroll
            for (int m = 0; m < 4; ++m) { if (ai == 1 && u.half) continue; const int row = u.pm * 256 + ai * 128 + wr * 64 + m * 16 + fr; const float gv = gatev[row];
#pragma unroll
                for (int bj = 0; bj < 2; ++bj) { const f32x4 v0 = acc[ai][bj][m][0] * gv, v1 = acc[ai][bj][m][1] * gv; u32x4 w; w.x = pk2(v0.x, v0.y); w.y = pk2(v0.z, v0.w); w.z = pk2(v1.x, v1.y); w.w = pk2(v1.z, v1.w);
                    *(u32x4*)(y + (size_t)row * D + u.pn * 256 + 128 * bj + 32 * wc + 8 * fq) = w; } }
    }
};

DI int block_sum_i(const Frame& F, int v, LAS int* tmp) {
#pragma unroll
    for (int o = 1; o < 64; o <<= 1) v += __shfl_xor(v, o);
    if (F.lane == 0) tmp[F.wave] = v;
    __syncthreads();
    int s = 0;
#pragma unroll
    for (int w = 0; w < 8; ++w) s += tmp[w];
    __syncthreads();
    return s;
}
DI int block_excl_scan_i(const Frame& F, int v, LAS int* tmp) {
    int inc = v;
#pragma unroll
    for (int o = 1; o < 64; o <<= 1) { const int t = __shfl_up(inc, o); if (F.lane >= o) inc += t; }
    if (F.lane == 63) tmp[F.wave] = inc;
    __syncthreads();
    int base = 0;
#pragma unroll
    for (int w = 0; w < 8; ++w) base += (w < F.wave) ? tmp[w] : 0;
    __syncthreads();
    return base + inc - v;
}
template <int KPT>
DI void topk_problem(const Frame& F, const float* aff, int* ridx, float* gatev, int* inv, int e, int N, int cap, int rowbase, int slotbase) {
    LAS int* tmp = (LAS int*)F.lds;
    unsigned key[KPT];
#pragma unroll
    for (int j = 0; j < KPT; ++j) { const int tok = F.tid * KPT + j; key[j] = (tok < N) ? __float_as_uint(aff[(size_t)(rowbase + tok) * NEXP + e]) : 0u; }
    unsigned T = 0u;
    for (int bit = 31; bit >= 0; --bit) { const unsigned cand = T | (1u << bit); int c = 0;
#pragma unroll
        for (int j = 0; j < KPT; ++j) c += (key[j] >= cand) ? 1 : 0;
        if (block_sum_i(F, c, tmp) >= cap) T = cand; }
    int cg = 0, ce = 0;
#pragma unroll
    for (int j = 0; j < KPT; ++j) { cg += (key[j] > T) ? 1 : 0; ce += (key[j] == T) ? 1 : 0; }
    const int need_eq = cap - block_sum_i(F, cg, tmp);
    int eqb = block_excl_scan_i(F, ce, tmp);
    int sel[KPT]; int ns = 0;
#pragma unroll
    for (int j = 0; j < KPT; ++j) { const bool s = (key[j] > T) || (key[j] == T && eqb < need_eq); if (key[j] == T) ++eqb; sel[j] = s ? 1 : 0; ns += sel[j]; }
    int ord = block_excl_scan_i(F, ns, tmp);
#pragma unroll
    for (int j = 0; j < KPT; ++j) { const int tok = F.tid * KPT + j; if (tok < N) { const int row = rowbase + tok; int ix = -1;
            if (sel[j]) { ix = e * EROWS_PAD + slotbase + ord; ridx[ix] = row; gatev[ix] = __uint_as_float(key[j]); ++ord; }
            inv[(size_t)e * RT + row] = ix; } }
}
DI void phase_topk(const Frame& F0, const Params& P, const int l) {
    const Frame F = relaunder(F0);
    const float* aff = wsp<float>(P, WS_AFF); int* ridx = wsp<int>(P, WS_RIDX); float* gatev = wsp<float>(P, WS_GATEV); int* inv = wsp<int>(P, WS_INV);
    const int nprob = NEXP * NB * ((l < DEPTH - 1) ? 2 : 1);
    for (int p = F.bid; p < nprob; p += F.G) { const int seg = p / (NEXP * NB), b = (p / NEXP) % NB, e = p % NEXP;
        if (seg == 0) topk_problem<(SEQ + 511) / 512>(F, aff, ridx, gatev, inv, e, SEQ, CAP_LAT, b * SEQ, b * CAP_LAT);
        else topk_problem<(CTX + 511) / 512>(F, aff, ridx, gatev, inv, e, CTX, CAP_CTX, R_LAT + b * CTX, NB * CAP_LAT + b * CAP_CTX); }
}

DI float softplusf_(float x) { const float t = __expf(-fabsf(x)); return fmaxf(x, 0.f) + (t < 1e-3f ? t * (1.0f - 0.5f * t) : __logf(1.0f + t)); }
DI float fexp2(float x) { return __builtin_amdgcn_exp2f(x); }
DI float rdlane(float v, int l) { return __builtin_bit_cast(float, __builtin_amdgcn_readlane(__builtin_bit_cast(int, v), l)); }

DI void phase_dn0(const Frame& F0, const Params& P, const int l) {
    const Frame F = relaunder(F0);
    const bf16_t* proj = wsp<bf16_t>(P, WS_PROJ); bf16_t* dnp = wsp<bf16_t>(P, WS_DNP); const float* ab = wsp<float>(P, WS_AB); float* gb = wsp<float>(P, WS_GB);
    const float* convw = P.in[I_CONVW] + (size_t)l * 5 * 768; const float* alog = P.in[I_ALOG] + l * 8; const float* dtb = P.in[I_DTB] + l * 8;
    const int lane = F.lane;
    constexpr int DR = 9, UL = (SEQ + DR - 1) / DR, UC = (CTX + DR - 1) / DR, NU0 = NB * (UL + UC);
    for (int u = F.gw; u < NU0; u += F.ngw) {
        int base, t0, T; if (u < NB * UL) { base = (u / UL) * SEQ; t0 = (u % UL) * DR; T = SEQ; } else { const int uu = u - NB * UL; base = R_LAT + (uu / UC) * CTX; t0 = (uu % UC) * DR; T = CTX; }
        const int row0 = base + t0;
        u32x2 w[3][DR + 4];
#pragma unroll
        for (int r = 0; r < DR + 4; ++r) { const int tt = t0 - 2 + r; const bool ok = (tt >= 0) && (tt < T);
#pragma unroll
            for (int part = 0; part < 3; ++part) w[part][r] = ok ? *(const u32x2*)(proj + (size_t)(base + tt) * PLD + 768 + part * 256 + 4 * lane) : (u32x2){0u, 0u}; }
#pragma unroll
        for (int ps = 0; ps < (DR + 7) / 8; ++ps) { const int ri = 8 * ps + (lane >> 3), k = lane & 7;
            if (ri < DR && t0 + ri < T) { const size_t row = (size_t)row0 + ri; const float av = ab[row * 16 + k], bv = ab[row * 16 + 8 + k];
                gb[row * 16 + k] = -__expf(alog[k]) * softplusf_(av + dtb[k]); gb[row * 16 + 8 + k] = __builtin_amdgcn_rcpf(1.0f + __expf(-bv)); } }
#pragma unroll
        for (int part = 0; part < 3; ++part) {
            f32x4 cw[5];
#pragma unroll
            for (int j = 0; j < 5; ++j) cw[j] = *(const f32x4*)(convw + j * 768 + part * 256 + 4 * lane);
#pragma unroll
            for (int i = 0; i < DR; ++i) {
                f32x4 a = {0.f, 0.f, 0.f, 0.f};
#pragma unroll
                for (int j = 0; j < 5; ++j) { const u32x2 x = w[part][i + j]; a += cw[j] * (f32x4){bflo(x.x), bfhi(x.x), bflo(x.y), bfhi(x.y)}; }
                a = (f32x4){siluf(a.x), siluf(a.y), siluf(a.z), siluf(a.w)};
                if (part < 2) { float ss = (a.x * a.x + a.y * a.y) + (a.z * a.z + a.w * a.w);
                    ss += __shfl_xor(ss, 1); ss += __shfl_xor(ss, 2); ss += __shfl_xor(ss, 4); ss += __shfl_xor(ss, 8);
                    const float r = (part == 0 ? 0.125f : 1.0f) * __builtin_amdgcn_rsqf(ss + 1e-6f); a = a * r; }
                u32x2 o; o.x = pk2(a.x, a.y); o.y = pk2(a.z, a.w); if (t0 + i < T) *(u32x2*)(dnp + (size_t)(row0 + i) * 768 + part * 256 + 4 * lane) = o;
            }
        }
    }
}

#define DN_TILE(jt, it) ((jt) == 0 ? ((it) == 0 ? 0 : 1) : 2)
template <int I> struct DnSolve {
    static DI void run(float (&X)[64], const f32x16 (&Lt)[3]) {
        DnSolve<I - 1>::run(X, Lt);
        float a = X[I];
#pragma unroll
        for (int j = 0; j < I; ++j) { const int jl = j & 31, reg = (jl & 3) + 4 * (jl >> 3), hj = (jl >> 2) & 1, src = (I & 31) + 32 * hj;
            a -= rdlane(Lt[DN_TILE(j >> 5, I >> 5)][reg], src) * X[j]; }
        X[I] = a;
        __builtin_amdgcn_sched_barrier(0);
    }
};
template <> struct DnSolve<-1> { static DI void run(float (&)[64], const f32x16 (&)[3]) {} };

DI void phase_dn1(const Frame& F0, const Params& P) {
    const Frame F = relaunder(F0);
    const bf16_t* dnp = wsp<bf16_t>(P, WS_DNP); const float* gb = wsp<float>(P, WS_GB);
    bf16_t* An_g = wsp<bf16_t>(P, WS_AN); bf16_t* Qe_g = wsp<bf16_t>(P, WS_QE); unsigned* Bn_g = wsp<unsigned>(P, WS_BN); float* Oi_g = wsp<float>(P, WS_OI);
    LAS unsigned char* XT = F.lds + F.wave * 16384;
    LAS float* gcs = (LAS float*)(XT + 9216); LAS float* bts = gcs + 64; LAS unsigned char* QpL = XT + 9728;
#define QP(tl, s) (*(const LAS bf16x8*)(QpL + (((tl) * 2 + (s)) * 64 + lane) * 16))
    const int nfull = (NUNIT / F.ngw) * F.ngw, nrem = NUNIT - nfull;
    for (int lin = F.gw; ; lin += F.ngw) {
        int uid, part;
        if (lin < nfull) { uid = lin; part = 2; } else { const int r = lin - nfull; if (r >= 2 * nrem) break; uid = nfull + (r >> 1); part = r & 1; }
        int lane = F.lane; LAUNDER_V(lane); const int r32 = lane & 31, hh = lane >> 5;
        const int n = uid % NCH, dir = (uid / NCH) & 1, h = (uid / (2 * NCH)) % NH, b = uid / (2 * NCH * NH);
        int seqb, T, nn; if (n < NCC) { seqb = R_LAT + b * CTX; T = CTX; nn = n; } else { seqb = b * SEQ; T = SEQ; nn = n - NCC; }
        const int rbase = dir ? seqb + T - 1 - 64 * nn : seqb + 64 * nn, sgn = dir ? -1 : 1;
#define ROWI(i) ((size_t)(rbase + sgn * (i)))
        const bf16_t* qb_ = dnp + h * 64; const bf16_t* kb_ = dnp + 256 + h * 64; const bf16_t* vb_ = dnp + 512 + h * 64;
        float gc = gb[ROWI(lane) * 16 + dir * 4 + h]; const float beta = gb[ROWI(lane) * 16 + 8 + dir * 4 + h];
#pragma unroll
        for (int o = 1; o < 64; o <<= 1) { const float t = __shfl_up(gc, o); if (lane >= o) gc += t; }
        gcs[lane] = gc; bts[lane] = beta;
        const float glast = __shfl(gc, 63), eglast = __expf(glast);
        WAIT_LGKM(0); CFENCE();
        f32x16 Lt[3];
        {
            bf16x8 Ak[2][4], Bq[2][4];
#pragma unroll
            for (int t2 = 0; t2 < 2; ++t2)
#pragma unroll
                for (int ks = 0; ks < 4; ++ks) { const size_t ro = ROWI(32 * t2 + r32) * 768 + 16 * ks + 8 * hh; Ak[t2][ks] = *(const bf16x8*)(kb_ + ro); Bq[t2][ks] = *(const bf16x8*)(qb_ + ro); }
            const float gci[2] = {gcs[r32], gcs[32 + r32]}, bti[2] = {bts[r32], bts[32 + r32]};
#pragma unroll
            for (int tl = 0; tl < 3; ++tl) { const int jt = (tl == 2) ? 1 : 0, it = (tl == 0) ? 0 : 1;
                f32x16 kk = zero16(), qk = zero16();
#pragma unroll
                for (int ks = 0; ks < 4; ++ks) { kk = MFMA32(Ak[jt][ks], Ak[it][ks], kk); qk = MFMA32(Ak[jt][ks], Bq[it][ks], qk); }
                const int i = 32 * it + r32;
#pragma unroll
                for (int reg = 0; reg < 16; ++reg) { const int j = 32 * jt + crow(reg, hh); const float dec = (i >= j) ? __expf(gci[it] - gcs[j]) : 0.f;
                    qk[reg] = qk[reg] * dec; kk[reg] = (i > j) ? bti[it] * kk[reg] * dec : 0.f; }
                Lt[tl] = kk; *(LAS bf16x8*)(QpL + ((tl * 2 + 0) * 64 + lane) * 16) = pack8(qk, 0); *(LAS bf16x8*)(QpL + ((tl * 2 + 1) * 64 + lane) * 16) = pack8(qk, 1); }
        }
        __builtin_amdgcn_sched_barrier(0);
        float X[64];
        if (part != 1) {
#pragma unroll
        for (int i = 0; i < 64; ++i) X[i] = bf2f(vb_[ROWI(i) * 768 + lane]) * rdlane(beta, i);
        __builtin_amdgcn_sched_barrier(0);
        DnSolve<63>::run(X, Lt);
#pragma unroll
        for (int q = 0; q < 8; ++q) { u32x4 w; w.x = pk2(X[8 * q], X[8 * q + 1]); w.y = pk2(X[8 * q + 2], X[8 * q + 3]); w.z = pk2(X[8 * q + 4], X[8 * q + 5]); w.w = pk2(X[8 * q + 6], X[8 * q + 7]); *(LAS u32x4*)(XT + lane * 144 + 16 * q) = w; }
        WAIT_LGKM(0); CFENCE();
        __builtin_amdgcn_sched_barrier(0);
#pragma unroll
        for (int it = 0; it < 2; ++it)
#pragma unroll
            for (int et = 0; et < 2; ++et) { f32x16 z = zero16();
#pragma unroll
                for (int jt = 0; jt <= it; ++jt)
#pragma unroll
                    for (int s = 0; s < 2; ++s) { const LAS unsigned char* p = XT + (32 * et + r32) * 144 + (32 * jt + 16 * s + 4 * hh) * 2;
                        z = MFMA32(QP(DN_TILE(jt, it), s), cat44(*(const LAS u32x2*)p, *(const LAS u32x2*)(p + 16)), z); }
                float* op = Oi_g + (size_t)uid * 4096 + 32 * et + r32;
#pragma unroll
                for (int reg = 0; reg < 16; ++reg) op[(32 * it + crow(reg, hh)) * 64] = z[reg]; }
        }
        __builtin_amdgcn_sched_barrier(0);
        bf16x8 Kd[2][4];
#pragma unroll
        for (int dt = 0; dt < 2; ++dt)
#pragma unroll
            for (int s4 = 0; s4 < 4; ++s4) { float v[8];
#pragma unroll
                for (int jj = 0; jj < 8; ++jj) { const int j = 16 * s4 + 8 * hh + jj; v[jj] = bf2f(kb_[ROWI(j) * 768 + 32 * dt + r32]) * __expf(glast - gcs[j]); }
                u32x4 w; w.x = pk2(v[0], v[1]); w.y = pk2(v[2], v[3]); w.z = pk2(v[4], v[5]); w.w = pk2(v[6], v[7]); Kd[dt][s4] = __builtin_bit_cast(bf16x8, w); }
        if (part != 1) {
#pragma unroll
        for (int dt = 0; dt < 2; ++dt)
#pragma unroll
            for (int et = 0; et < 2; ++et) { f32x16 z = zero16();
#pragma unroll
                for (int s4 = 0; s4 < 4; ++s4) z = MFMA32(Kd[dt][s4], *(const LAS bf16x8*)(XT + (32 * et + r32) * 144 + (16 * s4 + 8 * hh) * 2), z);
                u32x4* op = (u32x4*)(Bn_g + (size_t)uid * 2048 + ((dt * 2 + et) * 64 + lane) * 8);
                op[0] = (u32x4){pk2(z[0], z[1]), pk2(z[2], z[3]), pk2(z[4], z[5]), pk2(z[6], z[7])}; op[1] = (u32x4){pk2(z[8], z[9]), pk2(z[10], z[11]), pk2(z[12], z[13]), pk2(z[14], z[15])}; }
        }
        if (part != 0) {
        CFENCE();
        LAUNDER_V(Lt[0]); LAUNDER_V(Lt[1]); LAUNDER_V(Lt[2]);
        { const float bw = beta * __expf(gc);
#pragma unroll
          for (int i = 0; i < 64; ++i) X[i] = bf2f(kb_[ROWI(i) * 768 + lane]) * rdlane(bw, i); }
        __builtin_amdgcn_sched_barrier(0);
        DnSolve<63>::run(X, Lt);
#pragma unroll
        for (int q = 0; q < 8; ++q) { u32x4 w; w.x = pk2(X[8 * q], X[8 * q + 1]); w.y = pk2(X[8 * q + 2], X[8 * q + 3]); w.z = pk2(X[8 * q + 4], X[8 * q + 5]); w.w = pk2(X[8 * q + 6], X[8 * q + 7]); *(LAS u32x4*)(XT + lane * 144 + 16 * q) = w; }
        WAIT_LGKM(0); CFENCE();
        __builtin_amdgcn_sched_barrier(0);
#pragma unroll
        for (int dt = 0; dt < 2; ++dt)
#pragma unroll
            for (int et = 0; et < 2; ++et) { f32x16 z = zero16();
#pragma unroll
                for (int s4 = 0; s4 < 4; ++s4) z = MFMA32(Kd[dt][s4], *(const LAS bf16x8*)(XT + (32 * et + r32) * 144 + (16 * s4 + 8 * hh) * 2), z);
                const int x = r32 & 15, hhA = (x >> 2) & 1, jj = ((x >> 3) << 2) | (x & 3);
                bf16_t* op = An_g + (size_t)uid * 4096 + (((dt * 2 + et) * 2 + (r32 >> 4)) * 64 + 32 * hhA) * 8 + jj;
#pragma unroll
                for (int reg = 0; reg < 16; ++reg) { const int dl = crow(reg, hh); op[dl * 8] = f2bf(((32 * dt + dl == 32 * et + r32) ? eglast : 0.f) - z[reg]); } }
        __builtin_amdgcn_sched_barrier(0);
#pragma unroll
        for (int it = 0; it < 2; ++it) { const int i = 32 * it + r32; const float eg = __expf(gcs[i]);
#pragma unroll
            for (int dt = 0; dt < 2; ++dt) { f32x16 y = zero16();
#pragma unroll
                for (int jt = 0; jt <= it; ++jt)
#pragma unroll
                    for (int s = 0; s < 2; ++s) { const LAS unsigned char* p = XT + (32 * dt + r32) * 144 + (32 * jt + 16 * s + 4 * hh) * 2;
                        y = MFMA32(cat44(*(const LAS u32x2*)p, *(const LAS u32x2*)(p + 16)), QP(DN_TILE(jt, it), s), y); }
#pragma unroll
                for (int a = 0; a < 4; ++a) { const int d0 = 32 * dt + 8 * a + 4 * hh; const u32x2 qv = *(const u32x2*)(qb_ + ROWI(i) * 768 + d0);
                    u32x2 o; o.x = pk2(bflo(qv.x) * eg - y[4 * a], bfhi(qv.x) * eg - y[4 * a + 1]); o.y = pk2(bflo(qv.y) * eg - y[4 * a + 2], bfhi(qv.y) * eg - y[4 * a + 3]);
                    *(u32x2*)(Qe_g + (size_t)uid * 4096 + i * 64 + d0) = o; } } }
        }
        WAIT_LGKM(0); CFENCE();
#undef ROWI
    }
}

DI void dn2_load(const bf16_t* An_g, const unsigned* Bn_g, size_t uid, int et, int lane, u32x4 (&Ar)[8], u32x4 (&Br)[4]) {
#pragma unroll
    for (int f = 0; f < 8; ++f) Ar[f] = *(const u32x4*)(An_g + uid * 4096 + (f * 64 + lane) * 8);
#pragma unroll
    for (int dt = 0; dt < 2; ++dt) { const u32x4* bp = (const u32x4*)(Bn_g + uid * 2048 + ((dt * 2 + et) * 64 + lane) * 8); Br[2 * dt] = bp[0]; Br[2 * dt + 1] = bp[1]; }
}
DI void dn2_step(bf16_t* Sn_g, size_t uid, int et, int lane, f32x16 (&S)[2], const u32x4 (&Ar)[8], const u32x4 (&Br)[4]) {
    bf16x8 Sp[2][2];
#pragma unroll
    for (int dp = 0; dp < 2; ++dp)
#pragma unroll
        for (int s = 0; s < 2; ++s) { Sp[dp][s] = pack8(S[dp], s); *(bf16x8*)(Sn_g + uid * 4096 + (((et * 2 + dp) * 2 + s) * 64 + lane) * 8) = Sp[dp][s]; }
#pragma unroll
    for (int dt = 0; dt < 2; ++dt) { f32x16 z;
#pragma unroll
        for (int h2 = 0; h2 < 2; ++h2) { const u32x4 w = Br[2 * dt + h2]; z[8 * h2] = bflo(w.x); z[8 * h2 + 1] = bfhi(w.x); z[8 * h2 + 2] = bflo(w.y); z[8 * h2 + 3] = bfhi(w.y); z[8 * h2 + 4] = bflo(w.z); z[8 * h2 + 5] = bfhi(w.z); z[8 * h2 + 6] = bflo(w.w); z[8 * h2 + 7] = bfhi(w.w); }
#pragma unroll
        for (int dp = 0; dp < 2; ++dp)
#pragma unroll
            for (int s = 0; s < 2; ++s) z = MFMA32(__builtin_bit_cast(bf16x8, Ar[(dt * 2 + dp) * 2 + s]), Sp[dp][s], z);
        S[dt] = z; }
}
DI void phase_dn2(const Frame& F0, const Params& P) {
    const Frame F = relaunder(F0);
    const bf16_t* An_g = wsp<bf16_t>(P, WS_AN); const unsigned* Bn_g = wsp<unsigned>(P, WS_BN); bf16_t* Sn_g = wsp<bf16_t>(P, WS_SN);
    const int lane = F.lane;
    constexpr int NCHAIN = NB * NH * 2 * 2;
    if (F.wave < 4)
    for (int cid = F.bid * 4 + F.wave; cid < NCHAIN; cid += F.G * 4) {
        const int et = cid & 1; const size_t uid0 = (size_t)(cid >> 1) * NCH;
        f32x16 S[2] = {zero16(), zero16()};
        u32x4 A0[8], A1[8], A2[8], B0[4], B1[4], B2[4];
        dn2_load(An_g, Bn_g, uid0, et, lane, A0, B0);
        dn2_load(An_g, Bn_g, uid0 + (1 < NCH ? 1 : 0), et, lane, A1, B1);
        dn2_load(An_g, Bn_g, uid0 + (2 < NCH ? 2 : 0), et, lane, A2, B2);
        for (int n = 0; n < NCH; n += 3) {
            dn2_step(Sn_g, uid0 + n, et, lane, S, A0, B0);
            dn2_load(An_g, Bn_g, uid0 + (n + 3 < NCH ? n + 3 : n), et, lane, A0, B0);
            if (n + 1 < NCH) { dn2_step(Sn_g, uid0 + n + 1, et, lane, S, A1, B1); dn2_load(An_g, Bn_g, uid0 + (n + 4 < NCH ? n + 4 : n), et, lane, A1, B1); }
            if (n + 2 < NCH) { dn2_step(Sn_g, uid0 + n + 2, et, lane, S, A2, B2); dn2_load(An_g, Bn_g, uid0 + (n + 5 < NCH ? n + 5 : n), et, lane, A2, B2); }
        }
    }
}

DI void phase_dn3(const Frame& F0, const Params& P, const int l, const int pidx, const int np) {
    const Frame F = relaunder(F0);
    const bf16_t* Qe_g = wsp<bf16_t>(P, WS_QE); const bf16_t* Sn_g = wsp<bf16_t>(P, WS_SN); const float* Oi_g = wsp<float>(P, WS_OI);
    const bf16_t* proj = wsp<bf16_t>(P, WS_PROJ); bf16_t* mix = wsp<bf16_t>(P, WS_MIX); const float* ng = P.in[I_DNG] + l * 64;
    const int lane = F.lane, r32 = lane & 31, hh = lane >> 5;
    const int NC = NCL + ((l < DEPTH - 1) ? NCC : 0);
    for (int u = F.wave * np + pidx; u < NB * NH * NC; u += np * 8) {
        const int ca = u % NC, h = (u / NC) % NH, b = u / (NC * NH);
        int rowb, nf, nbk; if (ca < NCL) { rowb = b * SEQ + 64 * ca; nf = NCC + ca; nbk = NCC + (NCL - 1 - ca); } else { const int c = ca - NCL; rowb = R_LAT + b * CTX + 64 * c; nf = c; nbk = NCC - 1 - c; }
        f32x16 O[2][2] = {{zero16(), zero16()}, {zero16(), zero16()}};
#pragma unroll
        for (int dir = 0; dir < 2; ++dir) { const size_t uid = (size_t)((b * NH + h) * 2 + dir) * NCH + (dir ? nbk : nf);
#pragma unroll
            for (int it = 0; it < 2; ++it) { const int x = 32 * it + r32, xi = dir ? 63 - x : x;
                bf16x8 Bq[2][2];
#pragma unroll
                for (int dp = 0; dp < 2; ++dp)
#pragma unroll
                    for (int s = 0; s < 2; ++s) { const bf16_t* p = Qe_g + uid * 4096 + xi * 64 + 32 * dp + 16 * s + 4 * hh; Bq[dp][s] = cat44(*(const u32x2*)p, *(const u32x2*)(p + 8)); }
#pragma unroll
                for (int et = 0; et < 2; ++et) { f32x16 z = O[et][it];
#pragma unroll
                    for (int dp = 0; dp < 2; ++dp)
#pragma unroll
                        for (int s = 0; s < 2; ++s) z = MFMA32(*(const bf16x8*)(Sn_g + uid * 4096 + (((et * 2 + dp) * 2 + s) * 64 + lane) * 8), Bq[dp][s], z);
#pragma unroll
                    for (int a = 0; a < 4; ++a) { const f32x4 oi = *(const f32x4*)(Oi_g + uid * 4096 + xi * 64 + 32 * et + 8 * a + 4 * hh); z[4 * a] += oi.x; z[4 * a + 1] += oi.y; z[4 * a + 2] += oi.z; z[4 * a + 3] += oi.w; }
                    O[et][it] = z; } } }
#pragma unroll
        for (int it = 0; it < 2; ++it) { const size_t row = (size_t)rowb + 32 * it + r32; float ss = 0.f;
#pragma unroll
            for (int et = 0; et < 2; ++et)
#pragma unroll
                for (int reg = 0; reg < 16; ++reg) ss += O[et][it][reg] * O[et][it][reg];
            ss += __shfl_xor(ss, 32);
            const float r = 1.0f / sqrtf(ss * (1.0f / 64.0f) + RMS_EPS);
#pragma unroll
            for (int et = 0; et < 2; ++et)
#pragma unroll
                for (int a = 0; a < 4; ++a) { const int e0 = 32 * et + 8 * a + 4 * hh; const f32x4 g = *(const f32x4*)(ng + e0); const u32x2 gt = *(const u32x2*)(proj + row * PLD + 6 * 256 + h * 64 + e0);
                    const f32x16& z = O[et][it];
                    u32x2 o; o.x = pk2(z[4 * a] * r * g.x * siluf(bflo(gt.x)), z[4 * a + 1] * r * g.y * siluf(bfhi(gt.x))); o.y = pk2(z[4 * a + 2] * r * g.z * siluf(bflo(gt.y)), z[4 * a + 3] * r * g.w * siluf(bfhi(gt.y)));
                    *(u32x2*)(mix + row * D + 256 + h * 64 + e0) = o; } }
    }
}

struct TileInfo { int row0, dyb, kc0; };
#ifdef EMU
DI s16x4 lds_tr16(const LAS unsigned char* p) {
    emu::Wave* w = emu::cur->wave; const int lane = emu::cur->lane;
    const int slot = emu::rendezvous(&p, sizeof(p), [](emu::Wave*, int) {});
    s16x4 r; const int g = lane >> 4, i = lane & 15;
    for (int q = 0; q < 4; ++q) { const unsigned char* a; memcpy(&a, w->stage[slot][16 * g + 4 * q + (i >> 2)], sizeof(a)); short v; memcpy(&v, a + 2 * (i & 3), 2); r[q] = v; }
    emu::rendezvous(nullptr, 0, [](emu::Wave*, int) {});
    return r;
}
#else
DI s16x4 lds_tr16(const LAS unsigned char* p) { return __builtin_amdgcn_ds_read_tr16_b64_v4i16((LAS s16x4*)p); }
#endif
DI int att_off(int row, int ch) { return 256 * row + 16 * (ch ^ (((row & 3) << 2) | ((row >> 2) & 3))); }
template <int NMAP, int TC, int SUBS, class TF>
DI void attn_core(const Frame& F, LAS unsigned char* lds, const bf16_t* proj, const bool active, const int qrow, const int qcol, const int kcol, const int vcol, const int hoff,
                  const int ntiles32, const TF& tf, const float sc, const LAS float* bias, const int qc, float (&mS)[NMAP], float (&lS)[NMAP], f32x16 (&O)[NMAP][2]) {
    static_assert(SUBS == 1, "one 32-key tile per stage");
    constexpr int KS = 4 / NMAP, NIMG = TC / 64, BUFB = NIMG * 8192, PIECES = 4 * TC, PPT = (2 * PIECES + 511) / 512, CPR = TC / 8;
    constexpr bool FULL = (2 * PIECES) % 512 == 0;
    const int ntiles = ntiles32;
    const int lane = F.lane, r32 = lane & 31, hh = lane >> 5, tid = F.tid;
    const int c0q = (qc - 8 < 0) ? 0 : ((qc - 8 > 48) ? 48 : qc - 8);
    (void)sc;
    bf16x8 qf[NMAP][KS];
#pragma unroll
    for (int mi = 0; mi < NMAP; ++mi)
#pragma unroll
        for (int ks = 0; ks < KS; ++ks) qf[mi][ks] = *(const bf16x8*)(proj + (size_t)(active ? qrow : 0) * PLD + qcol + mi * 32 + ks * 16 + hh * 8);
#pragma unroll
    for (int mi = 0; mi < NMAP; ++mi) { mS[mi] = 0.f; lS[mi] = 0.f; O[mi][0] = zero16(); O[mi][1] = zero16(); }
    u32x4 stg[PPT], stg2[PPT];
#define ATT_LOAD(ti_, dst_) do { _Pragma("unroll") for (int j = 0; j < PPT; ++j) { const int idx = tid + 512 * j; if (FULL || idx < 2 * PIECES) { const bool isV = idx >= PIECES; const int p = isV ? idx - PIECES : idx; \
        dst_[j] = *(const u32x4*)(proj + (size_t)((ti_).row0 + p / CPR) * PLD + (isV ? vcol : kcol) + (p % CPR) * 8); } } } while (0)
#define ATT_STORE_FROM(buf_, src_) do { _Pragma("unroll") for (int j = 0; j < PPT; ++j) { const int idx = tid + 512 * j; if (FULL || idx < 2 * PIECES) { const bool isV = idx >= PIECES; const int p = isV ? idx - PIECES : idx; const int cc = p % CPR; \
        *(LAS u32x4*)(lds + (buf_) * BUFB + (cc >> 3) * 8192 + att_off(p / CPR, (cc & 7) + (isV ? 8 : 0))) = src_[j]; } } } while (0)
    const int img = hoff / 64 * 8192;
    int kaddr[4];
#pragma unroll
    for (int s = 0; s < 4; ++s) kaddr[s] = img + att_off(r32, 2 * s + hh);
    const int trq = (lane & 15) >> 2, trp = lane & 3, trb = (lane >> 4) & 1;
    int vaddr[2][2][2];
#pragma unroll
    for (int dt = 0; dt < 2; ++dt)
#pragma unroll
        for (int s2 = 0; s2 < 2; ++s2)
#pragma unroll
            for (int t = 0; t < 2; ++t) vaddr[dt][s2][t] = img + att_off(16 * s2 + 8 * t + 4 * hh + trq, 8 + 4 * dt + 2 * trb + (trp >> 1)) + 8 * (trp & 1);
    f32x16 negm[NMAP], Lacc[NMAP];
#pragma unroll
    for (int mi = 0; mi < NMAP; ++mi) { negm[mi] = zero16(); Lacc[mi] = zero16(); }
    const bf16x8 ones8 = {(short)0x3f80, (short)0x3f80, (short)0x3f80, (short)0x3f80, (short)0x3f80, (short)0x3f80, (short)0x3f80, (short)0x3f80};
    auto compute = [&](const int buf, const TileInfo ti, const bool first) {
        if (active) {
            const LAS unsigned char* Tb = lds + buf * BUFB;
            bf16x8 vf[2][2];
#pragma unroll
            for (int dt = 0; dt < 2; ++dt)
#pragma unroll
                for (int s2 = 0; s2 < 2; ++s2) { const s16x4 lo = lds_tr16(Tb + vaddr[dt][s2][0]), hi = lds_tr16(Tb + vaddr[dt][s2][1]);
                    vf[dt][s2] = __builtin_shufflevector(lo, hi, 0, 1, 2, 3, 4, 5, 6, 7); }
#pragma unroll
            for (int mi = 0; mi < NMAP; ++mi) {
                f32x16 st = negm[mi];
#pragma unroll
                for (int ks = 0; ks < KS; ++ks) st = MFMA32(*(const LAS bf16x8*)(Tb + kaddr[mi * KS + ks]), qf[mi][ks], st);
                float tmax = -3.0e38f;
                if (ti.dyb >= 0) {
#pragma unroll
                    for (int reg = 0; reg < 16; ++reg) { const int kc = ti.kc0 + crow(reg, hh); const bool ok = (kc >= c0q) && (kc < c0q + 16); const float bv = bias[ti.dyb + (ok ? kc - qc + 15 : 0)];
                        const float x = ok ? st[reg] + bv : -1.0e30f; st[reg] = x; tmax = fmaxf(tmax, x); }
                } else {
#pragma unroll
                    for (int reg = 0; reg < 16; ++reg) tmax = fmaxf(tmax, st[reg]);
                }
                tmax = fmaxf(tmax, __shfl_xor(tmax, 32));
                if (first || __any(tmax > 6.0f)) { const float delta = first ? tmax : fmaxf(tmax, 0.f), alpha = fexp2(-delta);
                    if (!first) { Lacc[mi] = Lacc[mi] * alpha; O[mi][0] = O[mi][0] * alpha; O[mi][1] = O[mi][1] * alpha; }
                    negm[mi] = negm[mi] - delta; st = st - delta; }
#pragma unroll
                for (int reg = 0; reg < 16; ++reg) st[reg] = fexp2(st[reg]);
#pragma unroll
                for (int s2 = 0; s2 < 2; ++s2) { const bf16x8 pf = pack8(st, s2);
                    Lacc[mi] = MFMA32(ones8, pf, Lacc[mi]);
#pragma unroll
                    for (int dt = 0; dt < 2; ++dt) O[mi][dt] = MFMA32(vf[dt][s2], pf, O[mi][dt]); }
            }
        }
    };
    constexpr int NSTG = (PPT == 1) ? 4 : 2;
    u32x4 stg3[PPT], stg4[PPT];
    { const TileInfo t0 = tf(0); ATT_LOAD(t0, stg); }
    { const TileInfo t1 = tf(1 < ntiles ? 1 : 0); ATT_LOAD(t1, stg2); }
    if (NSTG == 4) { { const TileInfo t2 = tf(2 < ntiles ? 2 : 0); ATT_LOAD(t2, stg3); } { const TileInfo t3 = tf(3 < ntiles ? 3 : 0); ATT_LOAD(t3, stg4); } }
#define ATT_STEP(k_, reg_) do { ATT_STORE_FROM((k_) & 1, reg_); \
        WAIT_LGKM(0); __builtin_amdgcn_s_barrier(); CFENCE();     \
        { const int nx = (i + (k_) + NSTG < ntiles) ? i + (k_) + NSTG : ntiles - 1; const TileInfo tn = tf(nx); ATT_LOAD(tn, reg_); } \
        compute((k_) & 1, tf(i + (k_)), i + (k_) == 0); } while (0)
    for (int i = 0; i < ntiles; i += NSTG) {
        ATT_STEP(0, stg); ATT_STEP(1, stg2);
        if (NSTG == 4) { ATT_STEP(2, stg3); ATT_STEP(3, stg4); }
    }
#undef ATT_STEP
#pragma unroll
    for (int mi = 0; mi < NMAP; ++mi) lS[mi] = 0.5f * Lacc[mi][0];
    __syncthreads();
#undef ATT_LOAD
#undef ATT_STORE_FROM
}

constexpr int NCHB = (NB * NH * 4 + 3) / 4;
DI bool chain_dedicated(int G) { return G >= 4 * NCHB; }
constexpr int NA_BUFB = 4 * 8192;
constexpr int NA_BIAS_OFF = 2 * NA_BUFB;
template <int PART> DI void phase_attn(const Frame& F0, const Params& P, const int l, const bool lat_on = true, const bool ctx_on = true, const int Gd = 0, const int cd = 0) {
    const Frame F = relaunder(F0);
    const bf16_t* proj = wsp<bf16_t>(P, WS_PROJ); bf16_t* mix = wsp<bf16_t>(P, WS_MIX);
    const bool last = (l == DEPTH - 1);
    const int lane = F.lane, r32 = lane & 31, hh = lane >> 5, wave = F.wave;
    LAS float* bias = (LAS float*)(F.lds + NA_BIAS_OFF);
    const bool dedicated = chain_dedicated(F.G); const int first = dedicated ? NCHB : 0;
    if (PART == 0 && (!dedicated || F.bid >= NCHB)) {
    for (int i = F.tid; i < 4 * 465; i += 512) bias[i] = P.in[I_RPB][(size_t)l * 4 * 465 + i] * LOG2E;
    __syncthreads();
    { const int nlat = NB * GROWS, nctx = last ? 0 : NB * (CTX / 64);
      for (int uq = F.bid - first; uq < nlat + nctx; uq += F.G - first) {
        const int u = (uq < nlat && nlat % 8 == 0) ? (uq % 8) * (nlat / 8) + uq / 8 : uq;
        const int h = wave >> 1, qh = wave & 1; int qrow, ntiles, b, r = 0, wstart = 0; const int nct = CTX / 32;
        if (u < nlat) { b = u / GROWS; r = u % GROWS; qrow = b * SEQ + r * 64 + qh * 32 + r32; int ws = r - WH / 2; ws = ws < 0 ? 0 : (ws > GROWS - WH ? GROWS - WH : ws); wstart = ws; ntiles = nct + 2 * WH; }
        else { const int uu = u - nlat; b = uu / (CTX / 64); qrow = R_LAT + b * CTX + (uu % (CTX / 64)) * 64 + qh * 32 + r32; ntiles = nct; }
        auto tf = [&](int i) { TileInfo t; if (i < nct) { t.row0 = R_LAT + b * CTX + 32 * i; t.dyb = -1; t.kc0 = 0; } else { const int w = (i - nct) >> 1, half = (i - nct) & 1, wrow = wstart + w; t.row0 = b * SEQ + wrow * 64 + 32 * half; t.dyb = (wrow - r + 7) * 31; t.kc0 = 32 * half; } return t; };
        float mS[1], lS[1]; f32x16 O[1][2];
        attn_core<1, 256, 1>(F, F.lds, proj, true, qrow, h * 64, 256, 512, 64 * h, ntiles, tf, 0.125f * LOG2E, bias + h * 465, qh * 32 + r32, mS, lS, O);
        const float inv = 1.0f / (lS[0] + __shfl_xor(lS[0], 32));
#pragma unroll
        for (int dt = 0; dt < 2; ++dt)
#pragma unroll
            for (int a = 0; a < 4; ++a) { const int d0 = 32 * dt + 8 * a + 4 * hh; u32x2 o; o.x = pk2(O[0][dt][4 * a] * inv, O[0][dt][4 * a + 1] * inv); o.y = pk2(O[0][dt][4 * a + 2] * inv, O[0][dt][4 * a + 3] * inv);
                *(u32x2*)(mix + (size_t)qrow * D + h * 64 + d0) = o; }
      } }
    }
    if (PART == 1) { const float lam_init = 0.8f - 0.6f * expf(-0.3f * (float)l);
      const float* dl = P.in[I_DFLAM] + (size_t)l * 128; const float p1 = (lane < 32) ? dl[lane] * dl[32 + lane] : 0.f, p2 = (lane < 32) ? dl[64 + lane] * dl[96 + lane] : 0.f;
      const float lam = expf(wave_sum(p1)) - expf(wave_sum(p2)) + lam_init;
      const float* dg = P.in[I_DFG] + l * 64;
      constexpr int QBL = SEQ / 256, QBC = (CTX + 255) / 256; const int nlat = lat_on ? NB * NH * QBL : 0, nctx = (last || !ctx_on) ? 0 : NB * NH * QBC; const int nct = CTX / 32;
      for (int u0 = cd; u0 < nlat + nctx; u0 += Gd) {
        const int ul = u0 - nctx, u = (u0 < nctx) ? nlat + u0 : ((nlat % 8 == 0) ? (ul % 8) * (nlat / 8) + ul / 8 : ul);
        int b, h, qrow, ntiles; bool active = true;
        if (u < nlat) { const int qb = u % QBL; h = (u / QBL) % NH; b = u / (QBL * NH); qrow = b * SEQ + qb * 256 + 32 * wave + r32; ntiles = nct + SEQ / 32; }
        else { const int uu = u - nlat, qb = uu % QBC; h = (uu / QBC) % NH; b = uu / (QBC * NH); active = (qb * 256 + 32 * wave) < CTX; qrow = R_LAT + b * CTX + qb * 256 + 32 * wave + r32; ntiles = nct; }
        auto tf = [&](int i) { TileInfo t; t.row0 = (i < nct) ? R_LAT + b * CTX + 32 * i : b * SEQ + 32 * (i - nct); t.dyb = -1; t.kc0 = 0; return t; };
        float mS[2], lS[2]; f32x16 O[2][2];
        attn_core<2, 64, 1>(F, F.lds, proj, active, qrow, 7 * 256 + h * 64, 8 * 256 + h * 64, 9 * 256 + h * 64, 0, ntiles, tf, 0.17677669529663687f * LOG2E, bias, 0, mS, lS, O);
        if (active) {
            const float i1 = 1.0f / (lS[0] + __shfl_xor(lS[0], 32)), i2 = lam / (lS[1] + __shfl_xor(lS[1], 32));
            float ss = 0.f;
#pragma unroll
            for (int dt = 0; dt < 2; ++dt)
#pragma unroll
                for (int reg = 0; reg < 16; ++reg) { const float o = O[0][dt][reg] * i1 - O[1][dt][reg] * i2; O[0][dt][reg] = o; ss += o * o; }
            ss += __shfl_xor(ss, 32);
            const float rr = (1.0f - lam_init) / sqrtf(ss * (1.0f / 64.0f) + RMS_EPS);
#pragma unroll
            for (int dt = 0; dt < 2; ++dt)
#pragma unroll
                for (int a = 0; a < 4; ++a) { const int d0 = 32 * dt + 8 * a + 4 * hh; const f32x4 g = *(const f32x4*)(dg + d0);
                    u32x2 o; o.x = pk2(O[0][dt][4 * a] * rr * g.x, O[0][dt][4 * a + 1] * rr * g.y); o.y = pk2(O[0][dt][4 * a + 2] * rr * g.z, O[0][dt][4 * a + 3] * rr * g.w);
                    *(u32x2*)(mix + (size_t)qrow * D + 512 + h * 64 + d0) = o; }
        }
      } }
}
DI void phase_ftreduce(const Frame& F0, const Params& P, const int l, const int pidx, const int np, const bool lat_on, const bool ctx_on) {
    const Frame F = relaunder(F0);
    const float* slab = wsp<float>(P, WS_SLAB); const float* slabc = wsp<float>(P, WS_SLABC); bf16_t* mix = wsp<bf16_t>(P, WS_MIX);
    const int gt = pidx * 512 + F.tid, ngt = np * 512;
    const int nl = lat_on ? R_LAT * 64 : 0, nc = (ctx_on && l < DEPTH - 1) ? R_CTX * 64 : 0;
    constexpr size_t SLABSZ = (size_t)NB * HSEQ * 64;
    for (int i = gt; i < nl + nc; i += ngt) {
        f32x4 v; int row; int c4;
        if (i < nl) { row = i / 64; c4 = i % 64; const int b = row / SEQ, k = row % SEQ;
            if (k == 0) continue;
            const int kk = (k <= HSEQ) ? k : SEQ - k; const size_t o = ((size_t)b * HSEQ + kk - 1) * 64 + c4;
            f32x4 p = *((const f32x4*)slab + o), q = *((const f32x4*)slab + (size_t)KSPLIT * SLABSZ + o);
#pragma unroll
            for (int ks = 1; ks < KSPLIT; ++ks) { p += *((const f32x4*)slab + (size_t)ks * SLABSZ + o); q += *((const f32x4*)slab + (size_t)(KSPLIT + ks) * SLABSZ + o); }
            v = (k <= HSEQ) ? p + q : p - q; }
        else { const int j = i - nl; row = R_LAT + j / 64; c4 = j % 64; v = *((const f32x4*)slabc + j); }
        u32x2 o; o.x = pk2(v.x, v.y); o.y = pk2(v.z, v.w); *(u32x2*)(mix + (size_t)row * D + 768 + 4 * c4) = o;
    }
    if (lat_on) { const bf16_t* ztl = wsp<bf16_t>(P, WS_ZTL); const float sc = 1.0f / sqrtf((float)SEQ);
      for (int u = F.wave * np + pidx; u < NB * 256; u += np * 8) { const bf16_t* zr = ztl + (size_t)u * 2 * SEQ; float s = 0.f;
          for (int t = 8 * F.lane; t < SEQ; t += 512) { const u32x4 w = *(const u32x4*)(zr + t); s += (bflo(w.x) + bfhi(w.x)) + (bflo(w.y) + bfhi(w.y)) + (bflo(w.z) + bfhi(w.z)) + (bflo(w.w) + bfhi(w.w)); }
          s = wave_sum(s);
          if (F.lane == 0) mix[((size_t)(u / 256) * SEQ) * D + 768 + (u % 256)] = f2bf(s * sc); } }
}

#define REP_P0 1
#define REP_PROJ 1
#define REP_DN0 1
#define REP_DN1 1
#define REP_CHAIN 1
#define REP_DFT 1
#define REP_ATT 1
#define REP_N2 1
#define REP_TOPK 1
#define REP_GU 1
#define REP_DOWN 1
__global__ void __launch_bounds__(512, 2) fwd_kernel(Params P) {
#ifdef EMU
    unsigned char* lds_raw = emu::cur->blk->lds;
#else
    extern __shared__ __attribute__((aligned(16))) unsigned char lds_raw[];
#endif
    Frame F; F.lds = (LAS unsigned char*)lds_raw; F.tid = threadIdx.x; F.lane = F.tid & 63; F.wave = __builtin_amdgcn_readfirstlane(F.tid >> 6);
    F.G = gridDim.x; F.bid = blockIdx.x; F.gw = F.wave * F.G + F.bid; F.ngw = F.G * 8;
    volatile LAS unsigned* misc = (volatile LAS unsigned*)(F.lds + LDS_MISC);
    if (F.tid < 64) misc[F.tid] = 0u;
    __syncthreads();
    XcdBarrier bar = xcd_barrier_post(wsp<unsigned>(P, WS_CTL) + CW_BAR, misc + 8);
#define GRID_BAR() xcd_barrier(bar)
#ifdef EMU
    const int emu_stop = getenv("EMU_STOP") ? atoi(getenv("EMU_STOP")) : -1;
#define EMU_STOP(l, ph) do { if (emu_stop == (l) * 100 + (ph)) return; } while (0)
#else
#define EMU_STOP(l, ph)
#endif

#pragma unroll
        for (int rep_ = 0; rep_ < REP_P0; ++rep_) {
    p0_weights(F, P);
    __syncthreads();
    p0_mod(F, P);
    p0_misc(F, P);
    GRID_BAR();
        }
    { SchedW S{F.G, F.bid, (const char*)wsp<bf16_t>(P, WS_MZT), (const char*)wsp<bf16_t>(P, WS_WFT)}; EpiW E{wsp<bf16_t>(P, WS_WIN)};
      g8::gemm_phase<EpiW, SchedW, false>(F.lds, 256, 256, S, E); }
    phase_norm1(F, P, 0);
    GRID_BAR();
    for (int l = 0; l < DEPTH; ++l) {
        const int last = (l == DEPTH - 1) ? 1 : 0;
        if (l > 0) { phase_norm1(F, P, l); GRID_BAR(); }
        EMU_STOP(l, 1);
#pragma unroll
        for (int rep_ = 0; rep_ < REP_PROJ; ++rep_) {
        { SchedProj S{F.G, F.bid, last, (const char*)wsp<bf16_t>(P, WS_H), (const char*)(wsp<bf16_t>(P, WS_WIN) + (size_t)l * NPROJ * D)};
          EpiProj E{wsp<bf16_t>(P, WS_PROJ), wsp<float>(P, WS_AB), wsp<bf16_t>(P, WS_ZTL), wsp<bf16_t>(P, WS_ZTC), wsp<float>(P, WS_ROPE)};
          g8::gemm_phase<EpiProj, SchedProj, false>(F.lds, D, D, S, E); }
        GRID_BAR();
        }
        EMU_STOP(l, 2);
#pragma unroll
        for (int rep_ = 0; rep_ < REP_DN0; ++rep_) {
        phase_dn0(F, P, l);
        GRID_BAR();
        }
        EMU_STOP(l, 3);
#pragma unroll
        for (int rep_ = 0; rep_ < REP_DN1; ++rep_) {
        { SchedDft S{F.G, F.bid, 1, (!last && !chain_dedicated(F.G)) ? 1 : 0, (const char*)wsp<bf16_t>(P, WS_DFTL), (const char*)wsp<bf16_t>(P, WS_DFTC), (const char*)wsp<bf16_t>(P, WS_ZTL), (const char*)wsp<bf16_t>(P, WS_ZTC)};
          EpiDft E{wsp<float>(P, WS_SLAB), wsp<float>(P, WS_SLABC)};
          g8::gemm_phase<EpiDft, SchedDft, false>(F.lds, 2 * SEQ, 2 * SEQ, S, E); }
        phase_dn1(F, P);
        GRID_BAR();
        }
        EMU_STOP(l, 4);
#pragma unroll
        for (int rep_ = 0; rep_ < REP_CHAIN; ++rep_) {
        phase_dn2(F, P);
        unsigned* chc = wsp<unsigned>(P, WS_CTL) + CW_CHC + 64 * l;
        if (chain_dedicated(F.G) && F.bid < NCHB) {
            WAIT_VM(0);
            __syncthreads();
            if (F.tid == 0) { __builtin_amdgcn_fence(__ATOMIC_RELEASE, "agent"); WAIT_VM(0); (void)xb_add(chc, 1u); }
        }
        if (chain_dedicated(F.G) && F.bid < NCHB && !last) {
            __syncthreads();
            { SchedDft S{NCHB, F.bid, 0, 1, (const char*)wsp<bf16_t>(P, WS_DFTL), (const char*)wsp<bf16_t>(P, WS_DFTC), (const char*)wsp<bf16_t>(P, WS_ZTL), (const char*)wsp<bf16_t>(P, WS_ZTC)};
              EpiDft E{wsp<float>(P, WS_SLAB), wsp<float>(P, WS_SLABC)};
              g8::gemm_phase<EpiDft, SchedDft, false>(F.lds, 2 * SEQ, 2 * SEQ, S, E); }
            phase_attn<1>(F, P, l, false, true, NCHB, F.bid);
        }
        phase_attn<0>(F, P, l);
        if (chain_dedicated(F.G) && F.bid >= NCHB) {
            const int nb_na = F.G - NCHB, units = NB * GROWS + (last ? 0 : NB * (CTX / 64)), extra = units % nb_na, idx = F.bid - NCHB;
            if (idx >= extra) { phase_ftreduce(F, P, l, idx - extra, nb_na - extra, true, false);
                { unsigned sp = 0u; while (xb_ld(chc) < (unsigned)NCHB) { __builtin_amdgcn_s_sleep(2); if (++sp > (1u << 22)) break; } }
                __builtin_amdgcn_fence(__ATOMIC_ACQUIRE, "agent");
                phase_dn3(F, P, l, idx - extra, nb_na - extra); }
        }
        GRID_BAR();
        }
        EMU_STOP(l, 5);
#pragma unroll
        for (int rep_ = 0; rep_ < REP_ATT; ++rep_) {
        if (!chain_dedicated(F.G)) phase_dn3(F, P, l, F.bid, F.G);
        phase_attn<1>(F, P, l, true, !chain_dedicated(F.G), F.G, F.bid);
        phase_ftreduce(F, P, l, F.bid, F.G, !chain_dedicated(F.G), true);
        GRID_BAR();
        }
        EMU_STOP(l, 7);
        { SchedOut S{F.G, F.bid, last, (const char*)wsp<bf16_t>(P, WS_MIX), (const char*)(wsp<bf16_t>(P, WS_WOUT) + (size_t)l * D * D)};
          EpiOut E{wsp<bf16_t>(P, WS_DMIX), wsp<float>(P, WS_MODL) + (size_t)l * NB * 6 * D + 2 * D, wsp<float>(P, WS_MODC) + (size_t)l * 6 * D + 2 * D};
          g8::gemm_phase<EpiOut, SchedOut, false>(F.lds, D, D, S, E); }
        GRID_BAR();
        EMU_STOP(l, 8);
#pragma unroll
        for (int rep_ = 0; rep_ < REP_N2; ++rep_) {
        phase_norm2(F, P, l);
        GRID_BAR();
        }
        EMU_STOP(l, 9);
#pragma unroll
        for (int rep_ = 0; rep_ < REP_TOPK; ++rep_) {
        phase_topk(F, P, l);
        GRID_BAR();
        }
        EMU_STOP(l, 10);
        const int epan = (last ? EROWS_LAT_PAD : EROWS_PAD) / 256;
#pragma unroll
        for (int rep_ = 0; rep_ < REP_GU; ++rep_) {
        { SchedGU S{F.G, F.bid, epan, (const char*)wsp<bf16_t>(P, WS_H), (const char*)(wsp<bf16_t>(P, WS_WGU) + (size_t)l * NEXP * 2 * DEXP * D), wsp<int>(P, WS_RIDX)};
          EpiGU E{wsp<bf16_t>(P, WS_HID)};
          g8::gemm_phase<EpiGU, SchedGU, true>(F.lds, D, D, S, E); }
        GRID_BAR();
        }
        EMU_STOP(l, 11);
#pragma unroll
        for (int rep_ = 0; rep_ < REP_DOWN; ++rep_) {
        { SchedDown S{F.G, F.bid, epan, (const char*)wsp<bf16_t>(P, WS_HID), (const char*)(wsp<bf16_t>(P, WS_WD) + (size_t)l * NEXP * D * DEXP)};
          EpiDown E{wsp<bf16_t>(P, WS_Y), wsp<float>(P, WS_GATEV)};
          g8::gemm_phase<EpiDown, SchedDown, false>(F.lds, DEXP, DEXP, S, E); }
        GRID_BAR();
        }
        EMU_STOP(l, 12);
    }
    phase_norm1(F, P, DEPTH);
}

extern "C" void kernel_launch(void* const* d_in, const int* in_sizes, int n_in, void* d_out, int out_size, void* d_ws, size_t ws_size, hipStream_t stream) {
    static int grid = 0;
    if (grid == 0) {
        if (n_in != 23 || ws_size < WS_END) { fprintf(stderr, "kernel_launch: expected 23 inputs and >= %zu bytes of workspace (got %d, %zu)\n", (size_t)WS_END, n_in, ws_size); grid = -1; return; }
#ifdef EMU
        const char* g = getenv("EMU_GRID"); grid = g ? atoi(g) : 3;
#else
        int dev = 0, cus = 0;
        if (hipGetDevice(&dev) != hipSuccess || hipDeviceGetAttribute(&cus, hipDeviceAttributeMultiprocessorCount, dev) != hipSuccess) { grid = -1; return; }
        if (hipFuncSetAttribute((const void*)fwd_kernel, hipFuncAttributeMaxDynamicSharedMemorySize, LDS_BYTES) != hipSuccess) { fprintf(stderr, "kernel_launch: hipFuncSetAttribute failed\n"); grid = -1; return; }
        int per_cu = 0;
        if (hipOccupancyMaxActiveBlocksPerMultiprocessor(&per_cu, (const void*)fwd_kernel, 512, LDS_BYTES) != hipSuccess || per_cu < 1) fprintf(stderr, "kernel_launch: occupancy query says %d\n", per_cu);
        (void)hipGetLastError();
        grid = cus;
#endif
    }
    if (grid < 0) return;
    (void)in_sizes; (void)out_size;
    hipMemsetAsync((char*)d_ws + WS_CTL, 0, CTL_BYTES, stream);
    Params p{};
    for (int i = 0; i < 23; ++i) p.in[i] = (const float*)d_in[i];
    p.out = (float*)d_out; p.ws = (unsigned char*)d_ws;
#ifdef EMU
    emu::launch([=]() { fwd_kernel(p); }, grid, 512, LDS_BYTES);
#else
    hipLaunchKernelGGL(fwd_kernel, dim3(grid), dim3(512), LDS_BYTES, stream, p);
#endif
}
```

```cpp
#ifdef EMU
#include "emu.h"
#define LAS
#define WAIT_VM(n)
#define WAIT_LGKM(n) emu::rendezvous(nullptr, 0, [](emu::Wave*, int) {})
#define CFENCE()
#define LAUNDER_V(x)
#define LAUNDER_S(x)
#else
#include <hip/hip_runtime.h>
#include <cstdio>
#define LAS __attribute__((address_space(3)))
#define WAIT_VM(n) asm volatile("s_waitcnt vmcnt(" #n ")" ::: "memory")
#define WAIT_LGKM(n) asm volatile("s_waitcnt lgkmcnt(" #n ")" ::: "memory")
#define CFENCE() asm volatile("" ::: "memory")
#define LAUNDER_V(x) asm volatile("" : "+v"(x))
#define LAUNDER_S(x) asm volatile("" : "+s"(x))
#endif
#define DI __device__ __forceinline__

#ifndef CFG_BATCH
#define CFG_BATCH 4
#define CFG_SEQ 4096
#define CFG_CTX 256
#define CFG_DEPTH 4
#define CFG_NEXP 16
#define CFG_DEXP 2048
#define CFG_KS 4
#endif
constexpr int NB = CFG_BATCH, SEQ = CFG_SEQ, CTX = CFG_CTX, DEPTH = CFG_DEPTH, NEXP = CFG_NEXP, DEXP = CFG_DEXP, KSPLIT = CFG_KS;
constexpr int D = 1024, GW = 256, NH = 4, HD = 64, GRIDW = 64, GROWS = SEQ / GRIDW;
constexpr int IN_W = 11 * GW + 4 * NH;
constexpr int R_LAT = NB * SEQ, R_CTX = NB * CTX, RT = R_LAT + R_CTX;
constexpr int NTILE = 13, NPROJ = NTILE * 256;
constexpr int PLD = 12 * 256;
constexpr int CAP_LAT = 2 * SEQ / NEXP, CAP_CTX = 2 * CTX / NEXP;
constexpr int EROWS = NB * (CAP_LAT + CAP_CTX), EROWS_PAD = (EROWS + 255) / 256 * 256, EROWS_LAT_PAD = (NB * CAP_LAT + 255) / 256 * 256;
constexpr int NCC = CTX / 64, NCL = SEQ / 64, NCH = NCC + NCL, NUNIT = NB * NH * 2 * NCH;
constexpr int WH = GROWS < 8 ? GROWS : 8;
constexpr float RMS_EPS = 1e-6f;
constexpr float LOG2E = 1.4426950408889634f;
static_assert(R_LAT % 256 == 0 && R_CTX % 256 == 0 && SEQ % 256 == 0 && CTX % 256 == 0, "row panels");
constexpr int KCH = SEQ / KSPLIT;
constexpr int HSEQ = SEQ / 2;
static_assert(KCH % 128 == 0 && KCH >= 256 && HSEQ % 256 == 0 && DEXP % 128 == 0 && DEXP >= 256, "gemm K");

constexpr size_t al256(size_t x) { return (x + 255) / 256 * 256; }
constexpr size_t WS_CTL = 0, CTL_BYTES = 1u << 20;
constexpr size_t WS_MODL = WS_CTL + CTL_BYTES;
constexpr size_t WS_MODC = WS_MODL + al256((size_t)DEPTH * NB * 6 * D * 4);
constexpr size_t WS_ROPE = WS_MODC + al256((size_t)DEPTH * 6 * D * 4);
constexpr size_t WS_DFTL = WS_ROPE + al256((size_t)SEQ * 32 * 4);
constexpr size_t WS_DFTC = WS_DFTL + al256((size_t)SEQ * 2 * SEQ * 2);
constexpr size_t WS_WIN = WS_DFTC + al256((size_t)CTX * 2 * SEQ * 2);
constexpr size_t WS_WOUT = WS_WIN + al256((size_t)DEPTH * NPROJ * D * 2);
constexpr size_t WS_WGU = WS_WOUT + al256((size_t)DEPTH * D * D * 2);
constexpr size_t WS_WD = WS_WGU + al256((size_t)DEPTH * NEXP * 2 * DEXP * D * 2);
constexpr size_t WS_MZT = WS_WD + al256((size_t)DEPTH * NEXP * D * DEXP * 2);
constexpr size_t WS_WFT = WS_MZT + al256((size_t)DEPTH * 512 * 256 * 2);
constexpr size_t WS_XRES = WS_WFT + al256((size_t)DEPTH * D * 256 * 2);
constexpr size_t WS_H = WS_XRES + al256((size_t)RT * D * 4);
constexpr size_t WS_PROJ = WS_H + al256((size_t)RT * D * 2);
constexpr size_t WS_AB = WS_PROJ + al256((size_t)RT * PLD * 2);
constexpr size_t WS_DNP = WS_AB + al256((size_t)RT * 16 * 4);
constexpr size_t WS_GB = WS_DNP + al256((size_t)RT * 768 * 2);
constexpr size_t WS_AN = WS_GB + al256((size_t)RT * 16 * 4);
constexpr size_t WS_QE = WS_AN + al256((size_t)NUNIT * 8192);
constexpr size_t WS_SN = WS_QE + al256((size_t)NUNIT * 8192);
constexpr size_t WS_BN = WS_SN + al256((size_t)NUNIT * 8192);
constexpr size_t WS_OI = WS_BN + al256((size_t)NUNIT * 16384);
constexpr size_t WS_ZTL = WS_OI + al256((size_t)NUNIT * 16384);
constexpr size_t WS_ZTC = WS_ZTL + al256((size_t)NB * 256 * 2 * SEQ * 2);
constexpr size_t WS_SLAB = WS_ZTC + al256((size_t)NB * 256 * 2 * SEQ * 2);
constexpr size_t WS_SLABC = WS_SLAB + al256((size_t)KSPLIT * R_LAT * 256 * 4);
constexpr size_t WS_MIX = WS_SLABC + al256((size_t)R_CTX * 256 * 4);
constexpr size_t WS_AFF = WS_MIX + al256((size_t)RT * D * 2);
constexpr size_t WS_RIDX = WS_AFF + al256((size_t)RT * NEXP * 4);
constexpr size_t WS_GATEV = WS_RIDX + al256((size_t)NEXP * EROWS_PAD * 4);
constexpr size_t WS_INV = WS_GATEV + al256((size_t)NEXP * EROWS_PAD * 4);
constexpr size_t WS_DMIX = WS_PROJ;
constexpr size_t WS_HID = WS_INV + al256((size_t)RT * NEXP * 4);
constexpr size_t WS_Y = WS_HID + al256((size_t)NEXP * EROWS_PAD * DEXP * 2);
constexpr size_t WS_END = WS_Y + al256((size_t)NEXP * EROWS_PAD * D * 2);
constexpr int CW_CHC = 2048;
constexpr int CW_BAR = 4096;

constexpr int LDS_WORK = 131072;
constexpr int LDS_MISC = LDS_WORK;
constexpr int LDS_BYTES = 147456;

typedef unsigned short bf16_t;
typedef short bf16x8 __attribute__((ext_vector_type(8)));
typedef short s16x4 __attribute__((ext_vector_type(4)));
typedef float f32x2 __attribute__((ext_vector_type(2)));
typedef float f32x4 __attribute__((ext_vector_type(4)));
typedef float f32x16 __attribute__((ext_vector_type(16)));
typedef unsigned u32x2 __attribute__((ext_vector_type(2)));
typedef unsigned u32x4 __attribute__((ext_vector_type(4)));
typedef int i32x4 __attribute__((ext_vector_type(4)));

DI float bf2f(bf16_t b) { return __builtin_bit_cast(float, ((unsigned)b) << 16); }
DI float bflo(unsigned w) { return __builtin_bit_cast(float, w << 16); }
DI float bfhi(unsigned w) { return __builtin_bit_cast(float, w & 0xffff0000u); }
#ifdef EMU
DI unsigned pk2(float lo, float hi) { return (unsigned)emu::f2bf(lo) | ((unsigned)emu::f2bf(hi) << 16); }
#else
typedef __bf16 bf16x2v __attribute__((ext_vector_type(2)));
DI unsigned pk2(float lo, float hi) { f32x2 v = {lo, hi}; return __builtin_bit_cast(unsigned, __builtin_convertvector(v, bf16x2v)); }
#endif
DI bf16_t f2bf(float f) { return (bf16_t)(pk2(f, 0.f) & 0xffffu); }
DI float siluf(float x) { return x * __builtin_amdgcn_rcpf(1.0f + __expf(-x)); }
DI float wave_sum(float v) {
#pragma unroll
    for (int o = 1; o < 64; o <<= 1) v += __shfl_xor(v, o);
    return v;
}
DI int crow(int reg, int hh) { return (reg & 3) + 8 * (reg >> 2) + 4 * hh; }
DI f32x16 zero16() { f32x16 z; for (int i = 0; i < 16; ++i) z[i] = 0.f; return z; }
DI bf16x8 pack8(const f32x16& x, int s) {
    u32x4 p; p.x = pk2(x[8 * s], x[8 * s + 1]); p.y = pk2(x[8 * s + 2], x[8 * s + 3]); p.z = pk2(x[8 * s + 4], x[8 * s + 5]); p.w = pk2(x[8 * s + 6], x[8 * s + 7]);
    return __builtin_bit_cast(bf16x8, p);
}
DI bf16x8 cat44(u32x2 lo, u32x2 hi) { u32x4 p; p.x = lo.x; p.y = lo.y; p.z = hi.x; p.w = hi.y; return __builtin_bit_cast(bf16x8, p); }
#define MFMA32(a, b, c) __builtin_amdgcn_mfma_f32_32x32x16_bf16((a), (b), (c), 0, 0, 0)
#define MFMA16(a, b, c) __builtin_amdgcn_mfma_f32_16x16x32_bf16((a), (b), (c), 0, 0, 0)

#define XB_TMO      128
#define XB_XCNT(j)  (256  + 64 * (j))
#define XB_XSUB(j)  (1280 + 64 * (j))
#define XB_XGEN(j)  (2304 + 64 * (j))
#define XB_TOP      3328
#define XB_TOPGEN   3392
#define XCD_BAR_WORDS 3456
#define XB_SPIN_CAP (1u << 18)
DI unsigned xb_ld(unsigned* p)              { return __hip_atomic_load(p, __ATOMIC_RELAXED, __HIP_MEMORY_SCOPE_AGENT); }
DI unsigned xb_add(unsigned* p, unsigned v) { return __hip_atomic_fetch_add(p, v, __ATOMIC_RELAXED, __HIP_MEMORY_SCOPE_AGENT); }
DI unsigned xb_xcc_id() { return (unsigned)__builtin_amdgcn_s_getreg((3 << 11) | 20) & 0xFu; }
#define XB_SPIN(cond, bar) do { unsigned _sp = 0; while (cond) { __builtin_amdgcn_s_sleep(1); \
    if ((++_sp & 255u) == 0u) { if (xb_ld(&(bar)[XB_TMO])) break; if (_sp > XB_SPIN_CAP) { atomicAdd(&(bar)[XB_TMO], 1u); break; } } } } while (0)
struct XcdBarrier { unsigned* bar; unsigned x; volatile LAS unsigned* st; };
DI XcdBarrier xcd_barrier_post(unsigned* bar, volatile LAS unsigned* st) {
    XcdBarrier b; b.bar = bar; b.x = (unsigned)__builtin_amdgcn_readfirstlane((int)xb_xcc_id()); b.st = st;
    if (threadIdx.x == 0) (void)xb_add(&bar[XB_XCNT(b.x)], 1u);
    return b;
}
DI void xcd_barrier_complete(unsigned* bar, unsigned x, unsigned& nloc, unsigned& nx) {
    const unsigned G = gridDim.x * gridDim.y * gridDim.z;
    unsigned sum, cnt, mine, sp = 0u;
    for (;;) {
        sum = 0u; cnt = 0u; mine = 0u;
#pragma unroll
        for (unsigned j = 0; j < 16; ++j) { const unsigned c = xb_ld(&bar[XB_XCNT(j)]); sum += c; cnt += (c > 0u) ? 1u : 0u; mine = (j == x) ? c : mine; }
        if (sum == G) break;
        __builtin_amdgcn_s_sleep(1);
        if ((++sp & 255u) == 0u) { if (xb_ld(&bar[XB_TMO])) break; if (sp > XB_SPIN_CAP) { atomicAdd(&bar[XB_TMO], 1u); break; } }
    }
    nloc = mine > 0u ? mine : 1u; nx = cnt > 0u ? cnt : 1u;
}
DI void xcd_barrier(const XcdBarrier& b) {
    WAIT_VM(0);
    __syncthreads();
    unsigned* bar = b.bar; unsigned bx = b.x; LAUNDER_S(bar); LAUNDER_S(bx);
    if (threadIdx.x == 0) {
        __builtin_amdgcn_s_waitcnt(0);
        unsigned nloc = b.st[0], nx = b.st[1];
        if (nloc == 0u) { xcd_barrier_complete(bar, bx, nloc, nx); b.st[0] = nloc; b.st[1] = nx; }
        const unsigned old = xb_add(&bar[XB_XSUB(bx)], 1u);
        const unsigned gen = old / nloc;
        if (old + 1u == (gen + 1u) * nloc) {
            __builtin_amdgcn_fence(__ATOMIC_RELEASE, "agent");
            WAIT_VM(0);
            const unsigned og = xb_add(&bar[XB_TOP], 1u);
            const unsigned tg = og / nx;
            if (og + 1u == (tg + 1u) * nx) xb_add(&bar[XB_TOPGEN], 1u);
            else XB_SPIN(xb_ld(&bar[XB_TOPGEN]) == tg, bar);
            __builtin_amdgcn_fence(__ATOMIC_ACQUIRE, "agent");
            xb_add(&bar[XB_XGEN(bx)], 1u);
            WAIT_VM(0);
        } else {
            XB_SPIN(xb_ld(&bar[XB_XGEN(bx)]) == gen, bar);
            __builtin_amdgcn_fence(__ATOMIC_ACQUIRE, "agent");
            WAIT_VM(0);
        }
    }
    __syncthreads();
}

#ifndef G8_SP2
#define G8_SP2 true
#endif
#ifndef G8_ALIGN_W
#define G8_ALIGN_W false
#endif
#ifndef G8_ALIGN_PROJ
#define G8_ALIGN_PROJ true
#endif
#ifndef G8_ALIGN_OUT
#define G8_ALIGN_OUT true
#endif
#ifndef G8_ALIGN_DFT
#define G8_ALIGN_DFT true
#endif
#ifndef G8_ALIGN_GU
#define G8_ALIGN_GU true
#endif
#ifndef G8_ALIGN_DOWN
#define G8_ALIGN_DOWN true
#endif
namespace g8 {
constexpr int BM = 256, BK = 64, HALF = 128, HTB = HALF * BK * 2, STAGE_BYTES = 8 * HTB;
DI int lds_byte(int r, int c) { const int st = (r >> 4) * 2 + (c >> 5), rr = r & 15, cc = c & 31, ob = rr * 64 + cc * 2; return st * 1024 + (ob ^ (((ob >> 9) & 1) << 5)); }
DI void stage_rc(int b, int& R, int& C) { const int st = b / 1024, sb = b % 1024, swz = sb ^ (((sb >> 9) & 1) << 5); R = (st >> 1) * 16 + swz / 64; C = (st & 1) * 32 + (swz % 64) / 2; }
DI int perm32(int rho) { const int n = rho >> 4, i = rho & 15; return 8 * (i >> 2) + 4 * n + (i & 3); }
struct Unit { const char* A; const char* B; const int* gidx; int pm, pn, aux, nt, half; };

template <class Epi, class Sched, bool GATHER>
DI void gemm_phase(LAS unsigned char* lds, const int lda, const int ldb, const Sched& S, const Epi& E) {
    int tid = threadIdx.x; LAUNDER_V(tid);
    const int wid = __builtin_amdgcn_readfirstlane(tid >> 6), lane = tid & 63, wr = wid >> 2, wc = wid & 3, fr = lane & 15, fq = lane >> 4;
    int Rr[2], Cc[2]; unsigned voffB[2];
#pragma unroll
    for (int i = 0; i < 2; ++i) { stage_rc(tid * 16 + i * 8192, Rr[i], Cc[i]); const int Rb = Epi::PERM ? ((Rr[i] & ~31) + perm32(Rr[i] & 31)) : Rr[i]; voffB[i] = (unsigned)(Rb * ldb + Cc[i]) * 2u; }
    const size_t kstep = (size_t)(BK * 2);
    const size_t hstepB = (size_t)HALF * ldb * 2;
    const unsigned ldsw = (unsigned)wid * 1024u;
    const int aoff = lds_byte(wr * 64 + fr, fq * 8), boff = lds_byte(wc * 32 + fr, fq * 8);
#define G8_SA(b, h) (((b) * 2 + (h)) * HTB)
#define G8_SB(b, h) ((4 + (b) * 2 + (h)) * HTB)
#define G8_STAGE(bufoff, gbase, v0, v1) do { \
        __builtin_amdgcn_global_load_lds((const unsigned*)((const char*)(gbase) + (v0)), (LAS unsigned*)(lds + (bufoff) + ldsw), 16, 0, 0); \
        __builtin_amdgcn_global_load_lds((const unsigned*)((const char*)(gbase) + (v1)), (LAS unsigned*)(lds + (bufoff) + ldsw + 8192), 16, 0, 0); } while (0)
#define G8_STAGE_B(bufoff, gbase) G8_STAGE(bufoff, gbase, voffB[0], voffB[1])
#define G8_LDA(dst, b, h) do { _Pragma("unroll") for (int m = 0; m < 4; ++m) _Pragma("unroll") for (int k = 0; k < 2; ++k) dst[m][k] = *(const LAS bf16x8*)(lds + G8_SA(b, h) + aoff + m * 2048 + k * 1024); } while (0)
#define G8_LDB(dst, b, h) do { _Pragma("unroll") for (int n = 0; n < 2; ++n) _Pragma("unroll") for (int k = 0; k < 2; ++k) dst[n][k] = *(const LAS bf16x8*)(lds + G8_SB(b, h) + boff + n * 2048 + k * 1024); } while (0)
#define G8_MMA(ai, bj, At, Bt) do { __builtin_amdgcn_s_setprio(1); _Pragma("unroll") for (int m = 0; m < 4; ++m) _Pragma("unroll") for (int n = 0; n < 2; ++n) _Pragma("unroll") for (int k = 0; k < 2; ++k) \
        acc[ai][bj][m][n] = MFMA16(Bt[n][k], At[m][k], acc[ai][bj][m][n]); __builtin_amdgcn_s_setprio(0); } while (0)
#define G8_BAR __builtin_amdgcn_s_barrier()
#define G8_SCHED __builtin_amdgcn_sched_barrier(0)
#define G8_VA(u, V) do { _Pragma("unroll") for (int h = 0; h < 2; ++h) _Pragma("unroll") for (int i = 0; i < 2; ++i) { \
        const int rr = GATHER ? (u).gidx[h * HALF + Rr[i]] : (h * HALF + Rr[i]); V[h][i] = (unsigned)(rr * lda + Cc[i]) * 2u; } } while (0)
    Unit cur, nxt; int ui = 0;
    if (!S.next(0, cur)) return;
    f32x4 acc[2][2][4][2];
#pragma unroll
    for (int a = 0; a < 2; ++a)
#pragma unroll
        for (int b = 0; b < 2; ++b)
#pragma unroll
            for (int m = 0; m < 4; ++m)
#pragma unroll
                for (int n = 0; n < 2; ++n) acc[a][b][m][n] = (f32x4){0.f, 0.f, 0.f, 0.f};
    bf16x8 At[4][2], B0[2][2], B1[2][2];
    unsigned vaC[2][2], vaN[2][2];
    G8_VA(cur, vaC);
    const char* cA = cur.A; const char* cB = cur.B;
    if constexpr (G8_SP2) {
        G8_STAGE_B(G8_SB(0, 0), cB); G8_STAGE_B(G8_SB(0, 1), cB + hstepB); G8_STAGE(G8_SA(0, 0), cA, vaC[0][0], vaC[0][1]); G8_STAGE(G8_SA(0, 1), cA, vaC[1][0], vaC[1][1]);
        if (wr == 1) G8_BAR;
        WAIT_VM(2); G8_BAR;
    } else {
        G8_STAGE_B(G8_SB(0, 0), cB); G8_STAGE(G8_SA(0, 0), cA, vaC[0][0], vaC[0][1]); G8_STAGE_B(G8_SB(0, 1), cB + hstepB); G8_STAGE(G8_SA(0, 1), cA, vaC[1][0], vaC[1][1]);
        if (wr == 1) G8_BAR;
        WAIT_VM(4); G8_BAR;
    }
    G8_STAGE_B(G8_SB(1, 0), cB + kstep); G8_STAGE(G8_SA(1, 0), cA + kstep, vaC[0][0], vaC[0][1]); G8_STAGE_B(G8_SB(1, 1), cB + hstepB + kstep);
    WAIT_VM(6); G8_BAR;
    for (;;) {
        const bool has_next = S.next(ui + 1, nxt);
        const int nt = cur.nt; const bool hf = cur.half != 0;
        const char* nA = has_next ? nxt.A : cA; const char* nB = has_next ? nxt.B : cB;
        if (GATHER) { if (has_next) { G8_VA(nxt, vaN); } else {
#pragma unroll
            for (int h = 0; h < 2; ++h)
#pragma unroll
                for (int i = 0; i < 2; ++i) vaN[h][i] = vaC[h][i]; } }
        for (int t = 0; t < nt; t += 2) {
            const bool last = (t == nt - 2);
            const char* a1 = cA + (size_t)(t + 1) * kstep;
            const char* a2 = last ? nA : cA + (size_t)(t + 2) * kstep; const char* b2 = last ? nB : cB + (size_t)(t + 2) * kstep;
            const char* a3 = a2 + kstep; const char* b3 = b2 + kstep;
            unsigned x00, x01, x10, x11;
            if (GATHER) { x00 = last ? vaN[0][0] : vaC[0][0]; x01 = last ? vaN[0][1] : vaC[0][1]; x10 = last ? vaN[1][0] : vaC[1][0]; x11 = last ? vaN[1][1] : vaC[1][1]; }
            else { x00 = vaC[0][0]; x01 = vaC[0][1]; x10 = vaC[1][0]; x11 = vaC[1][1]; }
            if constexpr (G8_SP2) {
            G8_LDB(B0, 0, 0); G8_LDB(B1, 0, 1); G8_SCHED; G8_LDA(At, 0, 0); G8_STAGE(G8_SA(1, 1), a1, vaC[1][0], vaC[1][1]);
            WAIT_VM(8); WAIT_LGKM(0); G8_BAR; G8_MMA(0, 0, At, B0); G8_MMA(0, 1, At, B1); G8_BAR; G8_SCHED;
            G8_LDA(At, 0, 1); G8_STAGE_B(G8_SB(0, 0), b2); G8_STAGE_B(G8_SB(0, 1), b2 + hstepB); G8_STAGE(G8_SA(0, 0), a2, x00, x01);
            WAIT_VM(8); WAIT_LGKM(0); G8_BAR; if (!hf) { G8_MMA(1, 0, At, B0); G8_MMA(1, 1, At, B1); } G8_BAR; G8_SCHED;
            G8_LDB(B0, 1, 0); G8_LDB(B1, 1, 1); G8_SCHED; G8_LDA(At, 1, 0); G8_STAGE(G8_SA(0, 1), a2, x10, x11);
            WAIT_VM(8); WAIT_LGKM(0); G8_BAR; G8_MMA(0, 0, At, B0); G8_MMA(0, 1, At, B1); G8_BAR; G8_SCHED;
            G8_LDA(At, 1, 1); G8_STAGE_B(G8_SB(1, 0), b3); G8_STAGE_B(G8_SB(1, 1), b3 + hstepB); G8_STAGE(G8_SA(1, 0), a3, x00, x01);
            WAIT_VM(8); WAIT_LGKM(0); G8_BAR; if (!hf) { G8_MMA(1, 0, At, B0); G8_MMA(1, 1, At, B1); } G8_BAR; G8_SCHED;
            } else {
            G8_LDB(B0, 0, 0); G8_SCHED; G8_LDA(At, 0, 0); G8_STAGE(G8_SA(1, 1), a1, vaC[1][0], vaC[1][1]);
            WAIT_LGKM(8); G8_BAR; WAIT_LGKM(0); G8_MMA(0, 0, At, B0); G8_BAR; G8_SCHED;
            G8_LDB(B1, 0, 1); G8_STAGE_B(G8_SB(0, 0), b2);
            G8_BAR; WAIT_LGKM(0); G8_MMA(0, 1, At, B1); G8_BAR;
            G8_LDA(At, 0, 1); G8_STAGE(G8_SA(0, 0), a2, x00, x01);
            G8_BAR; WAIT_LGKM(0); if (!hf) G8_MMA(1, 0, At, B0); G8_BAR; G8_SCHED;
            G8_STAGE_B(G8_SB(0, 1), b2 + hstepB);
            WAIT_VM(6); G8_BAR; if (!hf) G8_MMA(1, 1, At, B1); G8_BAR;
            G8_LDB(B0, 1, 0); G8_SCHED; G8_LDA(At, 1, 0); G8_STAGE(G8_SA(0, 1), a2, x10, x11);
            WAIT_LGKM(8); G8_BAR; WAIT_LGKM(0); G8_MMA(0, 0, At, B0); G8_BAR; G8_SCHED;
            G8_LDB(B1, 1, 1); G8_STAGE_B(G8_SB(1, 0), b3);
            G8_BAR; WAIT_LGKM(0); G8_MMA(0, 1, At, B1); G8_BAR;
            G8_LDA(At, 1, 1); G8_STAGE(G8_SA(1, 0), a3, x00, x01);
            G8_BAR; WAIT_LGKM(0); if (!hf) G8_MMA(1, 0, At, B0); G8_BAR; G8_SCHED;
            G8_STAGE_B(G8_SB(1, 1), b3 + hstepB);
            WAIT_VM(6); G8_BAR; if (!hf) G8_MMA(1, 1, At, B1); G8_BAR;
            }
        }
        if constexpr (Epi::ALIGN) { if (wr == 0) G8_BAR; }
        E(acc, cur, wr, wc, fr, fq);
        if (!has_next) break;
#pragma unroll
        for (int a = 0; a < 2; ++a)
#pragma unroll
            for (int b = 0; b < 2; ++b)
#pragma unroll
                for (int m = 0; m < 4; ++m)
#pragma unroll
                    for (int n = 0; n < 2; ++n) acc[a][b][m][n] = (f32x4){0.f, 0.f, 0.f, 0.f};
        cur = nxt; cA = nA; cB = nB; ++ui;
        if (GATHER) {
#pragma unroll
            for (int h = 0; h < 2; ++h)
#pragma unroll
                for (int i = 0; i < 2; ++i) vaC[h][i] = vaN[h][i]; }
        if constexpr (Epi::ALIGN) { if (wr == 1) G8_BAR; }
    }
    WAIT_VM(0);
    if constexpr (!Epi::ALIGN) { if (wr == 0) G8_BAR; }
    G8_BAR;
#undef G8_SA
#undef G8_SB
#undef G8_STAGE
#undef G8_STAGE_B
#undef G8_LDA
#undef G8_LDB
#undef G8_MMA
#undef G8_BAR
#undef G8_SCHED
#undef G8_VA
}
}

struct Params { const float* in[23]; float* out; unsigned char* ws; };
enum { I_X = 0, I_C, I_CTX, I_CCTX, I_WMOD, I_BMOD, I_N1G, I_WIN, I_RPB, I_CONVW, I_ALOG, I_DTB, I_DNG, I_DFLAM, I_DFG, I_FTW, I_WOUT, I_N2G, I_WR, I_WG, I_WU, I_WDN, I_FNG };
struct Frame { LAS unsigned char* lds; int tid, lane, wave, G, bid, gw, ngw; };
template <class T> DI T* wsp(const Params& P, size_t off) { return (T*)(P.ws + off); }
DI Frame relaunder(const Frame& F0) { Frame F = F0; LAUNDER_V(F.tid); F.lane = F.tid & 63; F.wave = __builtin_amdgcn_readfirstlane(F.tid >> 6); LAUNDER_S(F.bid); F.gw = F.wave * F.G + F.bid; return F; }
DI float cospi_(float x) { return cosf(3.14159265358979323846f * x); }
DI float sinpi_(float x) { return sinf(3.14159265358979323846f * x); }

struct TItem { const float* src; bf16_t* dst; int ldw, ldt; };
DI TItem p0_decode(const Params& P, int it) {
    constexpr int I_WINc = 10 * 16 * 8, I_ABc = 16, I_WOUTc = 16 * 32, I_Gc = NEXP * 16 * (DEXP / 32), I_Dc = NEXP * (DEXP / 64) * 32;
    constexpr int I_LAYER = I_WINc + I_ABc + I_WOUTc + 2 * I_Gc + I_Dc;
    bf16_t* WinT = wsp<bf16_t>(P, WS_WIN); bf16_t* WoutT = wsp<bf16_t>(P, WS_WOUT); bf16_t* WguT = wsp<bf16_t>(P, WS_WGU); bf16_t* WdT = wsp<bf16_t>(P, WS_WD);
    const int l = it / I_LAYER; int r = it % I_LAYER; TItem t;
    const float* w_in = P.in[I_WIN] + (size_t)l * D * IN_W;
    if (r < I_WINc) { const int g = r / 128, rr = r % 128, kb = ((rr >> 2) / 8) * 4 + (rr & 3), nb = (rr >> 2) % 8; const int so = 256 * g + (g >= 6 ? 16 : 0);
        t.src = w_in + so + nb * 32 + (size_t)64 * kb * IN_W; t.ldw = IN_W; t.dst = WinT + ((size_t)l * NPROJ + g * 256 + nb * 32) * D + 64 * kb; t.ldt = D; return t; }
    r -= I_WINc;
    if (r < I_ABc) { t.src = w_in + 1536 + (size_t)64 * r * IN_W; t.ldw = IN_W; t.dst = WinT + ((size_t)l * NPROJ + 12 * 256) * D + 64 * r; t.ldt = D; return t; }
    r -= I_ABc;
    if (r < I_WOUTc) { const int kb = ((r >> 2) / 32) * 4 + (r & 3), nb = (r >> 2) % 32; t.src = P.in[I_WOUT] + (size_t)l * D * D + nb * 32 + (size_t)64 * kb * D; t.ldw = D; t.dst = WoutT + ((size_t)l * D + nb * 32) * D + 64 * kb; t.ldt = D; return t; }
    r -= I_WOUTc;
    if (r < 2 * I_Gc) { const int up = r >= I_Gc; if (up) r -= I_Gc; const int e = r / (16 * (DEXP / 32)), rr = r % (16 * (DEXP / 32)), kb = ((rr >> 2) / (DEXP / 32)) * 4 + (rr & 3), nb = (rr >> 2) % (DEXP / 32), f0 = 32 * nb;
        t.src = P.in[up ? I_WU : I_WG] + ((size_t)l * NEXP + e) * D * DEXP + f0 + (size_t)64 * kb * DEXP; t.ldw = DEXP;
        t.dst = WguT + (((size_t)l * NEXP + e) * 2 * DEXP + (f0 / 128) * 256 + up * 128 + (f0 % 128)) * D + 64 * kb; t.ldt = D; return t; }
    r -= 2 * I_Gc;
    { const int e = r / ((DEXP / 64) * 32), rr = r % ((DEXP / 64) * 32), kb = ((rr >> 2) / 32) * 4 + (rr & 3), nb = (rr >> 2) % 32;
        t.src = P.in[I_WDN] + ((size_t)l * NEXP + e) * DEXP * D + nb * 32 + (size_t)64 * kb * D; t.ldw = D; t.dst = WdT + (((size_t)l * NEXP + e) * D + nb * 32) * DEXP + 64 * kb; t.ldt = DEXP; }
    return t;
}
DI void p0_weights(const Frame& F0, const Params& P) {
    const Frame F = relaunder(F0);
    LAS float* scr = (LAS float*)(F.lds + F.wave * 8448);
    constexpr int I_LAYER = 10 * 16 * 8 + 16 + 16 * 32 + 2 * NEXP * 16 * (DEXP / 32) + NEXP * (DEXP / 64) * 32, NIT = DEPTH * I_LAYER;
    const int lane = F.lane, lr = lane >> 3, lc = lane & 7;
    f32x4 va[8], vb[8];
#define P0_LOAD(dst_, it_) do { const int itc_ = (it_) < NIT ? (it_) : F.gw; const TItem tl_ = p0_decode(P, itc_); _Pragma("unroll") for (int i = 0; i < 8; ++i) dst_[i] = *(const f32x4*)(tl_.src + (size_t)(8 * i + lr) * tl_.ldw + 4 * lc); } while (0)
#define P0_ITEM(src_, it_, nx_) do { const TItem t_ = p0_decode(P, (it_)); \
        _Pragma("unroll") for (int i = 0; i < 8; ++i) { LAS float* s = scr + (8 * i + lr) * 33 + 4 * lc; s[0] = src_[i].x; s[1] = src_[i].y; s[2] = src_[i].z; s[3] = src_[i].w; } \
        P0_LOAD(src_, (nx_)); \
        WAIT_LGKM(0); CFENCE(); \
        _Pragma("unroll") for (int j = 0; j < 4; ++j) { const int n = lr + 8 * j; const LAS float* s = scr + (8 * lc) * 33 + n; \
            u32x4 o; o.x = pk2(s[0 * 33], s[1 * 33]); o.y = pk2(s[2 * 33], s[3 * 33]); o.z = pk2(s[4 * 33], s[5 * 33]); o.w = pk2(s[6 * 33], s[7 * 33]); \
            *(u32x4*)(t_.dst + (size_t)n * t_.ldt + 8 * lc) = o; } \
        WAIT_LGKM(0); CFENCE(); } while (0)
#define P0_SEQ(j_) ((F.gw + ((j_) >> 2) * F.ngw) * 4 + ((j_) & 3))
    if (P0_SEQ(0) < NIT) { P0_LOAD(va, P0_SEQ(0)); P0_LOAD(vb, P0_SEQ(1)); }
    for (int j = 0; P0_SEQ(j) < NIT; j += 2) {
        P0_ITEM(va, P0_SEQ(j), P0_SEQ(j + 2));
        if (P0_SEQ(j + 1) < NIT) P0_ITEM(vb, P0_SEQ(j + 1), P0_SEQ(j + 3));
    }
#undef P0_SEQ
#undef P0_LOAD
#undef P0_ITEM
}
DI void p0_mod(const Frame& F0, const Params& P) {
    const Frame F = relaunder(F0);
    LAS float* sv = (LAS float*)F.lds;
    LAS f32x2* red = (LAS f32x2*)(sv + (NB + 1) * D);
    float* modL = wsp<float>(P, WS_MODL); float* modC = wsp<float>(P, WS_MODC);
    for (int i = F.tid; i < (NB + 1) * D; i += 512) { const int s = i / D, k = i % D; sv[i] = siluf(s < NB ? P.in[I_C][s * D + k] : P.in[I_CCTX][k]); }
    __syncthreads();
    for (int it = F.bid; it < DEPTH * 48; it += F.G) {
        const int l = it / 48, n = (it % 48) * 128 + 2 * F.lane;
        const float* wm = P.in[I_WMOD] + (size_t)l * D * 6 * D + n;
        f32x2 acc[NB + 1];
#pragma unroll
        for (int s = 0; s <= NB; ++s) acc[s] = (f32x2){0.f, 0.f};
        for (int k0 = F.wave * 128; k0 < F.wave * 128 + 128; k0 += 16) { f32x2 w[16];
#pragma unroll
            for (int i = 0; i < 16; ++i) w[i] = *(const f32x2*)(wm + (size_t)(k0 + i) * 6 * D);
#pragma unroll
            for (int i = 0; i < 16; ++i)
#pragma unroll
                for (int s = 0; s <= NB; ++s) acc[s] += w[i] * sv[s * D + k0 + i]; }
#pragma unroll
        for (int s = 0; s <= NB; ++s) red[(F.wave * (NB + 1) + s) * 64 + F.lane] = acc[s];
        __syncthreads();
        if (F.tid < (NB + 1) * 64) { const int s = F.tid / 64, ln = F.tid % 64; f32x2 v = {0.f, 0.f};
            for (int w = 0; w < 8; ++w) v += red[(w * (NB + 1) + s) * 64 + ln];
            const int nn = (it % 48) * 128 + 2 * ln; v += *(const f32x2*)(P.in[I_BMOD] + (size_t)l * 6 * D + nn);
            *(f32x2*)((s < NB ? modL + ((size_t)l * NB + s) * 6 * D : modC + (size_t)l * 6 * D) + nn) = v; }
        __syncthreads();
    }
}
DI void p0_misc(const Frame& F0, const Params& P) {
    const Frame F = relaunder(F0);
    const size_t gt = (size_t)F.bid * 512 + F.tid, ngt = (size_t)F.G * 512;
    { float* rope = wsp<float>(P, WS_ROPE);
      for (size_t i = gt; i < (size_t)SEQ * 16; i += ngt) { const int t = (int)(i / 16), p = (int)(i % 16); const float pos = (p < 8) ? (float)(t / GRIDW) : (float)(t % GRIDW);
          const float inv = exp2f(-(float)(p & 7) * (13.287712379549449f / 8.0f));     const float ang = pos * inv; rope[2 * i] = cosf(ang); rope[2 * i + 1] = sinf(ang); } }
    { LAS float* ct = (LAS float*)F.lds;
      for (int m = F.tid; m < SEQ; m += 512) ct[m] = cospi_(2.0f * (float)m / (float)SEQ);
      __syncthreads();
      bf16_t* dl = wsp<bf16_t>(P, WS_DFTL); const float sc = 1.0f / sqrtf((float)SEQ);
      for (size_t i = gt; i < (size_t)(HSEQ + 1) * SEQ / 2; i += ngt) { const int k = (int)(i / (SEQ / 2)), t = 2 * (int)(i % (SEQ / 2));     const int m0 = (int)(((long long)k * t) % SEQ), m1 = (m0 + k) % SEQ;
          *(unsigned*)(dl + (size_t)k * 2 * SEQ + t) = pk2(ct[m0] * sc, ct[m1] * sc);
          *(unsigned*)(dl + (size_t)k * 2 * SEQ + SEQ + t) = pk2(ct[(m0 + 3 * SEQ / 4) % SEQ] * sc, ct[(m1 + 3 * SEQ / 4) % SEQ] * sc); }
      bf16_t* dc = wsp<bf16_t>(P, WS_DFTC); const float scc = 1.0f / sqrtf((float)CTX); constexpr int STEP = SEQ / CTX;
      for (size_t i = gt; i < (size_t)CTX * 2 * CTX; i += ngt) { const int k = (int)(i / (2 * CTX)), c = (int)(i % (2 * CTX)), t = c % CTX; const int m = ((k * t) % CTX) * STEP;
          dc[(size_t)k * 2 * SEQ + c] = f2bf((c < CTX ? ct[m] : ct[(m + 3 * SEQ / 4) % SEQ]) * scc); }
      __syncthreads(); }
    { bf16_t* mz = wsp<bf16_t>(P, WS_MZT);
      for (size_t i = gt; i < (size_t)DEPTH * 512 * 256; i += ngt) { const int l = (int)(i / (512 * 256)), np = (int)((i / 256) % 512), c = (int)(i % 256); const int n = np & 255, g0 = c & ~63;
          const float* fw = P.in[I_FTW] + (size_t)l * 256 * 256; float a = 0.f;
          for (int j = 0; j < 64; ++j) { const int m = ((c & 63) * j) & 63; const float x = 2.0f * (float)m / 64.0f; const float tr = (np < 256) ? cospi_(x) : -sinpi_(x); a += tr * fw[(size_t)(g0 + j) * 256 + n]; }
          mz[i] = f2bf(a * 0.125f); }
      bf16_t* wf = wsp<bf16_t>(P, WS_WFT);
      for (size_t i = gt; i < (size_t)DEPTH * D * 256; i += ngt) { const int l = (int)(i / (D * 256)), k = (int)((i / 256) % D), c = (int)(i % 256); wf[i] = f2bf(P.in[I_WIN][((size_t)l * D + k) * IN_W + 2576 + c]); } }
    { int* ridx = wsp<int>(P, WS_RIDX); for (size_t i = gt; i < (size_t)NEXP * EROWS_PAD; i += ngt) ridx[i] = 0; }
}

DI void phase_norm1(const Frame& F0, const Params& P, const int l) {
    const Frame F = relaunder(F0);
    float* xres = wsp<float>(P, WS_XRES); bf16_t* hb = wsp<bf16_t>(P, WS_H);
    const int* inv = wsp<int>(P, WS_INV); const bf16_t* yb = wsp<bf16_t>(P, WS_Y);
    const float* modL = wsp<float>(P, WS_MODL); const float* modC = wsp<float>(P, WS_MODC);
    const bool fin = (l == DEPTH);
    const int nrows = fin ? R_LAT : RT;
    const int R1 = (nrows + F.ngw - 1) / F.ngw;
    if (F.gw * R1 >= nrows) return;
    const int rend = (F.gw * R1 + R1 < nrows) ? F.gw * R1 + R1 : nrows;
    constexpr int NSL = 4;
#define N1_XSRC(r_) ((l <= 1) ? (const f32x4*)((r_) < R_LAT ? P.in[I_X] + (size_t)(r_) * D : P.in[I_CTX] + (size_t)((r_) - R_LAT) * D) + F.lane : (const f32x4*)(xres + (size_t)(r_) * D) + F.lane)
#define N1_LDINV(r_) do { _Pragma("unroll") for (int e_ = 0; e_ < NEXP; ++e_) ivv[e_ >> 2][e_ & 3] = inv[(size_t)e_ * RT + (r_)]; } while (0)
#define N1_ISSUE(r_) do { \
        _Pragma("unroll") for (int k_ = 0; k_ < NSL; ++k_) sl[k_] = -1; \
        if (l > 0) { int cnt_ = 0; \
            _Pragma("unroll") for (int e_ = 0; e_ < NEXP; ++e_) { const int ix_ = __builtin_amdgcn_readfirstlane(ivv[e_ >> 2][e_ & 3]); \
                if (ix_ >= 0) { _Pragma("unroll") for (int k_ = 0; k_ < NSL; ++k_) sl[k_] = (cnt_ == k_) ? ix_ : sl[k_]; ++cnt_; } } \
            nsel = cnt_; } \
        { const f32x4* xs_ = N1_XSRC(r_); _Pragma("unroll") for (int j_ = 0; j_ < 4; ++j_) xn[j_] = xs_[64 * j_]; } \
        if (l > 0) { const u32x2* dm_ = (const u32x2*)(dmix + (size_t)(r_) * D) + F.lane; _Pragma("unroll") for (int j_ = 0; j_ < 4; ++j_) dn[j_] = dm_[64 * j_]; } \
        if (l > 0) { _Pragma("unroll") for (int k_ = 0; k_ < NSL; ++k_) { const u32x2* yr_ = (const u32x2*)(yb + (size_t)(sl[k_] < 0 ? 0 : sl[k_]) * D) + F.lane; \
            _Pragma("unroll") for (int j_ = 0; j_ < 4; ++j_) yn[k_][j_] = yr_[64 * j_]; } } } while (0)
    const bf16_t* dmix = wsp<bf16_t>(P, WS_DMIX);
    i32x4 ivv[NEXP / 4]; int sl[NSL], nsel = 0; f32x4 xn[4]; u32x2 yn[NSL][4]; u32x2 dn[4];
    int row = F.gw * R1;
    if (l > 0) N1_LDINV(row);
    N1_ISSUE(row);
    { const int r1 = row + 1 < rend ? row + 1 : row; if (l > 0) N1_LDINV(r1); }
    f32x4 mg5[4], mgn[4], msh[4], mscl[4]; int bkey = -2;
    { const f32x4* g = (fin ? (const f32x4*)P.in[I_FNG] : (const f32x4*)(P.in[I_N1G] + (size_t)l * D)) + F.lane;
#pragma unroll
      for (int j = 0; j < 4; ++j) mgn[j] = g[64 * j]; }
    for (; row < rend; ++row) {
        const bool lat = row < R_LAT; const int b = lat ? row / SEQ : 0;
        if ((lat ? b : -1) != bkey) { bkey = lat ? b : -1;
            if (l > 0) { const float* mp = (lat ? modL + ((size_t)(l - 1) * NB + b) * 6 * D : modC + (size_t)(l - 1) * 6 * D) + 5 * D;
#pragma unroll
                for (int j = 0; j < 4; ++j) mg5[j] = *((const f32x4*)mp + F.lane + 64 * j); }
            if (!fin) { const float* mp = lat ? modL + ((size_t)l * NB + b) * 6 * D : modC + (size_t)l * 6 * D;
#pragma unroll
                for (int j = 0; j < 4; ++j) { msh[j] = *((const f32x4*)mp + F.lane + 64 * j); mscl[j] = *((const f32x4*)(mp + D) + F.lane + 64 * j); } } }
        f32x4* xr = (f32x4*)(xres + (size_t)row * D) + F.lane;
        f32x4 v[4]; u32x2 y[NSL][4]; int sc[NSL]; const int nc = nsel;
#pragma unroll
        for (int j = 0; j < 4; ++j) { v[j] = xn[j]; if (l > 0) { const u32x2 w = dn[j]; v[j] += (f32x4){bflo(w.x), bfhi(w.x), bflo(w.y), bfhi(w.y)}; } }
#pragma unroll
        for (int k = 0; k < NSL; ++k) { sc[k] = sl[k];
#pragma unroll
            for (int j = 0; j < 4; ++j) y[k][j] = yn[k][j]; }
        { const int r1 = row + 1 < rend ? row + 1 : row, r2 = r1 + 1 < rend ? r1 + 1 : r1;
          N1_ISSUE(r1);
          if (l > 0) N1_LDINV(r2); }
        if (l > 0) {
            f32x4 s[4];
#pragma unroll
            for (int j = 0; j < 4; ++j) s[j] = (f32x4){0.f, 0.f, 0.f, 0.f};
#pragma unroll
            for (int k = 0; k < NSL; ++k) if (sc[k] >= 0) {
#pragma unroll
                for (int j = 0; j < 4; ++j) { const u32x2 w = y[k][j]; s[j] += (f32x4){bflo(w.x), bfhi(w.x), bflo(w.y), bfhi(w.y)}; } }
            if (nc > NSL) { int seen = 0;
                for (int e = 0; e < NEXP; ++e) { const int ix = __builtin_amdgcn_readfirstlane(inv[(size_t)e * RT + row]);
                    if (ix >= 0) { if (seen >= NSL) { const u32x2* yr = (const u32x2*)(yb + (size_t)ix * D) + F.lane;
#pragma unroll
                            for (int j = 0; j < 4; ++j) { const u32x2 w = yr[64 * j]; s[j] += (f32x4){bflo(w.x), bfhi(w.x), bflo(w.y), bfhi(w.y)}; } }
                        ++seen; } } }
#pragma unroll
            for (int j = 0; j < 4; ++j) { v[j] += mg5[j] * s[j]; xr[64 * j] = v[j]; }
        }
        float ss = 0.f;
#pragma unroll
        for (int j = 0; j < 4; ++j) ss += (v[j].x * v[j].x + v[j].y * v[j].y) + (v[j].z * v[j].z + v[j].w * v[j].w);
        const float rstd = 1.0f / sqrtf(wave_sum(ss) * (1.0f / D) + RMS_EPS);
        if (fin) {
            f32x4* o = (f32x4*)(P.out + (size_t)row * D) + F.lane;
#pragma unroll
            for (int j = 0; j < 4; ++j) o[64 * j] = v[j] * rstd * mgn[j];
        } else {
            u32x2* ho = (u32x2*)(hb + (size_t)row * D) + F.lane;
#pragma unroll
            for (int j = 0; j < 4; ++j) { const f32x4 sh = msh[j], scl = mscl[j];
                const f32x4 hv = v[j] * rstd * mgn[j] * (scl + 1.0f) + sh; u32x2 w; w.x = pk2(hv.x, hv.y); w.y = pk2(hv.z, hv.w); ho[64 * j] = w; }
        }
    }
#undef N1_XSRC
#undef N1_LDINV
#undef N1_ISSUE
}
constexpr int lg2c(int x) { return x <= 1 ? 0 : 1 + lg2c(x / 2); }
template <int N> struct RouterRed {
    template <int OFF> static DI float run(float (&v)[N], int lane) {
        float w[N / 2];
        const bool up = (lane & OFF) != 0;
#pragma unroll
        for (int i = 0; i < N / 2; ++i) { const float send = up ? v[i] : v[i + N / 2], keep = up ? v[i + N / 2] : v[i]; w[i] = keep + __shfl_xor(send, OFF); }
        return RouterRed<N / 2>::template run<OFF / 2>(w, lane);
    }
};
template <> struct RouterRed<1> { template <int OFF> static DI float run(float (&v)[1], int) { float x = v[0];
#pragma unroll
        for (int o = OFF; o >= 1; o >>= 1) x += __shfl_xor(x, o);
        return x; } };
DI void phase_norm2(const Frame& F0, const Params& P, const int l) {
    const Frame F = relaunder(F0);
    const float* xres = wsp<float>(P, WS_XRES); bf16_t* hb = wsp<bf16_t>(P, WS_H); float* aff = wsp<float>(P, WS_AFF);
    const float* modL = wsp<float>(P, WS_MODL); const float* modC = wsp<float>(P, WS_MODC);
    const float* wr = P.in[I_WR] + (size_t)l * D * NEXP;
    constexpr int EC = NEXP / 4, LGE = lg2c(NEXP);
    LAS f32x4* wl = (LAS f32x4*)F.lds;
    for (int i = F.tid; i < 16 * EC * 64; i += 512) { const int ln = i & 63, c = (i >> 6) % EC, jq = (i >> 6) / EC, col = 4 * ln + 256 * (jq >> 2) + (jq & 3);
        wl[i] = *(const f32x4*)(wr + (size_t)col * NEXP + 4 * c); }
    __syncthreads();
    const int lane = F.lane;
    int elane = 0;
#pragma unroll
    for (int s = 0; s < LGE; ++s) elane |= ((lane >> (5 - s)) & 1) << (LGE - 1 - s);
    const int nrows = (l < DEPTH - 1) ? RT : R_LAT;
    const bf16_t* dmix = wsp<bf16_t>(P, WS_DMIX);
#define N2_XSRC(r_) ((l == 0) ? (const f32x4*)((r_) < R_LAT ? P.in[I_X] + (size_t)(r_) * D : P.in[I_CTX] + (size_t)((r_) - R_LAT) * D) + lane : (const f32x4*)(xres + (size_t)(r_) * D) + lane)
    f32x4 vn[4]; u32x2 dn[4];
    const int R2 = (nrows + F.ngw - 1) / F.ngw, rbeg = F.gw * R2, rend = (rbeg + R2 < nrows) ? rbeg + R2 : nrows;
    { const int r0 = rbeg < nrows ? rbeg : 0; const f32x4* xr = N2_XSRC(r0); const u32x2* dm = (const u32x2*)(dmix + (size_t)r0 * D) + lane;
#pragma unroll
      for (int j = 0; j < 4; ++j) { vn[j] = xr[64 * j]; dn[j] = dm[64 * j]; } }
    f32x4 mg[4], msh[4], mscl[4]; int bkey = -2;
    { const f32x4* g = (const f32x4*)(P.in[I_N2G] + (size_t)l * D) + lane;
#pragma unroll
      for (int j = 0; j < 4; ++j) mg[j] = g[64 * j]; }
    for (int row = rbeg; row < rend; ++row) {
        const bool lat = row < R_LAT; const int b = lat ? row / SEQ : 0;
        if ((lat ? b : -1) != bkey) { bkey = lat ? b : -1; const float* mp = lat ? modL + ((size_t)l * NB + b) * 6 * D : modC + (size_t)l * 6 * D;
#pragma unroll
            for (int j = 0; j < 4; ++j) { msh[j] = *((const f32x4*)(mp + 3 * D) + lane + 64 * j); mscl[j] = *((const f32x4*)(mp + 4 * D) + lane + 64 * j); } }
        const LAS f32x4* wlr = wl; LAUNDER_V(wlr);
        f32x4 v[4]; float ss = 0.f;
#pragma unroll
        for (int j = 0; j < 4; ++j) { const u32x2 w = dn[j]; v[j] = vn[j] + (f32x4){bflo(w.x), bfhi(w.x), bflo(w.y), bfhi(w.y)}; ss += (v[j].x * v[j].x + v[j].y * v[j].y) + (v[j].z * v[j].z + v[j].w * v[j].w); }
        { const int rn = row + 1 < rend ? row + 1 : row; const f32x4* xr = N2_XSRC(rn); const u32x2* dm = (const u32x2*)(dmix + (size_t)rn * D) + lane;
#pragma unroll
          for (int j = 0; j < 4; ++j) { vn[j] = xr[64 * j]; dn[j] = dm[64 * j]; } }
        const float rstd = 1.0f / sqrtf(wave_sum(ss) * (1.0f / D) + RMS_EPS);
        u32x2* ho = (u32x2*)(hb + (size_t)row * D) + lane;
        float lg[NEXP];
#pragma unroll
        for (int e = 0; e < NEXP; ++e) lg[e] = 0.f;
#pragma unroll
        for (int j = 0; j < 4; ++j) { const float* mpx = lat ? modL + ((size_t)l * NB + b) * 6 * D : modC + (size_t)l * 6 * D; const f32x4 sh = *((const f32x4*)(mpx + 3 * D) + lane + 64 * j), scl = *((const f32x4*)(mpx + 4 * D) + lane + 64 * j);
            const f32x4 hv = v[j] * rstd * mg[j] * (scl + 1.0f) + sh; u32x2 w; w.x = pk2(hv.x, hv.y); w.y = pk2(hv.z, hv.w); ho[64 * j] = w;
#pragma unroll
            for (int q = 0; q < 4; ++q)
#pragma unroll
                for (int c = 0; c < EC; ++c) { const f32x4 wv = wlr[((j * 4 + q) * EC + c) * 64 + lane]; lg[4 * c] += hv[q] * wv.x; lg[4 * c + 1] += hv[q] * wv.y; lg[4 * c + 2] += hv[q] * wv.z; lg[4 * c + 3] += hv[q] * wv.w; } }
        const float logit = RouterRed<NEXP>::template run<32>(lg, lane);
        float mx = logit;
#pragma unroll
        for (int s = 0; s < LGE; ++s) mx = fmaxf(mx, __shfl_xor(mx, 32 >> s));
        const float ex = __expf(logit - mx); float sum = ex;
#pragma unroll
        for (int s = 0; s < LGE; ++s) sum += __shfl_xor(sum, 32 >> s);
        if ((lane & ((64 >> LGE) - 1)) == 0) aff[(size_t)row * NEXP + elane] = ex / sum;
    }
    __syncthreads();
}

DI int xcd_remap(int L, int total) { const int q = total / 8, r = total % 8, x = L % 8, off = L / 8; return (x < r ? x * (q + 1) : r * (q + 1) + (x - r) * q) + off; }
DI void decode2d(int L, int nM, int nN, int& pm, int& pn) { const int nig = 8 * nN, gid = L / nig, fm = gid * 8, gsz = (nM - fm) < 8 ? (nM - fm) : 8; pm = fm + (L % nig) % gsz; pn = (L % nig) / gsz; }

struct SchedW {
    int G, c; const char* mz; const char* wf;
    DI bool next(int i, g8::Unit& u) const { const int L = i * G + c; if (L >= DEPTH * 8) return false; const int l = L / 8, pm = (L % 8) / 4, pn = L % 4;
        u.A = mz + ((size_t)l * 512 + pm * 256) * 256 * 2; u.B = wf + ((size_t)l * D + pn * 256) * 256 * 2; u.gidx = nullptr; u.pm = pm; u.pn = pn; u.aux = l; u.nt = 4; u.half = 0; return true; }
};
struct EpiW { static constexpr bool ALIGN = G8_ALIGN_W; static constexpr bool PERM = true; bf16_t* WinT;
    DI void operator()(const f32x4 (&acc)[2][2][4][2], const g8::Unit& u, int wr, int wc, int fr, int fq) const {
#pragma unroll
        for (int ai = 0; ai < 2; ++ai)
#pragma unroll
            for (int m = 0; m < 4; ++m) { const int r = u.pm * 256 + ai * 128 + wr * 64 + m * 16 + fr; bf16_t* rowp = WinT + ((size_t)u.aux * NPROJ + 2560 + r) * D + u.pn * 256 + wc * 32 + 8 * fq;
#pragma unroll
                for (int bj = 0; bj < 2; ++bj) { const f32x4 v0 = acc[ai][bj][m][0], v1 = acc[ai][bj][m][1]; u32x4 w; w.x = pk2(v0.x, v0.y); w.y = pk2(v0.z, v0.w); w.z = pk2(v1.x, v1.y); w.w = pk2(v1.z, v1.w); *(u32x4*)(rowp + bj * 128) = w; } }
    }
};
struct SchedProj {
    int G, c, last; const char* A; const char* B;
    DI bool next(int i, g8::Unit& u) const {
        constexpr int nLat = R_LAT / 256, nCtx = R_CTX / 256;
        const int ntc = last ? 8 : NTILE, total = nLat * NTILE + nCtx * ntc;
        int L = i * G + c; if (L >= total) return false; L = xcd_remap(L, total);
        int pm, pn;
        if (L < nLat * NTILE) decode2d(L, nLat, NTILE, pm, pn);
        else { L -= nLat * NTILE; pm = nLat + L / ntc; pn = L % ntc; if (last) { const int k = pn; pn = (k < 5) ? k + 1 : (k == 5 ? 8 : (k == 6 ? 9 : 12)); } }
        u.A = A + (size_t)pm * 256 * D * 2; u.B = B + (size_t)pn * 256 * D * 2; u.gidx = nullptr; u.pm = pm; u.pn = pn; u.aux = 0; u.nt = D / 64; u.half = 0; return true; }
};
struct EpiProj { static constexpr bool ALIGN = G8_ALIGN_PROJ; static constexpr bool PERM = true; bf16_t* proj; float* ab; bf16_t* ztl; bf16_t* ztc; const float* rope;
    DI void operator()(const f32x4 (&acc)[2][2][4][2], const g8::Unit& u, int wr, int wc, int fr, int fq) const {
        const int pn = u.pn; const bool lat = u.pm * 256 < R_LAT;
#pragma unroll
        for (int ai = 0; ai < 2; ++ai)
#pragma unroll
            for (int m = 0; m < 4; ++m) {
                const int row = u.pm * 256 + ai * 128 + wr * 64 + m * 16 + fr;
                int b, t; if (lat) { b = row / SEQ; t = row % SEQ; } else { const int rr = row - R_LAT; b = rr / CTX; t = rr % CTX; }
#pragma unroll
                for (int bj = 0; bj < 2; ++bj) {
                    const int c8 = 128 * bj + 32 * wc + 8 * fq; f32x4 v0 = acc[ai][bj][m][0], v1 = acc[ai][bj][m][1];
                    if (pn == 0) { v0 = v0 * (0.125f * LOG2E); v1 = v1 * (0.125f * LOG2E); }
                    if (pn == 7) { v0 = v0 * (0.17677669529663687f * LOG2E); v1 = v1 * (0.17677669529663687f * LOG2E); }
                    if (pn < 10) {
                        if ((pn == 7 || pn == 8) && lat) { const f32x4* cs = (const f32x4*)(rope + ((size_t)t * 16 + 4 * fq) * 2); const f32x4 c0 = cs[0], c1 = cs[1];
                            v0 = (f32x4){v0.x * c0.x - v0.y * c0.y, v0.x * c0.y + v0.y * c0.x, v0.z * c0.z - v0.w * c0.w, v0.z * c0.w + v0.w * c0.z};
                            v1 = (f32x4){v1.x * c1.x - v1.y * c1.y, v1.x * c1.y + v1.y * c1.x, v1.z * c1.z - v1.w * c1.w, v1.z * c1.w + v1.w * c1.z}; }
                        u32x4 w; w.x = pk2(v0.x, v0.y); w.y = pk2(v0.z, v0.w); w.z = pk2(v1.x, v1.y); w.w = pk2(v1.z, v1.w);
                        *(u32x4*)(proj + (size_t)row * PLD + pn * 256 + c8) = w;
                    } else if (pn < 12) {
                        bf16_t* base = (lat ? ztl : ztc) + ((size_t)(b * 256 + c8)) * (2 * SEQ) + (pn - 10) * (lat ? SEQ : CTX) + t;
#pragma unroll
                        for (int j = 0; j < 4; ++j) { base[(size_t)j * 2 * SEQ] = f2bf(v0[j]); base[(size_t)(j + 4) * 2 * SEQ] = f2bf(v1[j]); }
                    } else if (bj == 0 && wc == 0 && fq < 2) { f32x4* o = (f32x4*)(ab + (size_t)row * 16 + 8 * fq); o[0] = v0; o[1] = v1; }
                }
            }
    }
};
struct SchedOut {
    int G, c, last; const char* A; const char* B;
    DI bool next(int i, g8::Unit& u) const { const int nM = last ? R_LAT / 256 : RT / 256, total = nM * 4; int L = i * G + c; if (L >= total) return false; L = xcd_remap(L, total);
        int pm, pn; decode2d(L, nM, 4, pm, pn);
        u.A = A + (size_t)pm * 256 * D * 2; u.B = B + (size_t)pn * 256 * D * 2; u.gidx = nullptr; u.pm = pm; u.pn = pn; u.aux = 0; u.nt = D / 64; u.half = 0; return true; }
};
struct EpiOut { static constexpr bool ALIGN = G8_ALIGN_OUT; static constexpr bool PERM = true; bf16_t* dmix; const float* modL; const float* modC;
    DI void operator()(const f32x4 (&acc)[2][2][4][2], const g8::Unit& u, int wr, int wc, int fr, int fq) const {
        const bool lat = u.pm * 256 < R_LAT; const int b = lat ? (u.pm * 256) / SEQ : 0;
        const float* g2 = lat ? modL + (size_t)b * 6 * D : modC;
#pragma unroll
        for (int bj = 0; bj < 2; ++bj) { const int c = u.pn * 256 + 128 * bj + 32 * wc + 8 * fq; const f32x4 g0 = *(const f32x4*)(g2 + c), g1 = *(const f32x4*)(g2 + c + 4);
#pragma unroll
            for (int ai = 0; ai < 2; ++ai)
#pragma unroll
                for (int m = 0; m < 4; ++m) { const int row = u.pm * 256 + ai * 128 + wr * 64 + m * 16 + fr; const f32x4 v0 = g0 * acc[ai][bj][m][0], v1 = g1 * acc[ai][bj][m][1];
                    u32x4 w; w.x = pk2(v0.x, v0.y); w.y = pk2(v0.z, v0.w); w.z = pk2(v1.x, v1.y); w.w = pk2(v1.z, v1.w); *(u32x4*)(dmix + (size_t)row * D + c) = w; } }
    }
};
struct SchedDft {
    int G, c, lat_on, ctx_on; const char* dl; const char* dc; const char* zl; const char* zc;
    DI bool next(int i, g8::Unit& u) const { constexpr int nlatc = (HSEQ / 256) * 2 * KSPLIT * NB, nctx = (CTX / 256) * NB; const int nlat = lat_on ? nlatc : 0, nc = ctx_on ? nctx : 0, total = nlat + nc;
        int L = i * G + c; if (L >= total) return false;
        if (L >= nc) { L = xcd_remap(L - nc, nlat); const int b = L % NB, ks = (L / NB) % (2 * KSPLIT), pm = L / (NB * 2 * KSPLIT);
            const size_t ko = (ks < KSPLIT) ? (size_t)ks * KCH : (size_t)SEQ + (size_t)(ks - KSPLIT) * KCH;
            u.A = dl + ((size_t)(1 + pm * 256) * 2 * SEQ + ko) * 2; u.B = zl + ((size_t)b * 256 * 2 * SEQ + ko) * 2; u.pm = pm; u.pn = b; u.aux = ks; u.nt = KCH / 64; }
        else { const int b = L % NB, pm = L / NB; u.A = dc + (size_t)pm * 256 * 2 * SEQ * 2; u.B = zc + (size_t)b * 256 * 2 * SEQ * 2; u.pm = pm; u.pn = b; u.aux = -1; u.nt = 2 * CTX / 64; }
        u.gidx = nullptr; u.half = 0; return true; }
};
struct EpiDft { static constexpr bool ALIGN = G8_ALIGN_DFT; static constexpr bool PERM = false; float* slab; bf16_t* mix;
    DI void operator()(const f32x4 (&acc)[2][2][4][2], const g8::Unit& u, int wr, int wc, int fr, int fq) const {
        if (u.aux < 0) {
#pragma unroll
            for (int ai = 0; ai < 2; ++ai)
#pragma unroll
                for (int m = 0; m < 4; ++m) { bf16_t* rowp = mix + (size_t)(R_LAT + u.pn * CTX + u.pm * 256 + ai * 128 + wr * 64 + m * 16 + fr) * D + 768 + 32 * wc + 4 * fq;
#pragma unroll
                    for (int bj = 0; bj < 2; ++bj)
#pragma unroll
                        for (int n = 0; n < 2; ++n) { const f32x4 v = acc[ai][bj][m][n]; u32x2 o; o.x = pk2(v.x, v.y); o.y = pk2(v.z, v.w); *(u32x2*)(rowp + 128 * bj + 16 * n) = o; } }
            return;
        }
        float* base = slab + ((size_t)u.aux * (NB * HSEQ) + (size_t)u.pn * HSEQ + u.pm * 256) * 256;
#pragma unroll
        for (int ai = 0; ai < 2; ++ai)
#pragma unroll
            for (int m = 0; m < 4; ++m) { float* rowp = base + (size_t)(ai * 128 + wr * 64 + m * 16 + fr) * 256 + 32 * wc + 4 * fq;
#pragma unroll
                for (int bj = 0; bj < 2; ++bj)
#pragma unroll
                    for (int n = 0; n < 2; ++n) *(f32x4*)(rowp + 128 * bj + 16 * n) = acc[ai][bj][m][n]; }
    }
};
constexpr bool EHALF = (EROWS % 256 != 0) && (EROWS % 256 <= 128);
struct SchedGU {
    int G, c, epan; const char* A; const char* B; const int* ridx;
    DI bool next(int i, g8::Unit& u) const { constexpr int NN = 2 * DEXP / 256; const int total = NEXP * epan * NN; int L = i * G + c; if (L >= total) return false;
        const bool hp = EHALF && (epan == EROWS_PAD / 256); const int ef = hp ? epan - 1 : epan, nfull = NEXP * ef * NN;
        int e, pn, pm, hf = 0;
        if (L < nfull) { L = xcd_remap(L, nfull); e = L / (ef * NN); const int rem = L % (ef * NN); pn = rem / ef; pm = rem % ef; }
        else { L -= nfull; e = L / NN; pn = L % NN; pm = epan - 1; hf = 1; }
        u.A = A; u.gidx = ridx + (size_t)e * EROWS_PAD + pm * 256; u.B = B + ((size_t)e * 2 * DEXP + pn * 256) * D * 2; u.pm = e * (EROWS_PAD / 256) + pm; u.pn = pn; u.aux = e; u.nt = D / 64; u.half = hf; return true; }
};
struct EpiGU { static constexpr bool ALIGN = G8_ALIGN_GU; static constexpr bool PERM = true; bf16_t* hid;
    DI void operator()(const f32x4 (&acc)[2][2][4][2], const g8::Unit& u, int wr, int wc, int fr, int fq) const {
#pragma unroll
        for (int ai = 0; ai < 2; ++ai)
#pragma unroll
            for (int m = 0; m < 4; ++m) { if (ai == 1 && u.half) continue; const int row = u.pm * 256 + ai * 128 + wr * 64 + m * 16 + fr;
                const f32x4 g0 = acc[ai][0][m][0], g1 = acc[ai][0][m][1], u0 = acc[ai][1][m][0], u1 = acc[ai][1][m][1];
                u32x4 w; w.x = pk2(siluf(g0.x) * u0.x, siluf(g0.y) * u0.y); w.y = pk2(siluf(g0.z) * u0.z, siluf(g0.w) * u0.w); w.z = pk2(siluf(g1.x) * u1.x, siluf(g1.y) * u1.y); w.w = pk2(siluf(g1.z) * u1.z, siluf(g1.w) * u1.w);
                *(u32x4*)(hid + (size_t)row * DEXP + u.pn * 128 + 32 * wc + 8 * fq) = w; }
    }
};
struct SchedDown {
    int G, c, epan; const char* A; const char* B;
    DI bool next(int i, g8::Unit& u) const { const int total = NEXP * epan * 4; int L = i * G + c; if (L >= total) return false;
        const bool hp = EHALF && (epan == EROWS_PAD / 256); const int ef = hp ? epan - 1 : epan, nfull = NEXP * ef * 4;
        int e, pn, pm, hf = 0;
        if (L < nfull) { L = xcd_remap(L, nfull); e = L / (ef * 4); const int rem = L % (ef * 4); pn = rem / ef; pm = rem % ef; }
        else { L -= nfull; e = L / 4; pn = L % 4; pm = epan - 1; hf = 1; }
        u.A = A + ((size_t)e * EROWS_PAD + pm * 256) * DEXP * 2; u.gidx = nullptr; u.B = B + ((size_t)e * D + pn * 256) * DEXP * 2; u.pm = e * (EROWS_PAD / 256) + pm; u.pn = pn; u.aux = e; u.nt = DEXP / 64; u.half = hf; return true; }
};
struct EpiDown { static constexpr bool ALIGN = G8_ALIGN_DOWN; static constexpr bool PERM = true; bf16_t* y; const float* gatev;
    DI void operator()(const f32x4 (&acc)[2][2][4][2], const g8::Unit& u, int wr, int wc, int fr, int fq) const {
#pragma unroll
        for (int ai = 0; ai < 2; ++ai)
#pragma unroll
            for (int m = 0; m < 4; ++m) { if (ai == 1 && u.half) continue; const int row = u.pm * 256 + ai * 128 + wr * 64 + m * 16 + fr; const float gv = gatev[row];
#pragma unroll
                for (int bj = 0; bj < 2; ++bj) { const f32x4 v0 = acc[ai][bj][m][0] * gv, v1 = acc[ai][bj][m][1] * gv; u32x4 w; w.x = pk2(v0.x, v0.y); w.y = pk2(v0.z, v0.w); w.z = pk2(v1.x, v1.y); w.w = pk2(v1.z, v1.w);
                    *(u32x4*)(y + (size_t)row * D + u.pn * 256 + 128 * bj + 32 * wc + 8 * fq) = w; } }
    }
};

DI int block_sum_i(const Frame& F, int v, LAS int* tmp) {
#pragma unroll
    for (int o = 1; o < 64; o <<= 1) v += __shfl_xor(v, o);
    if (F.lane == 0) tmp[F.wave] = v;
    __syncthreads();
    int s = 0;
#pragma unroll
    for (int w = 0; w < 8; ++w) s += tmp[w];
    __syncthreads();
    return s;
}
DI int block_excl_scan_i(const Frame& F, int v, LAS int* tmp) {
    int inc = v;
#pragma unroll
    for (int o = 1; o < 64; o <<= 1) { const int t = __shfl_up(inc, o); if (F.lane >= o) inc += t; }
    if (F.lane == 63) tmp[F.wave] = inc;
    __syncthreads();
    int base = 0;
#pragma unroll
    for (int w = 0; w < 8; ++w) base += (w < F.wave) ? tmp[w] : 0;
    __syncthreads();
    return base + inc - v;
}
template <int KPT>
DI void topk_problem(const Frame& F, const float* aff, int* ridx, float* gatev, int* inv, int e, int N, int cap, int rowbase, int slotbase) {
    LAS int* tmp = (LAS int*)F.lds;
    unsigned key[KPT];
#pragma unroll
    for (int j = 0; j < KPT; ++j) { const int tok = F.tid * KPT + j; key[j] = (tok < N) ? __float_as_uint(aff[(size_t)(rowbase + tok) * NEXP + e]) : 0u; }
    unsigned T = 0u;
    for (int bit = 30; bit >= 0; --bit) { const unsigned cand = T | (1u << bit); int c = 0;
#pragma unroll
        for (int j = 0; j < KPT; ++j) c += __popcll(__ballot(key[j] >= cand));
        LAS int* tb = tmp + 16 + (bit & 1) * 8;
        if (F.lane == 0) tb[F.wave] = c;
        __syncthreads();
        int sum = 0;
#pragma unroll
        for (int w = 0; w < 8; ++w) sum += tb[w];
        if (sum >= cap) T = cand; }
    int cg = 0, ce = 0;
#pragma unroll
    for (int j = 0; j < KPT; ++j) { cg += (key[j] > T) ? 1 : 0; ce += (key[j] == T) ? 1 : 0; }
    const int need_eq = cap - block_sum_i(F, cg, tmp);
    int eqb = block_excl_scan_i(F, ce, tmp);
    int sel[KPT]; int ns = 0;
#pragma unroll
    for (int j = 0; j < KPT; ++j) { const bool s = (key[j] > T) || (key[j] == T && eqb < need_eq); if (key[j] == T) ++eqb; sel[j] = s ? 1 : 0; ns += sel[j]; }
    int ord = block_excl_scan_i(F, ns, tmp);
#pragma unroll
    for (int j = 0; j < KPT; ++j) { const int tok = F.tid * KPT + j; if (tok < N) { const int row = rowbase + tok; int ix = -1;
            if (sel[j]) { ix = e * EROWS_PAD + slotbase + ord; ridx[ix] = row; gatev[ix] = __uint_as_float(key[j]); ++ord; }
            inv[(size_t)e * RT + row] = ix; } }
}
DI void phase_topk(const Frame& F0, const Params& P, const int l) {
    const Frame F = relaunder(F0);
    const float* aff = wsp<float>(P, WS_AFF); int* ridx = wsp<int>(P, WS_RIDX); float* gatev = wsp<float>(P, WS_GATEV); int* inv = wsp<int>(P, WS_INV);
    const int nprob = NEXP * NB * ((l < DEPTH - 1) ? 2 : 1);
    for (int p = F.bid; p < nprob; p += F.G) { const int seg = p / (NEXP * NB), b = (p / NEXP) % NB, e = p % NEXP;
        if (seg == 0) topk_problem<(SEQ + 511) / 512>(F, aff, ridx, gatev, inv, e, SEQ, CAP_LAT, b * SEQ, b * CAP_LAT);
        else topk_problem<(CTX + 511) / 512>(F, aff, ridx, gatev, inv, e, CTX, CAP_CTX, R_LAT + b * CTX, NB * CAP_LAT + b * CAP_CTX); }
}

DI float softplusf_(float x) { const float t = __expf(-fabsf(x)); return fmaxf(x, 0.f) + (t < 1e-3f ? t * (1.0f - 0.5f * t) : __logf(1.0f + t)); }
DI float fexp2(float x) { return __builtin_amdgcn_exp2f(x); }
DI float rdlane(float v, int l) { return __builtin_bit_cast(float, __builtin_amdgcn_readlane(__builtin_bit_cast(int, v), l)); }

DI void phase_dn0(const Frame& F0, const Params& P, const int l) {
    const Frame F = relaunder(F0);
    const bf16_t* proj = wsp<bf16_t>(P, WS_PROJ); bf16_t* dnp = wsp<bf16_t>(P, WS_DNP); const float* ab = wsp<float>(P, WS_AB); float* gb = wsp<float>(P, WS_GB);
    const float* convw = P.in[I_CONVW] + (size_t)l * 5 * 768; const float* alog = P.in[I_ALOG] + l * 8; const float* dtb = P.in[I_DTB] + l * 8;
    const int lane = F.lane;
    constexpr int DR = 9, UL = (SEQ + DR - 1) / DR, UC = (CTX + DR - 1) / DR, NU0 = NB * (UL + UC);
    for (int u = F.gw; u < NU0; u += F.ngw) {
        int base, t0, T; if (u < NB * UL) { base = (u / UL) * SEQ; t0 = (u % UL) * DR; T = SEQ; } else { const int uu = u - NB * UL; base = R_LAT + (uu / UC) * CTX; t0 = (uu % UC) * DR; T = CTX; }
        const int row0 = base + t0;
        u32x2 w[3][DR + 4];
#pragma unroll
        for (int r = 0; r < DR + 4; ++r) { const int tt = t0 - 2 + r; const bool ok = (tt >= 0) && (tt < T);
#pragma unroll
            for (int part = 0; part < 3; ++part) w[part][r] = ok ? *(const u32x2*)(proj + (size_t)(base + tt) * PLD + 768 + part * 256 + 4 * lane) : (u32x2){0u, 0u}; }
#pragma unroll
        for (int ps = 0; ps < (DR + 7) / 8; ++ps) { const int ri = 8 * ps + (lane >> 3), k = lane & 7;
            if (ri < DR && t0 + ri < T) { const size_t row = (size_t)row0 + ri; const float av = ab[row * 16 + k], bv = ab[row * 16 + 8 + k];
                gb[row * 16 + k] = -__expf(alog[k]) * softplusf_(av + dtb[k]); gb[row * 16 + 8 + k] = __builtin_amdgcn_rcpf(1.0f + __expf(-bv)); } }
#pragma unroll
        for (int part = 0; part < 3; ++part) {
            f32x4 cw[5];
#pragma unroll
            for (int j = 0; j < 5; ++j) cw[j] = *(const f32x4*)(convw + j * 768 + part * 256 + 4 * lane);
#pragma unroll
            for (int i = 0; i < DR; ++i) {
                f32x4 a = {0.f, 0.f, 0.f, 0.f};
#pragma unroll
                for (int j = 0; j < 5; ++j) { const u32x2 x = w[part][i + j]; a += cw[j] * (f32x4){bflo(x.x), bfhi(x.x), bflo(x.y), bfhi(x.y)}; }
                a = (f32x4){siluf(a.x), siluf(a.y), siluf(a.z), siluf(a.w)};
                if (part < 2) { float ss = (a.x * a.x + a.y * a.y) + (a.z * a.z + a.w * a.w);
                    ss += __shfl_xor(ss, 1); ss += __shfl_xor(ss, 2); ss += __shfl_xor(ss, 4); ss += __shfl_xor(ss, 8);
                    const float r = (part == 0 ? 0.125f : 1.0f) * __builtin_amdgcn_rsqf(ss + 1e-6f); a = a * r; }
                u32x2 o; o.x = pk2(a.x, a.y); o.y = pk2(a.z, a.w); if (t0 + i < T) *(u32x2*)(dnp + (size_t)(row0 + i) * 768 + part * 256 + 4 * lane) = o;
            }
        }
    }
}

#define DN_TILE(jt, it) ((jt) == 0 ? ((it) == 0 ? 0 : 1) : 2)
template <int I> struct DnSolve {
    static DI void run(float (&X)[64], const f32x16 (&Lt)[3]) {
        DnSolve<I - 1>::run(X, Lt);
        float a = X[I];
#pragma unroll
        for (int j = 0; j < I; ++j) { const int jl = j & 31, reg = (jl & 3) + 4 * (jl >> 3), hj = (jl >> 2) & 1, src = (I & 31) + 32 * hj;
            a -= rdlane(Lt[DN_TILE(j >> 5, I >> 5)][reg], src) * X[j]; }
        X[I] = a;
        __builtin_amdgcn_sched_barrier(0);
    }
};
template <> struct DnSolve<-1> { static DI void run(float (&)[64], const f32x16 (&)[3]) {} };

DI void phase_dn1(const Frame& F0, const Params& P) {
    const Frame F = relaunder(F0);
    const bf16_t* dnp = wsp<bf16_t>(P, WS_DNP); const float* gb = wsp<float>(P, WS_GB);
    bf16_t* An_g = wsp<bf16_t>(P, WS_AN); bf16_t* Qe_g = wsp<bf16_t>(P, WS_QE); unsigned* Bn_g = wsp<unsigned>(P, WS_BN); float* Oi_g = wsp<float>(P, WS_OI);
    LAS unsigned char* XT = F.lds + F.wave * 16384;
    LAS float* gcs = (LAS float*)(XT + 9216); LAS float* bts = gcs + 64; LAS unsigned char* QpL = XT + 9728;
#define QP(tl, s) (*(const LAS bf16x8*)(QpL + (((tl) * 2 + (s)) * 64 + lane) * 16))
    const int nfull = (NUNIT / F.ngw) * F.ngw, nrem = NUNIT - nfull;
    for (int lin = F.gw; ; lin += F.ngw) {
        int uid, part;
        if (lin < nfull) { uid = lin; part = 2; } else { const int r = lin - nfull; if (r >= 2 * nrem) break; uid = nfull + (r >> 1); part = r & 1; }
        int lane = F.lane; LAUNDER_V(lane); const int r32 = lane & 31, hh = lane >> 5;
        const int n = uid % NCH, dir = (uid / NCH) & 1, h = (uid / (2 * NCH)) % NH, b = uid / (2 * NCH * NH);
        int seqb, T, nn; if (n < NCC) { seqb = R_LAT + b * CTX; T = CTX; nn = n; } else { seqb = b * SEQ; T = SEQ; nn = n - NCC; }
        const int rbase = dir ? seqb + T - 1 - 64 * nn : seqb + 64 * nn, sgn = dir ? -1 : 1;
#define ROWI(i) ((size_t)(rbase + sgn * (i)))
        const bf16_t* qb_ = dnp + h * 64; const bf16_t* kb_ = dnp + 256 + h * 64; const bf16_t* vb_ = dnp + 512 + h * 64;
        float gc = gb[ROWI(lane) * 16 + dir * 4 + h]; const float beta = gb[ROWI(lane) * 16 + 8 + dir * 4 + h];
#pragma unroll
        for (int o = 1; o < 64; o <<= 1) { const float t = __shfl_up(gc, o); if (lane >= o) gc += t; }
        gcs[lane] = gc; bts[lane] = beta;
        const float glast = __shfl(gc, 63), eglast = __expf(glast);
        WAIT_LGKM(0); CFENCE();
        f32x16 Lt[3];
        {
            bf16x8 Ak[2][4], Bq[2][4];
#pragma unroll
            for (int t2 = 0; t2 < 2; ++t2)
#pragma unroll
                for (int ks = 0; ks < 4; ++ks) { const size_t ro = ROWI(32 * t2 + r32) * 768 + 16 * ks + 8 * hh; Ak[t2][ks] = *(const bf16x8*)(kb_ + ro); Bq[t2][ks] = *(const bf16x8*)(qb_ + ro); }
            const float gci[2] = {gcs[r32], gcs[32 + r32]}, bti[2] = {bts[r32], bts[32 + r32]};
#pragma unroll
            for (int tl = 0; tl < 3; ++tl) { const int jt = (tl == 2) ? 1 : 0, it = (tl == 0) ? 0 : 1;
                f32x16 kk = zero16(), qk = zero16();
#pragma unroll
                for (int ks = 0; ks < 4; ++ks) { kk = MFMA32(Ak[jt][ks], Ak[it][ks], kk); qk = MFMA32(Ak[jt][ks], Bq[it][ks], qk); }
                const int i = 32 * it + r32;
#pragma unroll
                for (int reg = 0; reg < 16; ++reg) { const int j = 32 * jt + crow(reg, hh); const float dec = (i >= j) ? __expf(gci[it] - gcs[j]) : 0.f;
                    qk[reg] = qk[reg] * dec; kk[reg] = (i > j) ? bti[it] * kk[reg] * dec : 0.f; }
                Lt[tl] = kk; *(LAS bf16x8*)(QpL + ((tl * 2 + 0) * 64 + lane) * 16) = pack8(qk, 0); *(LAS bf16x8*)(QpL + ((tl * 2 + 1) * 64 + lane) * 16) = pack8(qk, 1); }
        }
        __builtin_amdgcn_sched_barrier(0);
        float X[64];
        if (part != 1) {
#pragma unroll
        for (int i = 0; i < 64; ++i) X[i] = bf2f(vb_[ROWI(i) * 768 + lane]) * rdlane(beta, i);
        __builtin_amdgcn_sched_barrier(0);
        DnSolve<63>::run(X, Lt);
#pragma unroll
        for (int q = 0; q < 8; ++q) { u32x4 w; w.x = pk2(X[8 * q], X[8 * q + 1]); w.y = pk2(X[8 * q + 2], X[8 * q + 3]); w.z = pk2(X[8 * q + 4], X[8 * q + 5]); w.w = pk2(X[8 * q + 6], X[8 * q + 7]); *(LAS u32x4*)(XT + lane * 144 + 16 * q) = w; }
        WAIT_LGKM(0); CFENCE();
        __builtin_amdgcn_sched_barrier(0);
#pragma unroll
        for (int it = 0; it < 2; ++it)
#pragma unroll
            for (int et = 0; et < 2; ++et) { f32x16 z = zero16();
#pragma unroll
                for (int jt = 0; jt <= it; ++jt)
#pragma unroll
                    for (int s = 0; s < 2; ++s) { const LAS unsigned char* p = XT + (32 * et + r32) * 144 + (32 * jt + 16 * s + 4 * hh) * 2;
                        z = MFMA32(QP(DN_TILE(jt, it), s), cat44(*(const LAS u32x2*)p, *(const LAS u32x2*)(p + 16)), z); }
                float* op = Oi_g + (size_t)uid * 4096 + 32 * et + r32;
#pragma unroll
                for (int reg = 0; reg < 16; ++reg) op[(32 * it + crow(reg, hh)) * 64] = z[reg]; }
        }
        __builtin_amdgcn_sched_barrier(0);
        bf16x8 Kd[2][4];
#pragma unroll
        for (int dt = 0; dt < 2; ++dt)
#pragma unroll
            for (int s4 = 0; s4 < 4; ++s4) { float v[8];
#pragma unroll
                for (int jj = 0; jj < 8; ++jj) { const int j = 16 * s4 + 8 * hh + jj; v[jj] = bf2f(kb_[ROWI(j) * 768 + 32 * dt + r32]) * __expf(glast - gcs[j]); }
                u32x4 w; w.x = pk2(v[0], v[1]); w.y = pk2(v[2], v[3]); w.z = pk2(v[4], v[5]); w.w = pk2(v[6], v[7]); Kd[dt][s4] = __builtin_bit_cast(bf16x8, w); }
        if (part != 1) {
#pragma unroll
        for (int dt = 0; dt < 2; ++dt)
#pragma unroll
            for (int et = 0; et < 2; ++et) { f32x16 z = zero16();
#pragma unroll
                for (int s4 = 0; s4 < 4; ++s4) z = MFMA32(Kd[dt][s4], *(const LAS bf16x8*)(XT + (32 * et + r32) * 144 + (16 * s4 + 8 * hh) * 2), z);
                u32x4* op = (u32x4*)(Bn_g + (size_t)uid * 2048 + ((dt * 2 + et) * 64 + lane) * 8);
                op[0] = (u32x4){pk2(z[0], z[1]), pk2(z[2], z[3]), pk2(z[4], z[5]), pk2(z[6], z[7])}; op[1] = (u32x4){pk2(z[8], z[9]), pk2(z[10], z[11]), pk2(z[12], z[13]), pk2(z[14], z[15])}; }
        }
        if (part != 0) {
        CFENCE();
        LAUNDER_V(Lt[0]); LAUNDER_V(Lt[1]); LAUNDER_V(Lt[2]);
        { const float bw = beta * __expf(gc);
#pragma unroll
          for (int i = 0; i < 64; ++i) X[i] = bf2f(kb_[ROWI(i) * 768 + lane]) * rdlane(bw, i); }
        __builtin_amdgcn_sched_barrier(0);
        DnSolve<63>::run(X, Lt);
#pragma unroll
        for (int q = 0; q < 8; ++q) { u32x4 w; w.x = pk2(X[8 * q], X[8 * q + 1]); w.y = pk2(X[8 * q + 2], X[8 * q + 3]); w.z = pk2(X[8 * q + 4], X[8 * q + 5]); w.w = pk2(X[8 * q + 6], X[8 * q + 7]); *(LAS u32x4*)(XT + lane * 144 + 16 * q) = w; }
        WAIT_LGKM(0); CFENCE();
        __builtin_amdgcn_sched_barrier(0);
#pragma unroll
        for (int dt = 0; dt < 2; ++dt)
#pragma unroll
            for (int et = 0; et < 2; ++et) { f32x16 z = zero16();
#pragma unroll
                for (int s4 = 0; s4 < 4; ++s4) z = MFMA32(Kd[dt][s4], *(const LAS bf16x8*)(XT + (32 * et + r32) * 144 + (16 * s4 + 8 * hh) * 2), z);
                const int x = r32 & 15, hhA = (x >> 2) & 1, jj = ((x >> 3) << 2) | (x & 3);
                bf16_t* op = An_g + (size_t)uid * 4096 + (((dt * 2 + et) * 2 + (r32 >> 4)) * 64 + 32 * hhA) * 8 + jj;
#pragma unroll
                for (int reg = 0; reg < 16; ++reg) { const int dl = crow(reg, hh); op[dl * 8] = f2bf(((32 * dt + dl == 32 * et + r32) ? eglast : 0.f) - z[reg]); } }
        __builtin_amdgcn_sched_barrier(0);
#pragma unroll
        for (int it = 0; it < 2; ++it) { const int i = 32 * it + r32; const float eg = __expf(gcs[i]);
#pragma unroll
            for (int dt = 0; dt < 2; ++dt) { f32x16 y = zero16();
#pragma unroll
                for (int jt = 0; jt <= it; ++jt)
#pragma unroll
                    for (int s = 0; s < 2; ++s) { const LAS unsigned char* p = XT + (32 * dt + r32) * 144 + (32 * jt + 16 * s + 4 * hh) * 2;
                        y = MFMA32(cat44(*(const LAS u32x2*)p, *(const LAS u32x2*)(p + 16)), QP(DN_TILE(jt, it), s), y); }
#pragma unroll
                for (int a = 0; a < 4; ++a) { const int d0 = 32 * dt + 8 * a + 4 * hh; const u32x2 qv = *(const u32x2*)(qb_ + ROWI(i) * 768 + d0);
                    u32x2 o; o.x = pk2(bflo(qv.x) * eg - y[4 * a], bfhi(qv.x) * eg - y[4 * a + 1]); o.y = pk2(bflo(qv.y) * eg - y[4 * a + 2], bfhi(qv.y) * eg - y[4 * a + 3]);
                    *(u32x2*)(Qe_g + (size_t)uid * 4096 + i * 64 + d0) = o; } } }
        }
        WAIT_LGKM(0); CFENCE();
#undef ROWI
    }
}

DI void dn2_load(const bf16_t* An_g, const unsigned* Bn_g, size_t uid, int et, int lane, u32x4 (&Ar)[8], u32x4 (&Br)[4]) {
#pragma unroll
    for (int f = 0; f < 8; ++f) Ar[f] = *(const u32x4*)(An_g + uid * 4096 + (f * 64 + lane) * 8);
#pragma unroll
    for (int dt = 0; dt < 2; ++dt) { const u32x4* bp = (const u32x4*)(Bn_g + uid * 2048 + ((dt * 2 + et) * 64 + lane) * 8); Br[2 * dt] = bp[0]; Br[2 * dt + 1] = bp[1]; }
}
DI void dn2_step(bf16_t* Sn_g, size_t uid, int et, int lane, f32x16 (&S)[2], const u32x4 (&Ar)[8], const u32x4 (&Br)[4]) {
    bf16x8 Sp[2][2];
#pragma unroll
    for (int dp = 0; dp < 2; ++dp)
#pragma unroll
        for (int s = 0; s < 2; ++s) { Sp[dp][s] = pack8(S[dp], s); *(bf16x8*)(Sn_g + uid * 4096 + (((et * 2 + dp) * 2 + s) * 64 + lane) * 8) = Sp[dp][s]; }
#pragma unroll
    for (int dt = 0; dt < 2; ++dt) { f32x16 z;
#pragma unroll
        for (int h2 = 0; h2 < 2; ++h2) { const u32x4 w = Br[2 * dt + h2]; z[8 * h2] = bflo(w.x); z[8 * h2 + 1] = bfhi(w.x); z[8 * h2 + 2] = bflo(w.y); z[8 * h2 + 3] = bfhi(w.y); z[8 * h2 + 4] = bflo(w.z); z[8 * h2 + 5] = bfhi(w.z); z[8 * h2 + 6] = bflo(w.w); z[8 * h2 + 7] = bfhi(w.w); }
#pragma unroll
        for (int dp = 0; dp < 2; ++dp)
#pragma unroll
            for (int s = 0; s < 2; ++s) z = MFMA32(__builtin_bit_cast(bf16x8, Ar[(dt * 2 + dp) * 2 + s]), Sp[dp][s], z);
        S[dt] = z; }
}
DI void phase_dn2(const Frame& F0, const Params& P) {
    const Frame F = relaunder(F0);
    const bf16_t* An_g = wsp<bf16_t>(P, WS_AN); const unsigned* Bn_g = wsp<unsigned>(P, WS_BN); bf16_t* Sn_g = wsp<bf16_t>(P, WS_SN);
    const int lane = F.lane;
    constexpr int NCHAIN = NB * NH * 2 * 2;
    if (F.wave < 4)
    for (int cid = F.bid * 4 + F.wave; cid < NCHAIN; cid += F.G * 4) {
        const int et = cid & 1; const size_t uid0 = (size_t)(cid >> 1) * NCH;
        f32x16 S[2] = {zero16(), zero16()};
        u32x4 A0[8], A1[8], A2[8], B0[4], B1[4], B2[4];
        dn2_load(An_g, Bn_g, uid0, et, lane, A0, B0);
        dn2_load(An_g, Bn_g, uid0 + (1 < NCH ? 1 : 0), et, lane, A1, B1);
        dn2_load(An_g, Bn_g, uid0 + (2 < NCH ? 2 : 0), et, lane, A2, B2);
        for (int n = 0; n < NCH; n += 3) {
            dn2_step(Sn_g, uid0 + n, et, lane, S, A0, B0);
            dn2_load(An_g, Bn_g, uid0 + (n + 3 < NCH ? n + 3 : n), et, lane, A0, B0);
            if (n + 1 < NCH) { dn2_step(Sn_g, uid0 + n + 1, et, lane, S, A1, B1); dn2_load(An_g, Bn_g, uid0 + (n + 4 < NCH ? n + 4 : n), et, lane, A1, B1); }
            if (n + 2 < NCH) { dn2_step(Sn_g, uid0 + n + 2, et, lane, S, A2, B2); dn2_load(An_g, Bn_g, uid0 + (n + 5 < NCH ? n + 5 : n), et, lane, A2, B2); }
        }
    }
}

DI void phase_dn3(const Frame& F0, const Params& P, const int l, const int pidx, const int np) {
    const Frame F = relaunder(F0);
    const bf16_t* Qe_g = wsp<bf16_t>(P, WS_QE); const bf16_t* Sn_g = wsp<bf16_t>(P, WS_SN); const float* Oi_g = wsp<float>(P, WS_OI);
    const bf16_t* proj = wsp<bf16_t>(P, WS_PROJ); bf16_t* mix = wsp<bf16_t>(P, WS_MIX); const float* ng = P.in[I_DNG] + l * 64;
    const int lane = F.lane, r32 = lane & 31, hh = lane >> 5;
    const int NC = NCL + ((l < DEPTH - 1) ? NCC : 0);
    for (int u = F.wave * np + pidx; u < NB * NH * NC; u += np * 8) {
        const int ca = u % NC, h = (u / NC) % NH, b = u / (NC * NH);
        int rowb, nf, nbk; if (ca < NCL) { rowb = b * SEQ + 64 * ca; nf = NCC + ca; nbk = NCC + (NCL - 1 - ca); } else { const int c = ca - NCL; rowb = R_LAT + b * CTX + 64 * c; nf = c; nbk = NCC - 1 - c; }
        f32x16 O[2][2] = {{zero16(), zero16()}, {zero16(), zero16()}};
#pragma unroll
        for (int dir = 0; dir < 2; ++dir) { const size_t uid = (size_t)((b * NH + h) * 2 + dir) * NCH + (dir ? nbk : nf);
#pragma unroll
            for (int it = 0; it < 2; ++it) { const int x = 32 * it + r32, xi = dir ? 63 - x : x;
                bf16x8 Bq[2][2];
#pragma unroll
                for (int dp = 0; dp < 2; ++dp)
#pragma unroll
                    for (int s = 0; s < 2; ++s) { const bf16_t* p = Qe_g + uid * 4096 + xi * 64 + 32 * dp + 16 * s + 4 * hh; Bq[dp][s] = cat44(*(const u32x2*)p, *(const u32x2*)(p + 8)); }
#pragma unroll
                for (int et = 0; et < 2; ++et) { f32x16 z = O[et][it];
#pragma unroll
                    for (int dp = 0; dp < 2; ++dp)
#pragma unroll
                        for (int s = 0; s < 2; ++s) z = MFMA32(*(const bf16x8*)(Sn_g + uid * 4096 + (((et * 2 + dp) * 2 + s) * 64 + lane) * 8), Bq[dp][s], z);
#pragma unroll
                    for (int a = 0; a < 4; ++a) { const f32x4 oi = *(const f32x4*)(Oi_g + uid * 4096 + xi * 64 + 32 * et + 8 * a + 4 * hh); z[4 * a] += oi.x; z[4 * a + 1] += oi.y; z[4 * a + 2] += oi.z; z[4 * a + 3] += oi.w; }
                    O[et][it] = z; } } }
#pragma unroll
        for (int it = 0; it < 2; ++it) { const size_t row = (size_t)rowb + 32 * it + r32; float ss = 0.f;
#pragma unroll
            for (int et = 0; et < 2; ++et)
#pragma unroll
                for (int reg = 0; reg < 16; ++reg) ss += O[et][it][reg] * O[et][it][reg];
            ss += __shfl_xor(ss, 32);
            const float r = 1.0f / sqrtf(ss * (1.0f / 64.0f) + RMS_EPS);
#pragma unroll
            for (int et = 0; et < 2; ++et)
#pragma unroll
                for (int a = 0; a < 4; ++a) { const int e0 = 32 * et + 8 * a + 4 * hh; const f32x4 g = *(const f32x4*)(ng + e0); const u32x2 gt = *(const u32x2*)(proj + row * PLD + 6 * 256 + h * 64 + e0);
                    const f32x16& z = O[et][it];
                    u32x2 o; o.x = pk2(z[4 * a] * r * g.x * siluf(bflo(gt.x)), z[4 * a + 1] * r * g.y * siluf(bfhi(gt.x))); o.y = pk2(z[4 * a + 2] * r * g.z * siluf(bflo(gt.y)), z[4 * a + 3] * r * g.w * siluf(bfhi(gt.y)));
                    *(u32x2*)(mix + row * D + 256 + h * 64 + e0) = o; } }
    }
}

struct TileInfo { int row0, dyb, kc0; };
#ifdef EMU
DI s16x4 lds_tr16(const LAS unsigned char* p) {
    emu::Wave* w = emu::cur->wave; const int lane = emu::cur->lane;
    const int slot = emu::rendezvous(&p, sizeof(p), [](emu::Wave*, int) {});
    s16x4 r; const int g = lane >> 4, i = lane & 15;
    for (int q = 0; q < 4; ++q) { const unsigned char* a; memcpy(&a, w->stage[slot][16 * g + 4 * q + (i >> 2)], sizeof(a)); short v; memcpy(&v, a + 2 * (i & 3), 2); r[q] = v; }
    emu::rendezvous(nullptr, 0, [](emu::Wave*, int) {});
    return r;
}
#else
DI s16x4 lds_tr16(const LAS unsigned char* p) { return __builtin_amdgcn_ds_read_tr16_b64_v4i16((LAS s16x4*)p); }
#endif
DI int att_off(int row, int ch) { return 256 * row + 16 * (ch ^ (((row & 3) << 2) | ((row >> 2) & 3))); }
template <int NMAP, int TC, int SUBS, class TF>
DI void attn_core(const Frame& F, LAS unsigned char* lds, const bf16_t* proj, const bool active, const int qrow, const int qcol, const int kcol, const int vcol, const int hoff,
                  const int ntiles32, const TF& tf, const float sc, const LAS float* bias, const int qc, float (&mS)[NMAP], float (&lS)[NMAP], f32x16 (&O)[NMAP][2]) {
    static_assert(SUBS == 1, "one 32-key tile per stage");
    constexpr int KS = 4 / NMAP, NIMG = TC / 64, BUFB = NIMG * 8192, PIECES = 4 * TC, PPT = (2 * PIECES + 511) / 512, CPR = TC / 8;
    constexpr bool FULL = (2 * PIECES) % 512 == 0;
    const int ntiles = ntiles32;
    const int lane = F.lane, r32 = lane & 31, hh = lane >> 5, tid = F.tid;
    const int c0q = (qc - 8 < 0) ? 0 : ((qc - 8 > 48) ? 48 : qc - 8);
    (void)sc;
    bf16x8 qf[NMAP][KS];
#pragma unroll
    for (int mi = 0; mi < NMAP; ++mi)
#pragma unroll
        for (int ks = 0; ks < KS; ++ks) qf[mi][ks] = *(const bf16x8*)(proj + (size_t)(active ? qrow : 0) * PLD + qcol + mi * 32 + ks * 16 + hh * 8);
#pragma unroll
    for (int mi = 0; mi < NMAP; ++mi) { mS[mi] = 0.f; lS[mi] = 0.f; O[mi][0] = zero16(); O[mi][1] = zero16(); }
    u32x4 stg[PPT], stg2[PPT];
#define ATT_LOAD(ti_, dst_) do { _Pragma("unroll") for (int j = 0; j < PPT; ++j) { const int idx = tid + 512 * j; if (FULL || idx < 2 * PIECES) { const bool isV = idx >= PIECES; const int p = isV ? idx - PIECES : idx; \
        dst_[j] = *(const u32x4*)(proj + (size_t)((ti_).row0 + p / CPR) * PLD + (isV ? vcol : kcol) + (p % CPR) * 8); } } } while (0)
#define ATT_STORE_FROM(buf_, src_) do { _Pragma("unroll") for (int j = 0; j < PPT; ++j) { const int idx = tid + 512 * j; if (FULL || idx < 2 * PIECES) { const bool isV = idx >= PIECES; const int p = isV ? idx - PIECES : idx; const int cc = p % CPR; \
        *(LAS u32x4*)(lds + (buf_) * BUFB + (cc >> 3) * 8192 + att_off(p / CPR, (cc & 7) + (isV ? 8 : 0))) = src_[j]; } } } while (0)
    const int img = hoff / 64 * 8192;
    int kaddr[4];
#pragma unroll
    for (int s = 0; s < 4; ++s) kaddr[s] = img + att_off(r32, 2 * s + hh);
    const int trq = (lane & 15) >> 2, trp = lane & 3, trb = (lane >> 4) & 1;
    int vaddr[2][2][2];
#pragma unroll
    for (int dt = 0; dt < 2; ++dt)
#pragma unroll
        for (int s2 = 0; s2 < 2; ++s2)
#pragma unroll
            for (int t = 0; t < 2; ++t) vaddr[dt][s2][t] = img + att_off(16 * s2 + 8 * t + 4 * hh + trq, 8 + 4 * dt + 2 * trb + (trp >> 1)) + 8 * (trp & 1);
    f32x16 negm[NMAP], Lacc[NMAP];
#pragma unroll
    for (int mi = 0; mi < NMAP; ++mi) { negm[mi] = zero16(); Lacc[mi] = zero16(); }
    const bf16x8 ones8 = {(short)0x3f80, (short)0x3f80, (short)0x3f80, (short)0x3f80, (short)0x3f80, (short)0x3f80, (short)0x3f80, (short)0x3f80};
    auto compute = [&](const int buf, const TileInfo ti, const bool first) {
        if (active) {
            const LAS unsigned char* Tb = lds + buf * BUFB;
            bf16x8 vf[2][2];
#pragma unroll
            for (int dt = 0; dt < 2; ++dt)
#pragma unroll
                for (int s2 = 0; s2 < 2; ++s2) { const s16x4 lo = lds_tr16(Tb + vaddr[dt][s2][0]), hi = lds_tr16(Tb + vaddr[dt][s2][1]);
                    vf[dt][s2] = __builtin_shufflevector(lo, hi, 0, 1, 2, 3, 4, 5, 6, 7); }
#pragma unroll
            for (int mi = 0; mi < NMAP; ++mi) {
                f32x16 st = negm[mi];
#pragma unroll
                for (int ks = 0; ks < KS; ++ks) st = MFMA32(*(const LAS bf16x8*)(Tb + kaddr[mi * KS + ks]), qf[mi][ks], st);
                float tmax = -3.0e38f;
                if (ti.dyb >= 0) {
#pragma unroll
                    for (int reg = 0; reg < 16; ++reg) { const int kc = ti.kc0 + crow(reg, hh); const bool ok = (kc >= c0q) && (kc < c0q + 16); const float bv = bias[ti.dyb + (ok ? kc - qc + 15 : 0)];
                        const float x = ok ? st[reg] + bv : -1.0e30f; st[reg] = x; tmax = fmaxf(tmax, x); }
                } else {
#pragma unroll
                    for (int reg = 0; reg < 16; ++reg) tmax = fmaxf(tmax, st[reg]);
                }
                tmax = fmaxf(tmax, __shfl_xor(tmax, 32));
                if (first || __any(tmax > 6.0f)) { const float delta = first ? tmax : fmaxf(tmax, 0.f), alpha = fexp2(-delta);
                    if (!first) { Lacc[mi] = Lacc[mi] * alpha; O[mi][0] = O[mi][0] * alpha; O[mi][1] = O[mi][1] * alpha; }
                    negm[mi] = negm[mi] - delta; st = st - delta; }
#pragma unroll
                for (int reg = 0; reg < 16; ++reg) st[reg] = fexp2(st[reg]);
#pragma unroll
                for (int s2 = 0; s2 < 2; ++s2) { const bf16x8 pf = pack8(st, s2);
                    Lacc[mi] = MFMA32(ones8, pf, Lacc[mi]);
#pragma unroll
                    for (int dt = 0; dt < 2; ++dt) O[mi][dt] = MFMA32(vf[dt][s2], pf, O[mi][dt]); }
            }
        }
    };
    constexpr int NSTG = (PPT == 1) ? 4 : 2;
    u32x4 stg3[PPT], stg4[PPT];
    { const TileInfo t0 = tf(0); ATT_LOAD(t0, stg); }
    { const TileInfo t1 = tf(1 < ntiles ? 1 : 0); ATT_LOAD(t1, stg2); }
    if (NSTG == 4) { { const TileInfo t2 = tf(2 < ntiles ? 2 : 0); ATT_LOAD(t2, stg3); } { const TileInfo t3 = tf(3 < ntiles ? 3 : 0); ATT_LOAD(t3, stg4); } }
#define ATT_STEP(k_, reg_) do { ATT_STORE_FROM((k_) & 1, reg_); \
        WAIT_LGKM(0); __builtin_amdgcn_s_barrier(); CFENCE();     \
        { const int nx = (i + (k_) + NSTG < ntiles) ? i + (k_) + NSTG : ntiles - 1; const TileInfo tn = tf(nx); ATT_LOAD(tn, reg_); } \
        compute((k_) & 1, tf(i + (k_)), i + (k_) == 0); } while (0)
    for (int i = 0; i < ntiles; i += NSTG) {
        ATT_STEP(0, stg); ATT_STEP(1, stg2);
        if (NSTG == 4) { ATT_STEP(2, stg3); ATT_STEP(3, stg4); }
    }
#undef ATT_STEP
#pragma unroll
    for (int mi = 0; mi < NMAP; ++mi) lS[mi] = 0.5f * Lacc[mi][0];
    __syncthreads();
#undef ATT_LOAD
#undef ATT_STORE_FROM
}

constexpr int NCHB = (NB * NH * 4 + 3) / 4;
DI bool chain_dedicated(int G) { return G >= 4 * NCHB; }
constexpr int NA_BUFB = 4 * 8192;
constexpr int NA_BIAS_OFF = 2 * NA_BUFB;
template <int PART> DI void phase_attn(const Frame& F0, const Params& P, const int l, const bool lat_on = true, const bool ctx_on = true, const int Gd = 0, const int cd = 0) {
    const Frame F = relaunder(F0);
    const bf16_t* proj = wsp<bf16_t>(P, WS_PROJ); bf16_t* mix = wsp<bf16_t>(P, WS_MIX);
    const bool last = (l == DEPTH - 1);
    const int lane = F.lane, r32 = lane & 31, hh = lane >> 5, wave = F.wave;
    LAS float* bias = (LAS float*)(F.lds + NA_BIAS_OFF);
    const bool dedicated = chain_dedicated(F.G); const int first = dedicated ? NCHB : 0;
    if (PART == 0 && (!dedicated || F.bid >= NCHB)) {
    for (int i = F.tid; i < 4 * 465; i += 512) bias[i] = P.in[I_RPB][(size_t)l * 4 * 465 + i] * LOG2E;
    __syncthreads();
    { const int nlat = NB * GROWS, nctx = last ? 0 : NB * (CTX / 64);
      for (int uq = F.bid - first; uq < nlat + nctx; uq += F.G - first) {
        const int u = (uq < nlat && nlat % 8 == 0) ? (uq % 8) * (nlat / 8) + uq / 8 : uq;
        const int h = wave >> 1, qh = wave & 1; int qrow, ntiles, b, r = 0, wstart = 0; const int nct = CTX / 32;
        if (u < nlat) { b = u / GROWS; r = u % GROWS; qrow = b * SEQ + r * 64 + qh * 32 + r32; int ws = r - WH / 2; ws = ws < 0 ? 0 : (ws > GROWS - WH ? GROWS - WH : ws); wstart = ws; ntiles = nct + 2 * WH; }
        else { const int uu = u - nlat; b = uu / (CTX / 64); qrow = R_LAT + b * CTX + (uu % (CTX / 64)) * 64 + qh * 32 + r32; ntiles = nct; }
        auto tf = [&](int i) { TileInfo t; if (i < nct) { t.row0 = R_LAT + b * CTX + 32 * i; t.dyb = -1; t.kc0 = 0; } else { const int w = (i - nct) >> 1, half = (i - nct) & 1, wrow = wstart + w; t.row0 = b * SEQ + wrow * 64 + 32 * half; t.dyb = (wrow - r + 7) * 31; t.kc0 = 32 * half; } return t; };
        float mS[1], lS[1]; f32x16 O[1][2];
        attn_core<1, 256, 1>(F, F.lds, proj, true, qrow, h * 64, 256, 512, 64 * h, ntiles, tf, 0.125f * LOG2E, bias + h * 465, qh * 32 + r32, mS, lS, O);
        const float inv = 1.0f / (lS[0] + __shfl_xor(lS[0], 32));
#pragma unroll
        for (int dt = 0; dt < 2; ++dt)
#pragma unroll
            for (int a = 0; a < 4; ++a) { const int d0 = 32 * dt + 8 * a + 4 * hh; u32x2 o; o.x = pk2(O[0][dt][4 * a] * inv, O[0][dt][4 * a + 1] * inv); o.y = pk2(O[0][dt][4 * a + 2] * inv, O[0][dt][4 * a + 3] * inv);
                *(u32x2*)(mix + (size_t)qrow * D + h * 64 + d0) = o; }
      } }
    }
    if (PART == 1) { const float lam_init = 0.8f - 0.6f * expf(-0.3f * (float)l);
      const float* dl = P.in[I_DFLAM] + (size_t)l * 128; const float p1 = (lane < 32) ? dl[lane] * dl[32 + lane] : 0.f, p2 = (lane < 32) ? dl[64 + lane] * dl[96 + lane] : 0.f;
      const float lam = expf(wave_sum(p1)) - expf(wave_sum(p2)) + lam_init;
      const float* dg = P.in[I_DFG] + l * 64;
      constexpr int QBL = SEQ / 256, QBC = (CTX + 255) / 256; const int nlat = lat_on ? NB * NH * QBL : 0, nctx = (last || !ctx_on) ? 0 : NB * NH * QBC; const int nct = CTX / 32;
      for (int u0 = cd; u0 < nlat + nctx; u0 += Gd) {
        const int ul = u0 - nctx, u = (u0 < nctx) ? nlat + u0 : ((nlat % 8 == 0) ? (ul % 8) * (nlat / 8) + ul / 8 : ul);
        int b, h, qrow, ntiles; bool active = true;
        if (u < nlat) { const int qb = u % QBL; h = (u / QBL) % NH; b = u / (QBL * NH); qrow = b * SEQ + qb * 256 + 32 * wave + r32; ntiles = nct + SEQ / 32; }
        else { const int uu = u - nlat, qb = uu % QBC; h = (uu / QBC) % NH; b = uu / (QBC * NH); active = (qb * 256 + 32 * wave) < CTX; qrow = R_LAT + b * CTX + qb * 256 + 32 * wave + r32; ntiles = nct; }
        auto tf = [&](int i) { TileInfo t; t.row0 = (i < nct) ? R_LAT + b * CTX + 32 * i : b * SEQ + 32 * (i - nct); t.dyb = -1; t.kc0 = 0; return t; };
        float mS[2], lS[2]; f32x16 O[2][2];
        attn_core<2, 64, 1>(F, F.lds, proj, active, qrow, 7 * 256 + h * 64, 8 * 256 + h * 64, 9 * 256 + h * 64, 0, ntiles, tf, 0.17677669529663687f * LOG2E, bias, 0, mS, lS, O);
        if (active) {
            const float i1 = 1.0f / (lS[0] + __shfl_xor(lS[0], 32)), i2 = lam / (lS[1] + __shfl_xor(lS[1], 32));
            float ss = 0.f;
#pragma unroll
            for (int dt = 0; dt < 2; ++dt)
#pragma unroll
                for (int reg = 0; reg < 16; ++reg) { const float o = O[0][dt][reg] * i1 - O[1][dt][reg] * i2; O[0][dt][reg] = o; ss += o * o; }
            ss += __shfl_xor(ss, 32);
            const float rr = (1.0f - lam_init) / sqrtf(ss * (1.0f / 64.0f) + RMS_EPS);
#pragma unroll
            for (int dt = 0; dt < 2; ++dt)
#pragma unroll
                for (int a = 0; a < 4; ++a) { const int d0 = 32 * dt + 8 * a + 4 * hh; const f32x4 g = *(const f32x4*)(dg + d0);
                    u32x2 o; o.x = pk2(O[0][dt][4 * a] * rr * g.x, O[0][dt][4 * a + 1] * rr * g.y); o.y = pk2(O[0][dt][4 * a + 2] * rr * g.z, O[0][dt][4 * a + 3] * rr * g.w);
                    *(u32x2*)(mix + (size_t)qrow * D + 512 + h * 64 + d0) = o; }
        }
      } }
}
DI void phase_ftreduce(const Frame& F0, const Params& P, const int l, const int pidx, const int np, const bool lat_on, const bool ctx_on) {
    const Frame F = relaunder(F0);
    const float* slab = wsp<float>(P, WS_SLAB); const float* slabc = wsp<float>(P, WS_SLABC); bf16_t* mix = wsp<bf16_t>(P, WS_MIX);
    const int gt = pidx * 512 + F.tid, ngt = np * 512;
    const int nl = lat_on ? R_LAT * 64 : 0, nc = (ctx_on && l < DEPTH - 1) ? R_CTX * 64 : 0;
    constexpr size_t SLABSZ = (size_t)NB * HSEQ * 64;
    for (int i = gt; i < nl + nc; i += ngt) {
        f32x4 v; int row; int c4;
        if (i < nl) { row = i / 64; c4 = i % 64; const int b = row / SEQ, k = row % SEQ;
            if (k == 0) continue;
            const int kk = (k <= HSEQ) ? k : SEQ - k; const size_t o = ((size_t)b * HSEQ + kk - 1) * 64 + c4;
            f32x4 p = *((const f32x4*)slab + o), q = *((const f32x4*)slab + (size_t)KSPLIT * SLABSZ + o);
#pragma unroll
            for (int ks = 1; ks < KSPLIT; ++ks) { p += *((const f32x4*)slab + (size_t)ks * SLABSZ + o); q += *((const f32x4*)slab + (size_t)(KSPLIT + ks) * SLABSZ + o); }
            v = (k <= HSEQ) ? p + q : p - q; }
        else { const int j = i - nl; row = R_LAT + j / 64; c4 = j % 64; v = *((const f32x4*)slabc + j); }
        u32x2 o; o.x = pk2(v.x, v.y); o.y = pk2(v.z, v.w); *(u32x2*)(mix + (size_t)row * D + 768 + 4 * c4) = o;
    }
    if (lat_on) { const bf16_t* ztl = wsp<bf16_t>(P, WS_ZTL); const float sc = 1.0f / sqrtf((float)SEQ);
      for (int u = F.wave * np + pidx; u < NB * 256; u += np * 8) { const bf16_t* zr = ztl + (size_t)u * 2 * SEQ; float s = 0.f;
          for (int t = 8 * F.lane; t < SEQ; t += 512) { const u32x4 w = *(const u32x4*)(zr + t); s += (bflo(w.x) + bfhi(w.x)) + (bflo(w.y) + bfhi(w.y)) + (bflo(w.z) + bfhi(w.z)) + (bflo(w.w) + bfhi(w.w)); }
          s = wave_sum(s);
          if (F.lane == 0) mix[((size_t)(u / 256) * SEQ) * D + 768 + (u % 256)] = f2bf(s * sc); } }
}

#define REP_P0 1
#define REP_PROJ 1
#define REP_DN0 1
#define REP_DN1 1
#define REP_CHAIN 1
#define REP_DFT 1
#define REP_ATT 1
#define REP_N2 1
#define REP_TOPK 1
#define REP_GU 1
#define REP_DOWN 1
__global__ void __launch_bounds__(512, 2) fwd_kernel(Params P) {
#ifdef EMU
    unsigned char* lds_raw = emu::cur->blk->lds;
#else
    extern __shared__ __attribute__((aligned(16))) unsigned char lds_raw[];
#endif
    Frame F; F.lds = (LAS unsigned char*)lds_raw; F.tid = threadIdx.x; F.lane = F.tid & 63; F.wave = __builtin_amdgcn_readfirstlane(F.tid >> 6);
    F.G = gridDim.x; F.bid = blockIdx.x; F.gw = F.wave * F.G + F.bid; F.ngw = F.G * 8;
    volatile LAS unsigned* misc = (volatile LAS unsigned*)(F.lds + LDS_MISC);
    if (F.tid < 64) misc[F.tid] = 0u;
    __syncthreads();
    XcdBarrier bar = xcd_barrier_post(wsp<unsigned>(P, WS_CTL) + CW_BAR, misc + 8);
#define GRID_BAR() xcd_barrier(bar)
#ifdef EMU
    const int emu_stop = getenv("EMU_STOP") ? atoi(getenv("EMU_STOP")) : -1;
#define EMU_STOP(l, ph) do { if (emu_stop == (l) * 100 + (ph)) return; } while (0)
#else
#define EMU_STOP(l, ph)
#endif

#pragma unroll
        for (int rep_ = 0; rep_ < REP_P0; ++rep_) {
    p0_weights(F, P);
    __syncthreads();
    p0_mod(F, P);
    p0_misc(F, P);
    GRID_BAR();
        }
    { SchedW S{F.G, F.bid, (const char*)wsp<bf16_t>(P, WS_MZT), (const char*)wsp<bf16_t>(P, WS_WFT)}; EpiW E{wsp<bf16_t>(P, WS_WIN)};
      g8::gemm_phase<EpiW, SchedW, false>(F.lds, 256, 256, S, E); }
    phase_norm1(F, P, 0);
    GRID_BAR();
    for (int l = 0; l < DEPTH; ++l) {
        const int last = (l == DEPTH - 1) ? 1 : 0;
        if (l > 0) { phase_norm1(F, P, l); GRID_BAR(); }
        EMU_STOP(l, 1);
#pragma unroll
        for (int rep_ = 0; rep_ < REP_PROJ; ++rep_) {
        { SchedProj S{F.G, F.bid, last, (const char*)wsp<bf16_t>(P, WS_H), (const char*)(wsp<bf16_t>(P, WS_WIN) + (size_t)l * NPROJ * D)};
          EpiProj E{wsp<bf16_t>(P, WS_PROJ), wsp<float>(P, WS_AB), wsp<bf16_t>(P, WS_ZTL), wsp<bf16_t>(P, WS_ZTC), wsp<float>(P, WS_ROPE)};
          g8::gemm_phase<EpiProj, SchedProj, false>(F.lds, D, D, S, E); }
        GRID_BAR();
        }
        EMU_STOP(l, 2);
#pragma unroll
        for (int rep_ = 0; rep_ < REP_DN0; ++rep_) {
        phase_dn0(F, P, l);
        GRID_BAR();
        }
        EMU_STOP(l, 3);
#pragma unroll
        for (int rep_ = 0; rep_ < REP_DN1; ++rep_) {
        { SchedDft S{F.G, F.bid, 1, (!last && !chain_dedicated(F.G)) ? 1 : 0, (const char*)wsp<bf16_t>(P, WS_DFTL), (const char*)wsp<bf16_t>(P, WS_DFTC), (const char*)wsp<bf16_t>(P, WS_ZTL), (const char*)wsp<bf16_t>(P, WS_ZTC)};
          EpiDft E{wsp<float>(P, WS_SLAB), wsp<bf16_t>(P, WS_MIX)};
          g8::gemm_phase<EpiDft, SchedDft, false>(F.lds, 2 * SEQ, 2 * SEQ, S, E); }
        phase_dn1(F, P);
        GRID_BAR();
        }
        EMU_STOP(l, 4);
#pragma unroll
        for (int rep_ = 0; rep_ < REP_CHAIN; ++rep_) {
        phase_dn2(F, P);
        unsigned* chc = wsp<unsigned>(P, WS_CTL) + CW_CHC + 64 * l;
        if (chain_dedicated(F.G) && F.bid < NCHB) {
            WAIT_VM(0);
            __syncthreads();
            if (F.tid == 0) { __builtin_amdgcn_fence(__ATOMIC_RELEASE, "agent"); WAIT_VM(0); (void)xb_add(chc, 1u); }
        }
        if (chain_dedicated(F.G) && F.bid < NCHB && !last) {
            __syncthreads();
            { SchedDft S{NCHB, F.bid, 0, 1, (const char*)wsp<bf16_t>(P, WS_DFTL), (const char*)wsp<bf16_t>(P, WS_DFTC), (const char*)wsp<bf16_t>(P, WS_ZTL), (const char*)wsp<bf16_t>(P, WS_ZTC)};
              EpiDft E{wsp<float>(P, WS_SLAB), wsp<bf16_t>(P, WS_MIX)};
              g8::gemm_phase<EpiDft, SchedDft, false>(F.lds, 2 * SEQ, 2 * SEQ, S, E); }
            phase_attn<1>(F, P, l, false, true, NCHB, F.bid);
        }
        phase_attn<0>(F, P, l);
        if (chain_dedicated(F.G) && F.bid >= NCHB) {
            const int nb_na = F.G - NCHB, units = NB * GROWS + (last ? 0 : NB * (CTX / 64)), extra = units % nb_na, idx = F.bid - NCHB;
            if (idx >= extra) { phase_ftreduce(F, P, l, idx - extra, nb_na - extra, true, false);
                { unsigned sp = 0u; while (xb_ld(chc) < (unsigned)NCHB) { __builtin_amdgcn_s_sleep(2); if (++sp > (1u << 22)) break; } }
                __builtin_amdgcn_fence(__ATOMIC_ACQUIRE, "agent");
                phase_dn3(F, P, l, idx - extra, nb_na - extra); }
        }
        GRID_BAR();
        }
        EMU_STOP(l, 5);
#pragma unroll
        for (int rep_ = 0; rep_ < REP_ATT; ++rep_) {
        if (!chain_dedicated(F.G)) phase_dn3(F, P, l, F.bid, F.G);
        phase_attn<1>(F, P, l, true, !chain_dedicated(F.G), F.G, F.bid);
        if (!chain_dedicated(F.G)) phase_ftreduce(F, P, l, F.bid, F.G, true, false);
        GRID_BAR();
        }
        EMU_STOP(l, 7);
        { SchedOut S{F.G, F.bid, last, (const char*)wsp<bf16_t>(P, WS_MIX), (const char*)(wsp<bf16_t>(P, WS_WOUT) + (size_t)l * D * D)};
          EpiOut E{wsp<bf16_t>(P, WS_DMIX), wsp<float>(P, WS_MODL) + (size_t)l * NB * 6 * D + 2 * D, wsp<float>(P, WS_MODC) + (size_t)l * 6 * D + 2 * D};
          g8::gemm_phase<EpiOut, SchedOut, false>(F.lds, D, D, S, E); }
        GRID_BAR();
        EMU_STOP(l, 8);
#pragma unroll
        for (int rep_ = 0; rep_ < REP_N2; ++rep_) {
        phase_norm2(F, P, l);
        GRID_BAR();
        }
        EMU_STOP(l, 9);
#pragma unroll
        for (int rep_ = 0; rep_ < REP_TOPK; ++rep_) {
        phase_topk(F, P, l);
        GRID_BAR();
        }
        EMU_STOP(l, 10);
        const int epan = (last ? EROWS_LAT_PAD : EROWS_PAD) / 256;
#pragma unroll
        for (int rep_ = 0; rep_ < REP_GU; ++rep_) {
        { SchedGU S{F.G, F.bid, epan, (const char*)wsp<bf16_t>(P, WS_H), (const char*)(wsp<bf16_t>(P, WS_WGU) + (size_t)l * NEXP * 2 * DEXP * D), wsp<int>(P, WS_RIDX)};
          EpiGU E{wsp<bf16_t>(P, WS_HID)};
          g8::gemm_phase<EpiGU, SchedGU, true>(F.lds, D, D, S, E); }
        GRID_BAR();
        }
        EMU_STOP(l, 11);
#pragma unroll
        for (int rep_ = 0; rep_ < REP_DOWN; ++rep_) {
        { SchedDown S{F.G, F.bid, epan, (const char*)wsp<bf16_t>(P, WS_HID), (const char*)(wsp<bf16_t>(P, WS_WD) + (size_t)l * NEXP * D * DEXP)};
          EpiDown E{wsp<bf16_t>(P, WS_Y), wsp<float>(P, WS_GATEV)};
          g8::gemm_phase<EpiDown, SchedDown, false>(F.lds, DEXP, DEXP, S, E); }
        GRID_BAR();
        }
        EMU_STOP(l, 12);
    }
    phase_norm1(F, P, DEPTH);
}

extern "C" void kernel_launch(void* const* d_in, const int* in_sizes, int n_in, void* d_out, int out_size, void* d_ws, size_t ws_size, hipStream_t stream) {
    static int grid = 0;
    if (grid == 0) {
        if (n_in != 23 || ws_size < WS_END) { fprintf(stderr, "kernel_launch: expected 23 inputs and >= %zu bytes of workspace (got %d, %zu)\n", (size_t)WS_END, n_in, ws_size); grid = -1; return; }
#ifdef EMU
        const char* g = getenv("EMU_GRID"); grid = g ? atoi(g) : 3;
#else
        int dev = 0, cus = 0;
        if (hipGetDevice(&dev) != hipSuccess || hipDeviceGetAttribute(&cus, hipDeviceAttributeMultiprocessorCount, dev) != hipSuccess) { grid = -1; return; }
        if (hipFuncSetAttribute((const void*)fwd_kernel, hipFuncAttributeMaxDynamicSharedMemorySize, LDS_BYTES) != hipSuccess) { fprintf(stderr, "kernel_launch: hipFuncSetAttribute failed\n"); grid = -1; return; }
        int per_cu = 0;
        if (hipOccupancyMaxActiveBlocksPerMultiprocessor(&per_cu, (const void*)fwd_kernel, 512, LDS_BYTES) != hipSuccess || per_cu < 1) fprintf(stderr, "kernel_launch: occupancy query says %d\n", per_cu);
        (void)hipGetLastError();
        grid = cus;
#endif
    }
    if (grid < 0) return;
    (void)in_sizes; (void)out_size;
    hipMemsetAsync((char*)d_ws + WS_CTL, 0, CTL_BYTES, stream);
    Params p{};
    for (int i = 0; i < 23; ++i) p.in[i] = (const float*)d_in[i];
    p.out = (float*)d_out; p.ws = (unsigned char*)d_ws;
#ifdef EMU
    emu::launch([=]() { fwd_kernel(p); }, grid, 512, LDS_BYTES);
#else
    hipLaunchKernelGGL(fwd_kernel, dim3(grid), dim3(512), LDS_BYTES, stream, p);
#endif
}
```

```cpp
#ifdef EMU
#include "emu.h"
#define LAS
#define WAIT_VM(n)
#define WAIT_LGKM(n) emu::rendezvous(nullptr, 0, [](emu::Wave*, int) {})
#define CFENCE()
#define LAUNDER_V(x)
#define LAUNDER_S(x)
#else
#include <hip/hip_runtime.h>
#include <cstdio>
#define LAS __attribute__((address_space(3)))
#define WAIT_VM(n) asm volatile("s_waitcnt vmcnt(" #n ")" ::: "memory")
#define WAIT_LGKM(n) asm volatile("s_waitcnt lgkmcnt(" #n ")" ::: "memory")
#define CFENCE() asm volatile("" ::: "memory")
#define LAUNDER_V(x) asm volatile("" : "+v"(x))
#define LAUNDER_S(x) asm volatile("" : "+s"(x))
#endif
#define DI __device__ __forceinline__

#ifndef CFG_BATCH
#define CFG_BATCH 4
#define CFG_SEQ 4096
#define CFG_CTX 256
#define CFG_DEPTH 4
#define CFG_NEXP 16
#define CFG_DEXP 2048
#define CFG_KS 4
#endif
constexpr int NB = CFG_BATCH, SEQ = CFG_SEQ, CTX = CFG_CTX, DEPTH = CFG_DEPTH, NEXP = CFG_NEXP, DEXP = CFG_DEXP, KSPLIT = CFG_KS;
constexpr int D = 1024, GW = 256, NH = 4, HD = 64, GRIDW = 64, GROWS = SEQ / GRIDW;
constexpr int IN_W = 11 * GW + 4 * NH;
constexpr int R_LAT = NB * SEQ, R_CTX = NB * CTX, RT = R_LAT + R_CTX;
constexpr int NTILE = 13, NPROJ = NTILE * 256;
constexpr int PLD = 12 * 256;
constexpr int CAP_LAT = 2 * SEQ / NEXP, CAP_CTX = 2 * CTX / NEXP;
constexpr int EROWS = NB * (CAP_LAT + CAP_CTX), EROWS_PAD = (EROWS + 255) / 256 * 256, EROWS_LAT_PAD = (NB * CAP_LAT + 255) / 256 * 256;
constexpr int NCC = CTX / 64, NCL = SEQ / 64, NCH = NCC + NCL, NUNIT = NB * NH * 2 * NCH;
constexpr int WH = GROWS < 8 ? GROWS : 8;
constexpr float RMS_EPS = 1e-6f;
constexpr float LOG2E = 1.4426950408889634f;
static_assert(R_LAT % 256 == 0 && R_CTX % 256 == 0 && SEQ % 256 == 0 && CTX % 256 == 0, "row panels");
constexpr int KCH = SEQ / KSPLIT;
constexpr int HSEQ = SEQ / 2;
static_assert(KCH % 128 == 0 && KCH >= 256 && HSEQ % 256 == 0 && DEXP % 128 == 0 && DEXP >= 256, "gemm K");

constexpr size_t al256(size_t x) { return (x + 255) / 256 * 256; }
constexpr size_t WS_CTL = 0, CTL_BYTES = 1u << 20;
constexpr size_t WS_MODL = WS_CTL + CTL_BYTES;
constexpr size_t WS_MODC = WS_MODL + al256((size_t)DEPTH * NB * 6 * D * 4);
constexpr size_t WS_ROPE = WS_MODC + al256((size_t)DEPTH * 6 * D * 4);
constexpr size_t WS_DFTL = WS_ROPE + al256((size_t)SEQ * 32 * 4);
constexpr size_t WS_DFTC = WS_DFTL + al256((size_t)SEQ * 2 * SEQ * 2);
constexpr size_t WS_WIN = WS_DFTC + al256((size_t)CTX * 2 * SEQ * 2);
constexpr size_t WS_WOUT = WS_WIN + al256((size_t)DEPTH * NPROJ * D * 2);
constexpr size_t WS_WGU = WS_WOUT + al256((size_t)DEPTH * D * D * 2);
constexpr size_t WS_WD = WS_WGU + al256((size_t)DEPTH * NEXP * 2 * DEXP * D * 2);
constexpr size_t WS_MZT = WS_WD + al256((size_t)DEPTH * NEXP * D * DEXP * 2);
constexpr size_t WS_WFT = WS_MZT + al256((size_t)DEPTH * 512 * 256 * 2);
constexpr size_t WS_XRES = WS_WFT + al256((size_t)DEPTH * D * 256 * 2);
constexpr size_t WS_H = WS_XRES + al256((size_t)RT * D * 4);
constexpr size_t WS_PROJ = WS_H + al256((size_t)RT * D * 2);
constexpr size_t WS_AB = WS_PROJ + al256((size_t)RT * PLD * 2);
constexpr size_t WS_DNP = WS_AB + al256((size_t)RT * 16 * 4);
constexpr size_t WS_GB = WS_DNP + al256((size_t)RT * 768 * 2);
constexpr size_t WS_AN = WS_GB + al256((size_t)RT * 16 * 4);
constexpr size_t WS_QE = WS_AN + al256((size_t)NUNIT * 8192);
constexpr size_t WS_SN = WS_QE + al256((size_t)NUNIT * 8192);
constexpr size_t WS_BN = WS_SN + al256((size_t)NUNIT * 8192);
constexpr size_t WS_OI = WS_BN + al256((size_t)NUNIT * 16384);
constexpr size_t WS_ZTL = WS_OI + al256((size_t)NUNIT * 16384);
constexpr size_t WS_ZTC = WS_ZTL + al256((size_t)NB * 256 * 2 * SEQ * 2);
constexpr size_t WS_SLAB = WS_ZTC + al256((size_t)NB * 256 * 2 * SEQ * 2);
constexpr size_t WS_SLABC = WS_SLAB + al256((size_t)KSPLIT * R_LAT * 256 * 4);
constexpr size_t WS_MIX = WS_SLABC + al256((size_t)R_CTX * 256 * 4);
constexpr size_t WS_AFF = WS_MIX + al256((size_t)RT * D * 2);
constexpr size_t WS_RIDX = WS_AFF + al256((size_t)RT * NEXP * 4);
constexpr size_t WS_GATEV = WS_RIDX + al256((size_t)NEXP * EROWS_PAD * 4);
constexpr size_t WS_INV = WS_GATEV + al256((size_t)NEXP * EROWS_PAD * 4);
constexpr size_t WS_DMIX = WS_PROJ;
constexpr size_t WS_HID = WS_INV + al256((size_t)RT * NEXP * 4);
constexpr size_t WS_Y = WS_HID + al256((size_t)NEXP * EROWS_PAD * DEXP * 2);
constexpr size_t WS_END = WS_Y + al256((size_t)NEXP * EROWS_PAD * D * 2);
constexpr int CW_CHC = 2048;
constexpr int CW_BAR = 4096;

constexpr int LDS_WORK = 131072;
constexpr int LDS_MISC = LDS_WORK;
constexpr int LDS_BYTES = 147456;

typedef unsigned short bf16_t;
typedef short bf16x8 __attribute__((ext_vector_type(8)));
typedef short s16x4 __attribute__((ext_vector_type(4)));
typedef float f32x2 __attribute__((ext_vector_type(2)));
typedef float f32x4 __attribute__((ext_vector_type(4)));
typedef float f32x16 __attribute__((ext_vector_type(16)));
typedef unsigned u32x2 __attribute__((ext_vector_type(2)));
typedef unsigned u32x4 __attribute__((ext_vector_type(4)));
typedef int i32x4 __attribute__((ext_vector_type(4)));

DI float bf2f(bf16_t b) { return __builtin_bit_cast(float, ((unsigned)b) << 16); }
DI float bflo(unsigned w) { return __builtin_bit_cast(float, w << 16); }
DI float bfhi(unsigned w) { return __builtin_bit_cast(float, w & 0xffff0000u); }
#ifdef EMU
DI unsigned pk2(float lo, float hi) { return (unsigned)emu::f2bf(lo) | ((unsigned)emu::f2bf(hi) << 16); }
#else
typedef __bf16 bf16x2v __attribute__((ext_vector_type(2)));
DI unsigned pk2(float lo, float hi) { f32x2 v = {lo, hi}; return __builtin_bit_cast(unsigned, __builtin_convertvector(v, bf16x2v)); }
#endif
DI bf16_t f2bf(float f) { return (bf16_t)(pk2(f, 0.f) & 0xffffu); }
DI float siluf(float x) { return x * __builtin_amdgcn_rcpf(1.0f + __expf(-x)); }
DI float wave_sum(float v) {
#pragma unroll
    for (int o = 1; o < 64; o <<= 1) v += __shfl_xor(v, o);
    return v;
}
DI int crow(int reg, int hh) { return (reg & 3) + 8 * (reg >> 2) + 4 * hh; }
DI f32x16 zero16() { f32x16 z; for (int i = 0; i < 16; ++i) z[i] = 0.f; return z; }
DI bf16x8 pack8(const f32x16& x, int s) {
    u32x4 p; p.x = pk2(x[8 * s], x[8 * s + 1]); p.y = pk2(x[8 * s + 2], x[8 * s + 3]); p.z = pk2(x[8 * s + 4], x[8 * s + 5]); p.w = pk2(x[8 * s + 6], x[8 * s + 7]);
    return __builtin_bit_cast(bf16x8, p);
}
DI bf16x8 cat44(u32x2 lo, u32x2 hi) { u32x4 p; p.x = lo.x; p.y = lo.y; p.z = hi.x; p.w = hi.y; return __builtin_bit_cast(bf16x8, p); }
#define MFMA32(a, b, c) __builtin_amdgcn_mfma_f32_32x32x16_bf16((a), (b), (c), 0, 0, 0)
#define MFMA16(a, b, c) __builtin_amdgcn_mfma_f32_16x16x32_bf16((a), (b), (c), 0, 0, 0)

#define XB_TMO      128
#define XB_XCNT(j)  (256  + 64 * (j))
#define XB_XSUB(j)  (1280 + 64 * (j))
#define XB_XGEN(j)  (2304 + 64 * (j))
#define XB_TOP      3328
#define XB_TOPGEN   3392
#define XCD_BAR_WORDS 3456
#define XB_SPIN_CAP (1u << 18)
DI unsigned xb_ld(unsigned* p)              { return __hip_atomic_load(p, __ATOMIC_RELAXED, __HIP_MEMORY_SCOPE_AGENT); }
DI unsigned xb_add(unsigned* p, unsigned v) { return __hip_atomic_fetch_add(p, v, __ATOMIC_RELAXED, __HIP_MEMORY_SCOPE_AGENT); }
DI unsigned xb_xcc_id() { return (unsigned)__builtin_amdgcn_s_getreg((3 << 11) | 20) & 0xFu; }
#define XB_SPIN(cond, bar) do { unsigned _sp = 0; while (cond) { __builtin_amdgcn_s_sleep(1); \
    if ((++_sp & 255u) == 0u) { if (xb_ld(&(bar)[XB_TMO])) break; if (_sp > XB_SPIN_CAP) { atomicAdd(&(bar)[XB_TMO], 1u); break; } } } } while (0)
struct XcdBarrier { unsigned* bar; unsigned x; volatile LAS unsigned* st; };
DI XcdBarrier xcd_barrier_post(unsigned* bar, volatile LAS unsigned* st) {
    XcdBarrier b; b.bar = bar; b.x = (unsigned)__builtin_amdgcn_readfirstlane((int)xb_xcc_id()); b.st = st;
    if (threadIdx.x == 0) (void)xb_add(&bar[XB_XCNT(b.x)], 1u);
    return b;
}
DI void xcd_barrier_complete(unsigned* bar, unsigned x, unsigned& nloc, unsigned& nx) {
    const unsigned G = gridDim.x * gridDim.y * gridDim.z;
    unsigned sum, cnt, mine, sp = 0u;
    for (;;) {
        sum = 0u; cnt = 0u; mine = 0u;
#pragma unroll
        for (unsigned j = 0; j < 16; ++j) { const unsigned c = xb_ld(&bar[XB_XCNT(j)]); sum += c; cnt += (c > 0u) ? 1u : 0u; mine = (j == x) ? c : mine; }
        if (sum == G) break;
        __builtin_amdgcn_s_sleep(1);
        if ((++sp & 255u) == 0u) { if (xb_ld(&bar[XB_TMO])) break; if (sp > XB_SPIN_CAP) { atomicAdd(&bar[XB_TMO], 1u); break; } }
    }
    nloc = mine > 0u ? mine : 1u; nx = cnt > 0u ? cnt : 1u;
}
DI void xcd_barrier(const XcdBarrier& b) {
    WAIT_VM(0);
    __syncthreads();
    unsigned* bar = b.bar; unsigned bx = b.x; LAUNDER_S(bar); LAUNDER_S(bx);
    if (threadIdx.x == 0) {
        __builtin_amdgcn_s_waitcnt(0);
        unsigned nloc = b.st[0], nx = b.st[1];
        if (nloc == 0u) { xcd_barrier_complete(bar, bx, nloc, nx); b.st[0] = nloc; b.st[1] = nx; }
        const unsigned old = xb_add(&bar[XB_XSUB(bx)], 1u);
        const unsigned gen = old / nloc;
        if (old + 1u == (gen + 1u) * nloc) {
            __builtin_amdgcn_fence(__ATOMIC_RELEASE, "agent");
            WAIT_VM(0);
            const unsigned og = xb_add(&bar[XB_TOP], 1u);
            const unsigned tg = og / nx;
            if (og + 1u == (tg + 1u) * nx) xb_add(&bar[XB_TOPGEN], 1u);
            else XB_SPIN(xb_ld(&bar[XB_TOPGEN]) == tg, bar);
            __builtin_amdgcn_fence(__ATOMIC_ACQUIRE, "agent");
            xb_add(&bar[XB_XGEN(bx)], 1u);
            WAIT_VM(0);
        } else {
            XB_SPIN(xb_ld(&bar[XB_XGEN(bx)]) == gen, bar);
            __builtin_amdgcn_fence(__ATOMIC_ACQUIRE, "agent");
            WAIT_VM(0);
        }
    }
    __syncthreads();
}

#ifndef G8_SP2
#define G8_SP2 true
#endif
#ifndef G8_ALIGN_W
#define G8_ALIGN_W false
#endif
#ifndef G8_ALIGN_PROJ
#define G8_ALIGN_PROJ true
#endif
#ifndef G8_ALIGN_OUT
#define G8_ALIGN_OUT true
#endif
#ifndef G8_ALIGN_DFT
#define G8_ALIGN_DFT true
#endif
#ifndef G8_ALIGN_GU
#define G8_ALIGN_GU true
#endif
#ifndef G8_ALIGN_DOWN
#define G8_ALIGN_DOWN true
#endif
namespace g8 {
constexpr int BM = 256, BK = 64, HALF = 128, HTB = HALF * BK * 2, STAGE_BYTES = 8 * HTB;
DI int lds_byte(int r, int c) { const int st = (r >> 4) * 2 + (c >> 5), rr = r & 15, cc = c & 31, ob = rr * 64 + cc * 2; return st * 1024 + (ob ^ (((ob >> 9) & 1) << 5)); }
DI void stage_rc(int b, int& R, int& C) { const int st = b / 1024, sb = b % 1024, swz = sb ^ (((sb >> 9) & 1) << 5); R = (st >> 1) * 16 + swz / 64; C = (st & 1) * 32 + (swz % 64) / 2; }
DI int perm32(int rho) { const int n = rho >> 4, i = rho & 15; return 8 * (i >> 2) + 4 * n + (i & 3); }
struct Unit { const char* A; const char* B; const int* gidx; int pm, pn, aux, nt, half; };

template <class Epi, class Sched, bool GATHER>
DI void gemm_phase(LAS unsigned char* lds, const int lda, const int ldb, const Sched& S, const Epi& E) {
    int tid = threadIdx.x; LAUNDER_V(tid);
    const int wid = __builtin_amdgcn_readfirstlane(tid >> 6), lane = tid & 63, wr = wid >> 2, wc = wid & 3, fr = lane & 15, fq = lane >> 4;
    int Rr[2], Cc[2]; unsigned voffB[2];
#pragma unroll
    for (int i = 0; i < 2; ++i) { stage_rc(tid * 16 + i * 8192, Rr[i], Cc[i]); const int Rb = Epi::PERM ? ((Rr[i] & ~31) + perm32(Rr[i] & 31)) : Rr[i]; voffB[i] = (unsigned)(Rb * ldb + Cc[i]) * 2u; }
    const size_t kstep = (size_t)(BK * 2);
    const size_t hstepB = (size_t)HALF * ldb * 2;
    const unsigned ldsw = (unsigned)wid * 1024u;
    const int aoff = lds_byte(wr * 64 + fr, fq * 8), boff = lds_byte(wc * 32 + fr, fq * 8);
#define G8_SA(b, h) (((b) * 2 + (h)) * HTB)
#define G8_SB(b, h) ((4 + (b) * 2 + (h)) * HTB)
#define G8_STAGE(bufoff, gbase, v0, v1) do { \
        __builtin_amdgcn_global_load_lds((const unsigned*)((const char*)(gbase) + (v0)), (LAS unsigned*)(lds + (bufoff) + ldsw), 16, 0, 0); \
        __builtin_amdgcn_global_load_lds((const unsigned*)((const char*)(gbase) + (v1)), (LAS unsigned*)(lds + (bufoff) + ldsw + 8192), 16, 0, 0); } while (0)
#define G8_STAGE_B(bufoff, gbase) G8_STAGE(bufoff, gbase, voffB[0], voffB[1])
#define G8_LDA(dst, b, h) do { _Pragma("unroll") for (int m = 0; m < 4; ++m) _Pragma("unroll") for (int k = 0; k < 2; ++k) dst[m][k] = *(const LAS bf16x8*)(lds + G8_SA(b, h) + aoff + m * 2048 + k * 1024); } while (0)
#define G8_LDB(dst, b, h) do { _Pragma("unroll") for (int n = 0; n < 2; ++n) _Pragma("unroll") for (int k = 0; k < 2; ++k) dst[n][k] = *(const LAS bf16x8*)(lds + G8_SB(b, h) + boff + n * 2048 + k * 1024); } while (0)
#define G8_MMA(ai, bj, At, Bt) do { __builtin_amdgcn_s_setprio(1); _Pragma("unroll") for (int m = 0; m < 4; ++m) _Pragma("unroll") for (int n = 0; n < 2; ++n) _Pragma("unroll") for (int k = 0; k < 2; ++k) \
        acc[ai][bj][m][n] = MFMA16(Bt[n][k], At[m][k], acc[ai][bj][m][n]); __builtin_amdgcn_s_setprio(0); } while (0)
#define G8_BAR __builtin_amdgcn_s_barrier()
#define G8_SCHED __builtin_amdgcn_sched_barrier(0)
#define G8_VA(u, V) do { _Pragma("unroll") for (int h = 0; h < 2; ++h) _Pragma("unroll") for (int i = 0; i < 2; ++i) { \
        const int rr = GATHER ? (u).gidx[h * HALF + Rr[i]] : (h * HALF + Rr[i]); V[h][i] = (unsigned)(rr * lda + Cc[i]) * 2u; } } while (0)
    Unit cur, nxt; int ui = 0;
    if (!S.next(0, cur)) return;
    f32x4 acc[2][2][4][2];
#pragma unroll
    for (int a = 0; a < 2; ++a)
#pragma unroll
        for (int b = 0; b < 2; ++b)
#pragma unroll
            for (int m = 0; m < 4; ++m)
#pragma unroll
                for (int n = 0; n < 2; ++n) acc[a][b][m][n] = (f32x4){0.f, 0.f, 0.f, 0.f};
    bf16x8 At[4][2], B0[2][2], B1[2][2];
    unsigned vaC[2][2], vaN[2][2];
    G8_VA(cur, vaC);
    const char* cA = cur.A; const char* cB = cur.B;
    if constexpr (G8_SP2) {
        G8_STAGE_B(G8_SB(0, 0), cB); G8_STAGE_B(G8_SB(0, 1), cB + hstepB); G8_STAGE(G8_SA(0, 0), cA, vaC[0][0], vaC[0][1]); G8_STAGE(G8_SA(0, 1), cA, vaC[1][0], vaC[1][1]);
        if (wr == 1) G8_BAR;
        WAIT_VM(2); G8_BAR;
    } else {
        G8_STAGE_B(G8_SB(0, 0), cB); G8_STAGE(G8_SA(0, 0), cA, vaC[0][0], vaC[0][1]); G8_STAGE_B(G8_SB(0, 1), cB + hstepB); G8_STAGE(G8_SA(0, 1), cA, vaC[1][0], vaC[1][1]);
        if (wr == 1) G8_BAR;
        WAIT_VM(4); G8_BAR;
    }
    G8_STAGE_B(G8_SB(1, 0), cB + kstep); G8_STAGE(G8_SA(1, 0), cA + kstep, vaC[0][0], vaC[0][1]); G8_STAGE_B(G8_SB(1, 1), cB + hstepB + kstep);
    WAIT_VM(6); G8_BAR;
    for (;;) {
        const bool has_next = S.next(ui + 1, nxt);
        const int nt = cur.nt; const bool hf = cur.half != 0;
        const char* nA = has_next ? nxt.A : cA; const char* nB = has_next ? nxt.B : cB;
        if (GATHER) { if (has_next) { G8_VA(nxt, vaN); } else {
#pragma unroll
            for (int h = 0; h < 2; ++h)
#pragma unroll
                for (int i = 0; i < 2; ++i) vaN[h][i] = vaC[h][i]; } }
        for (int t = 0; t < nt; t += 2) {
            const bool last = (t == nt - 2);
            const char* a1 = cA + (size_t)(t + 1) * kstep;
            const char* a2 = last ? nA : cA + (size_t)(t + 2) * kstep; const char* b2 = last ? nB : cB + (size_t)(t + 2) * kstep;
            const char* a3 = a2 + kstep; const char* b3 = b2 + kstep;
            unsigned x00, x01, x10, x11;
            if (GATHER) { x00 = last ? vaN[0][0] : vaC[0][0]; x01 = last ? vaN[0][1] : vaC[0][1]; x10 = last ? vaN[1][0] : vaC[1][0]; x11 = last ? vaN[1][1] : vaC[1][1]; }
            else { x00 = vaC[0][0]; x01 = vaC[0][1]; x10 = vaC[1][0]; x11 = vaC[1][1]; }
            if constexpr (G8_SP2) {
            G8_LDB(B0, 0, 0); G8_LDB(B1, 0, 1); G8_SCHED; G8_LDA(At, 0, 0); G8_STAGE(G8_SA(1, 1), a1, vaC[1][0], vaC[1][1]);
            WAIT_VM(8); WAIT_LGKM(0); G8_BAR; G8_MMA(0, 0, At, B0); G8_MMA(0, 1, At, B1); G8_BAR; G8_SCHED;
            G8_LDA(At, 0, 1); G8_STAGE_B(G8_SB(0, 0), b2); G8_STAGE_B(G8_SB(0, 1), b2 + hstepB); G8_STAGE(G8_SA(0, 0), a2, x00, x01);
            WAIT_VM(8); WAIT_LGKM(0); G8_BAR; if (!hf) { G8_MMA(1, 0, At, B0); G8_MMA(1, 1, At, B1); } G8_BAR; G8_SCHED;
            G8_LDB(B0, 1, 0); G8_LDB(B1, 1, 1); G8_SCHED; G8_LDA(At, 1, 0); G8_STAGE(G8_SA(0, 1), a2, x10, x11);
            WAIT_VM(8); WAIT_LGKM(0); G8_BAR; G8_MMA(0, 0, At, B0); G8_MMA(0, 1, At, B1); G8_BAR; G8_SCHED;
            G8_LDA(At, 1, 1); G8_STAGE_B(G8_SB(1, 0), b3); G8_STAGE_B(G8_SB(1, 1), b3 + hstepB); G8_STAGE(G8_SA(1, 0), a3, x00, x01);
            WAIT_VM(8); WAIT_LGKM(0); G8_BAR; if (!hf) { G8_MMA(1, 0, At, B0); G8_MMA(1, 1, At, B1); } G8_BAR; G8_SCHED;
            } else {
            G8_LDB(B0, 0, 0); G8_SCHED; G8_LDA(At, 0, 0); G8_STAGE(G8_SA(1, 1), a1, vaC[1][0], vaC[1][1]);
            WAIT_LGKM(8); G8_BAR; WAIT_LGKM(0); G8_MMA(0, 0, At, B0); G8_BAR; G8_SCHED;
            G8_LDB(B1, 0, 1); G8_STAGE_B(G8_SB(0, 0), b2);
            G8_BAR; WAIT_LGKM(0); G8_MMA(0, 1, At, B1); G8_BAR;
            G8_LDA(At, 0, 1); G8_STAGE(G8_SA(0, 0), a2, x00, x01);
            G8_BAR; WAIT_LGKM(0); if (!hf) G8_MMA(1, 0, At, B0); G8_BAR; G8_SCHED;
            G8_STAGE_B(G8_SB(0, 1), b2 + hstepB);
            WAIT_VM(6); G8_BAR; if (!hf) G8_MMA(1, 1, At, B1); G8_BAR;
            G8_LDB(B0, 1, 0); G8_SCHED; G8_LDA(At, 1, 0); G8_STAGE(G8_SA(0, 1), a2, x10, x11);
            WAIT_LGKM(8); G8_BAR; WAIT_LGKM(0); G8_MMA(0, 0, At, B0); G8_BAR; G8_SCHED;
            G8_LDB(B1, 1, 1); G8_STAGE_B(G8_SB(1, 0), b3);
            G8_BAR; WAIT_LGKM(0); G8_MMA(0, 1, At, B1); G8_BAR;
            G8_LDA(At, 1, 1); G8_STAGE(G8_SA(1, 0), a3, x00, x01);
            G8_BAR; WAIT_LGKM(0); if (!hf) G8_MMA(1, 0, At, B0); G8_BAR; G8_SCHED;
            G8_STAGE_B(G8_SB(1, 1), b3 + hstepB);
            WAIT_VM(6); G8_BAR; if (!hf) G8_MMA(1, 1, At, B1); G8_BAR;
            }
        }
        if constexpr (Epi::ALIGN) { if (wr == 0) G8_BAR; }
        E(acc, cur, wr, wc, fr, fq);
        if (!has_next) break;
#pragma unroll
        for (int a = 0; a < 2; ++a)
#pragma unroll
            for (int b = 0; b < 2; ++b)
#pragma unroll
                for (int m = 0; m < 4; ++m)
#pragma unroll
                    for (int n = 0; n < 2; ++n) acc[a][b][m][n] = (f32x4){0.f, 0.f, 0.f, 0.f};
        cur = nxt; cA = nA; cB = nB; ++ui;
        if (GATHER) {
#pragma unroll
            for (int h = 0; h < 2; ++h)
#pragma unroll
                for (int i = 0; i < 2; ++i) vaC[h][i] = vaN[h][i]; }
        if constexpr (Epi::ALIGN) { if (wr == 1) G8_BAR; }
    }
    WAIT_VM(0);
    if constexpr (!Epi::ALIGN) { if (wr == 0) G8_BAR; }
    G8_BAR;
#undef G8_SA
#undef G8_SB
#undef G8_STAGE
#undef G8_STAGE_B
#undef G8_LDA
#undef G8_LDB
#undef G8_MMA
#undef G8_BAR
#undef G8_SCHED
#undef G8_VA
}
}

struct Params { const float* in[23]; float* out; unsigned char* ws; };
enum { I_X = 0, I_C, I_CTX, I_CCTX, I_WMOD, I_BMOD, I_N1G, I_WIN, I_RPB, I_CONVW, I_ALOG, I_DTB, I_DNG, I_DFLAM, I_DFG, I_FTW, I_WOUT, I_N2G, I_WR, I_WG, I_WU, I_WDN, I_FNG };
struct Frame { LAS unsigned char* lds; int tid, lane, wave, G, bid, gw, ngw; };
template <class T> DI T* wsp(const Params& P, size_t off) { return (T*)(P.ws + off); }
DI Frame relaunder(const Frame& F0) { Frame F = F0; LAUNDER_V(F.tid); F.lane = F.tid & 63; F.wave = __builtin_amdgcn_readfirstlane(F.tid >> 6); LAUNDER_S(F.bid); F.gw = F.wave * F.G + F.bid; return F; }
DI float cospi_(float x) { return cosf(3.14159265358979323846f * x); }
DI float sinpi_(float x) { return sinf(3.14159265358979323846f * x); }

struct TItem { const float* src; bf16_t* dst; int ldw, ldt; };
DI TItem p0_decode(const Params& P, int it) {
    constexpr int I_WINc = 10 * 16 * 8, I_ABc = 16, I_WOUTc = 16 * 32, I_Gc = NEXP * 16 * (DEXP / 32), I_Dc = NEXP * (DEXP / 64) * 32;
    constexpr int I_LAYER = I_WINc + I_ABc + I_WOUTc + 2 * I_Gc + I_Dc;
    bf16_t* WinT = wsp<bf16_t>(P, WS_WIN); bf16_t* WoutT = wsp<bf16_t>(P, WS_WOUT); bf16_t* WguT = wsp<bf16_t>(P, WS_WGU); bf16_t* WdT = wsp<bf16_t>(P, WS_WD);
    const int l = it / I_LAYER; int r = it % I_LAYER; TItem t;
    const float* w_in = P.in[I_WIN] + (size_t)l * D * IN_W;
    if (r < I_WINc) { const int g = r / 128, rr = r % 128, kb = ((rr >> 2) / 8) * 4 + (rr & 3), nb = (rr >> 2) % 8; const int so = 256 * g + (g >= 6 ? 16 : 0);
        t.src = w_in + so + nb * 32 + (size_t)64 * kb * IN_W; t.ldw = IN_W; t.dst = WinT + ((size_t)l * NPROJ + g * 256 + nb * 32) * D + 64 * kb; t.ldt = D; return t; }
    r -= I_WINc;
    if (r < I_ABc) { t.src = w_in + 1536 + (size_t)64 * r * IN_W; t.ldw = IN_W; t.dst = WinT + ((size_t)l * NPROJ + 12 * 256) * D + 64 * r; t.ldt = D; return t; }
    r -= I_ABc;
    if (r < I_WOUTc) { const int kb = ((r >> 2) / 32) * 4 + (r & 3), nb = (r >> 2) % 32; t.src = P.in[I_WOUT] + (size_t)l * D * D + nb * 32 + (size_t)64 * kb * D; t.ldw = D; t.dst = WoutT + ((size_t)l * D + nb * 32) * D + 64 * kb; t.ldt = D; return t; }
    r -= I_WOUTc;
    if (r < 2 * I_Gc) { const int up = r >= I_Gc; if (up) r -= I_Gc; const int e = r / (16 * (DEXP / 32)), rr = r % (16 * (DEXP / 32)), kb = ((rr >> 2) / (DEXP / 32)) * 4 + (rr & 3), nb = (rr >> 2) % (DEXP / 32), f0 = 32 * nb;
        t.src = P.in[up ? I_WU : I_WG] + ((size_t)l * NEXP + e) * D * DEXP + f0 + (size_t)64 * kb * DEXP; t.ldw = DEXP;
        t.dst = WguT + (((size_t)l * NEXP + e) * 2 * DEXP + (f0 / 128) * 256 + up * 128 + (f0 % 128)) * D + 64 * kb; t.ldt = D; return t; }
    r -= 2 * I_Gc;
    { const int e = r / ((DEXP / 64) * 32), rr = r % ((DEXP / 64) * 32), kb = ((rr >> 2) / 32) * 4 + (rr & 3), nb = (rr >> 2) % 32;
        t.src = P.in[I_WDN] + ((size_t)l * NEXP + e) * DEXP * D + nb * 32 + (size_t)64 * kb * D; t.ldw = D; t.dst = WdT + (((size_t)l * NEXP + e) * D + nb * 32) * DEXP + 64 * kb; t.ldt = DEXP; }
    return t;
}
DI void p0_weights(const Frame& F0, const Params& P) {
    const Frame F = relaunder(F0);
    LAS float* scr = (LAS float*)(F.lds + F.wave * 8448);
    constexpr int I_LAYER = 10 * 16 * 8 + 16 + 16 * 32 + 2 * NEXP * 16 * (DEXP / 32) + NEXP * (DEXP / 64) * 32, NIT = DEPTH * I_LAYER;
    const int lane = F.lane, lr = lane >> 3, lc = lane & 7;
    f32x4 va[8], vb[8];
#define P0_LOAD(dst_, it_) do { const int itc_ = (it_) < NIT ? (it_) : F.gw; const TItem tl_ = p0_decode(P, itc_); _Pragma("unroll") for (int i = 0; i < 8; ++i) dst_[i] = *(const f32x4*)(tl_.src + (size_t)(8 * i + lr) * tl_.ldw + 4 * lc); } while (0)
#define P0_ITEM(src_, it_, nx_) do { const TItem t_ = p0_decode(P, (it_)); \
        _Pragma("unroll") for (int i = 0; i < 8; ++i) { LAS float* s = scr + (8 * i + lr) * 33 + 4 * lc; s[0] = src_[i].x; s[1] = src_[i].y; s[2] = src_[i].z; s[3] = src_[i].w; } \
        P0_LOAD(src_, (nx_)); \
        WAIT_LGKM(0); CFENCE(); \
        _Pragma("unroll") for (int j = 0; j < 4; ++j) { const int n = lr + 8 * j; const LAS float* s = scr + (8 * lc) * 33 + n; \
            u32x4 o; o.x = pk2(s[0 * 33], s[1 * 33]); o.y = pk2(s[2 * 33], s[3 * 33]); o.z = pk2(s[4 * 33], s[5 * 33]); o.w = pk2(s[6 * 33], s[7 * 33]); \
            *(u32x4*)(t_.dst + (size_t)n * t_.ldt + 8 * lc) = o; } \
        WAIT_LGKM(0); CFENCE(); } while (0)
#define P0_SEQ(j_) ((F.gw + ((j_) >> 2) * F.ngw) * 4 + ((j_) & 3))
    if (P0_SEQ(0) < NIT) { P0_LOAD(va, P0_SEQ(0)); P0_LOAD(vb, P0_SEQ(1)); }
    for (int j = 0; P0_SEQ(j) < NIT; j += 2) {
        P0_ITEM(va, P0_SEQ(j), P0_SEQ(j + 2));
        if (P0_SEQ(j + 1) < NIT) P0_ITEM(vb, P0_SEQ(j + 1), P0_SEQ(j + 3));
    }
#undef P0_SEQ
#undef P0_LOAD
#undef P0_ITEM
}
DI void p0_mod(const Frame& F0, const Params& P) {
    const Frame F = relaunder(F0);
    LAS float* sv = (LAS float*)F.lds;
    LAS f32x2* red = (LAS f32x2*)(sv + (NB + 1) * D);
    float* modL = wsp<float>(P, WS_MODL); float* modC = wsp<float>(P, WS_MODC);
    for (int i = F.tid; i < (NB + 1) * D; i += 512) { const int s = i / D, k = i % D; sv[i] = siluf(s < NB ? P.in[I_C][s * D + k] : P.in[I_CCTX][k]); }
    __syncthreads();
    for (int it = F.bid; it < DEPTH * 48; it += F.G) {
        const int l = it / 48, n = (it % 48) * 128 + 2 * F.lane;
        const float* wm = P.in[I_WMOD] + (size_t)l * D * 6 * D + n;
        f32x2 acc[NB + 1];
#pragma unroll
        for (int s = 0; s <= NB; ++s) acc[s] = (f32x2){0.f, 0.f};
        for (int k0 = F.wave * 128; k0 < F.wave * 128 + 128; k0 += 16) { f32x2 w[16];
#pragma unroll
            for (int i = 0; i < 16; ++i) w[i] = *(const f32x2*)(wm + (size_t)(k0 + i) * 6 * D);
#pragma unroll
            for (int i = 0; i < 16; ++i)
#pragma unroll
                for (int s = 0; s <= NB; ++s) acc[s] += w[i] * sv[s * D + k0 + i]; }
#pragma unroll
        for (int s = 0; s <= NB; ++s) red[(F.wave * (NB + 1) + s) * 64 + F.lane] = acc[s];
        __syncthreads();
        if (F.tid < (NB + 1) * 64) { const int s = F.tid / 64, ln = F.tid % 64; f32x2 v = {0.f, 0.f};
            for (int w = 0; w < 8; ++w) v += red[(w * (NB + 1) + s) * 64 + ln];
            const int nn = (it % 48) * 128 + 2 * ln; v += *(const f32x2*)(P.in[I_BMOD] + (size_t)l * 6 * D + nn);
            *(f32x2*)((s < NB ? modL + ((size_t)l * NB + s) * 6 * D : modC + (size_t)l * 6 * D) + nn) = v; }
        __syncthreads();
    }
}
DI void p0_misc(const Frame& F0, const Params& P) {
    const Frame F = relaunder(F0);
    const size_t gt = (size_t)F.bid * 512 + F.tid, ngt = (size_t)F.G * 512;
    { float* rope = wsp<float>(P, WS_ROPE);
      for (size_t i = gt; i < (size_t)SEQ * 16; i += ngt) { const int t = (int)(i / 16), p = (int)(i % 16); const float pos = (p < 8) ? (float)(t / GRIDW) : (float)(t % GRIDW);
          const float inv = exp2f(-(float)(p & 7) * (13.287712379549449f / 8.0f));     const float ang = pos * inv; rope[2 * i] = cosf(ang); rope[2 * i + 1] = sinf(ang); } }
    { LAS float* ct = (LAS float*)F.lds;
      for (int m = F.tid; m < SEQ; m += 512) ct[m] = cospi_(2.0f * (float)m / (float)SEQ);
      __syncthreads();
      bf16_t* dl = wsp<bf16_t>(P, WS_DFTL); const float sc = 1.0f / sqrtf((float)SEQ);
      for (size_t i = gt; i < (size_t)(HSEQ + 1) * SEQ / 2; i += ngt) { const int k = (int)(i / (SEQ / 2)), t = 2 * (int)(i % (SEQ / 2));     const int m0 = (int)(((long long)k * t) % SEQ), m1 = (m0 + k) % SEQ;
          *(unsigned*)(dl + (size_t)k * 2 * SEQ + t) = pk2(ct[m0] * sc, ct[m1] * sc);
          *(unsigned*)(dl + (size_t)k * 2 * SEQ + SEQ + t) = pk2(ct[(m0 + 3 * SEQ / 4) % SEQ] * sc, ct[(m1 + 3 * SEQ / 4) % SEQ] * sc); }
      bf16_t* dc = wsp<bf16_t>(P, WS_DFTC); const float scc = 1.0f / sqrtf((float)CTX); constexpr int STEP = SEQ / CTX;
      for (size_t i = gt; i < (size_t)CTX * 2 * CTX; i += ngt) { const int k = (int)(i / (2 * CTX)), c = (int)(i % (2 * CTX)), t = c % CTX; const int m = ((k * t) % CTX) * STEP;
          dc[(size_t)k * 2 * SEQ + c] = f2bf((c < CTX ? ct[m] : ct[(m + 3 * SEQ / 4) % SEQ]) * scc); }
      __syncthreads(); }
    { bf16_t* mz = wsp<bf16_t>(P, WS_MZT);
      for (size_t i = gt; i < (size_t)DEPTH * 512 * 256; i += ngt) { const int l = (int)(i / (512 * 256)), np = (int)((i / 256) % 512), c = (int)(i % 256); const int n = np & 255, g0 = c & ~63;
          const float* fw = P.in[I_FTW] + (size_t)l * 256 * 256; float a = 0.f;
          for (int j = 0; j < 64; ++j) { const int m = ((c & 63) * j) & 63; const float x = 2.0f * (float)m / 64.0f; const float tr = (np < 256) ? cospi_(x) : -sinpi_(x); a += tr * fw[(size_t)(g0 + j) * 256 + n]; }
          mz[i] = f2bf(a * 0.125f); }
      bf16_t* wf = wsp<bf16_t>(P, WS_WFT);
      for (size_t i = gt; i < (size_t)DEPTH * D * 256; i += ngt) { const int l = (int)(i / (D * 256)), k = (int)((i / 256) % D), c = (int)(i % 256); wf[i] = f2bf(P.in[I_WIN][((size_t)l * D + k) * IN_W + 2576 + c]); } }
    { int* ridx = wsp<int>(P, WS_RIDX); for (size_t i = gt; i < (size_t)NEXP * EROWS_PAD; i += ngt) ridx[i] = 0; }
}

DI void phase_norm1(const Frame& F0, const Params& P, const int l) {
    const Frame F = relaunder(F0);
    float* xres = wsp<float>(P, WS_XRES); bf16_t* hb = wsp<bf16_t>(P, WS_H);
    const int* inv = wsp<int>(P, WS_INV); const bf16_t* yb = wsp<bf16_t>(P, WS_Y);
    const float* modL = wsp<float>(P, WS_MODL); const float* modC = wsp<float>(P, WS_MODC);
    const bool fin = (l == DEPTH);
    const int nrows = fin ? R_LAT : RT;
    const int R1 = (nrows + F.ngw - 1) / F.ngw;
    if (F.gw * R1 >= nrows) return;
    const int rend = (F.gw * R1 + R1 < nrows) ? F.gw * R1 + R1 : nrows;
    constexpr int NSL = 4;
#define N1_XSRC(r_) ((l <= 1) ? (const f32x4*)((r_) < R_LAT ? P.in[I_X] + (size_t)(r_) * D : P.in[I_CTX] + (size_t)((r_) - R_LAT) * D) + F.lane : (const f32x4*)(xres + (size_t)(r_) * D) + F.lane)
#define N1_LDINV(r_) do { _Pragma("unroll") for (int e_ = 0; e_ < NEXP; ++e_) ivv[e_ >> 2][e_ & 3] = inv[(size_t)e_ * RT + (r_)]; } while (0)
#define N1_ISSUE(r_) do { \
        _Pragma("unroll") for (int k_ = 0; k_ < NSL; ++k_) sl[k_] = -1; \
        if (l > 0) { int cnt_ = 0; \
            _Pragma("unroll") for (int e_ = 0; e_ < NEXP; ++e_) { const int ix_ = __builtin_amdgcn_readfirstlane(ivv[e_ >> 2][e_ & 3]); \
                if (ix_ >= 0) { _Pragma("unroll") for (int k_ = 0; k_ < NSL; ++k_) sl[k_] = (cnt_ == k_) ? ix_ : sl[k_]; ++cnt_; } } \
            nsel = cnt_; } \
        { const f32x4* xs_ = N1_XSRC(r_); _Pragma("unroll") for (int j_ = 0; j_ < 4; ++j_) xn[j_] = xs_[64 * j_]; } \
        if (l > 0) { const u32x2* dm_ = (const u32x2*)(dmix + (size_t)(r_) * D) + F.lane; _Pragma("unroll") for (int j_ = 0; j_ < 4; ++j_) dn[j_] = dm_[64 * j_]; } \
        if (l > 0) { _Pragma("unroll") for (int k_ = 0; k_ < NSL; ++k_) { const u32x2* yr_ = (const u32x2*)(yb + (size_t)(sl[k_] < 0 ? 0 : sl[k_]) * D) + F.lane; \
            _Pragma("unroll") for (int j_ = 0; j_ < 4; ++j_) yn[k_][j_] = yr_[64 * j_]; } } } while (0)
    const bf16_t* dmix = wsp<bf16_t>(P, WS_DMIX);
    i32x4 ivv[NEXP / 4]; int sl[NSL], nsel = 0; f32x4 xn[4]; u32x2 yn[NSL][4]; u32x2 dn[4];
    int row = F.gw * R1;
    if (l > 0) N1_LDINV(row);
    N1_ISSUE(row);
    { const int r1 = row + 1 < rend ? row + 1 : row; if (l > 0) N1_LDINV(r1); }
    f32x4 mg5[4], mgn[4], msh[4], mscl[4]; int bkey = -2;
    { const f32x4* g = (fin ? (const f32x4*)P.in[I_FNG] : (const f32x4*)(P.in[I_N1G] + (size_t)l * D)) + F.lane;
#pragma unroll
      for (int j = 0; j < 4; ++j) mgn[j] = g[64 * j]; }
    for (; row < rend; ++row) {
        const bool lat = row < R_LAT; const int b = lat ? row / SEQ : 0;
        if ((lat ? b : -1) != bkey) { bkey = lat ? b : -1;
            if (l > 0) { const float* mp = (lat ? modL + ((size_t)(l - 1) * NB + b) * 6 * D : modC + (size_t)(l - 1) * 6 * D) + 5 * D;
#pragma unroll
                for (int j = 0; j < 4; ++j) mg5[j] = *((const f32x4*)mp + F.lane + 64 * j); }
            if (!fin) { const float* mp = lat ? modL + ((size_t)l * NB + b) * 6 * D : modC + (size_t)l * 6 * D;
#pragma unroll
                for (int j = 0; j < 4; ++j) { msh[j] = *((const f32x4*)mp + F.lane + 64 * j); mscl[j] = *((const f32x4*)(mp + D) + F.lane + 64 * j); } } }
        f32x4* xr = (f32x4*)(xres + (size_t)row * D) + F.lane;
        f32x4 v[4]; u32x2 y[NSL][4]; int sc[NSL]; const int nc = nsel;
#pragma unroll
        for (int j = 0; j < 4; ++j) { v[j] = xn[j]; if (l > 0) { const u32x2 w = dn[j]; v[j] += (f32x4){bflo(w.x), bfhi(w.x), bflo(w.y), bfhi(w.y)}; } }
#pragma unroll
        for (int k = 0; k < NSL; ++k) { sc[k] = sl[k];
#pragma unroll
            for (int j = 0; j < 4; ++j) y[k][j] = yn[k][j]; }
        { const int r1 = row + 1 < rend ? row + 1 : row, r2 = r1 + 1 < rend ? r1 + 1 : r1;
          N1_ISSUE(r1);
          if (l > 0) N1_LDINV(r2); }
        if (l > 0) {
            f32x4 s[4];
#pragma unroll
            for (int j = 0; j < 4; ++j) s[j] = (f32x4){0.f, 0.f, 0.f, 0.f};
#pragma unroll
            for (int k = 0; k < NSL; ++k) if (sc[k] >= 0) {
#pragma unroll
                for (int j = 0; j < 4; ++j) { const u32x2 w = y[k][j]; s[j] += (f32x4){bflo(w.x), bfhi(w.x), bflo(w.y), bfhi(w.y)}; } }
            if (nc > NSL) { int seen = 0;
                for (int e = 0; e < NEXP; ++e) { const int ix = __builtin_amdgcn_readfirstlane(inv[(size_t)e * RT + row]);
                    if (ix >= 0) { if (seen >= NSL) { const u32x2* yr = (const u32x2*)(yb + (size_t)ix * D) + F.lane;
#pragma unroll
                            for (int j = 0; j < 4; ++j) { const u32x2 w = yr[64 * j]; s[j] += (f32x4){bflo(w.x), bfhi(w.x), bflo(w.y), bfhi(w.y)}; } }
                        ++seen; } } }
#pragma unroll
            for (int j = 0; j < 4; ++j) { v[j] += mg5[j] * s[j]; xr[64 * j] = v[j]; }
        }
        float ss = 0.f;
#pragma unroll
        for (int j = 0; j < 4; ++j) ss += (v[j].x * v[j].x + v[j].y * v[j].y) + (v[j].z * v[j].z + v[j].w * v[j].w);
        const float rstd = 1.0f / sqrtf(wave_sum(ss) * (1.0f / D) + RMS_EPS);
        if (fin) {
            f32x4* o = (f32x4*)(P.out + (size_t)row * D) + F.lane;
#pragma unroll
            for (int j = 0; j < 4; ++j) o[64 * j] = v[j] * rstd * mgn[j];
        } else {
            u32x2* ho = (u32x2*)(hb + (size_t)row * D) + F.lane;
#pragma unroll
            for (int j = 0; j < 4; ++j) { const f32x4 sh = msh[j], scl = mscl[j];
                const f32x4 hv = v[j] * rstd * mgn[j] * (scl + 1.0f) + sh; u32x2 w; w.x = pk2(hv.x, hv.y); w.y = pk2(hv.z, hv.w); ho[64 * j] = w; }
        }
    }
#undef N1_XSRC
#undef N1_LDINV
#undef N1_ISSUE
}
constexpr int lg2c(int x) { return x <= 1 ? 0 : 1 + lg2c(x / 2); }
template <int N> struct RouterRed {
    template <int OFF> static DI float run(float (&v)[N], int lane) {
        float w[N / 2];
        const bool up = (lane & OFF) != 0;
#pragma unroll
        for (int i = 0; i < N / 2; ++i) { const float send = up ? v[i] : v[i + N / 2], keep = up ? v[i + N / 2] : v[i]; w[i] = keep + __shfl_xor(send, OFF); }
        return RouterRed<N / 2>::template run<OFF / 2>(w, lane);
    }
};
template <> struct RouterRed<1> { template <int OFF> static DI float run(float (&v)[1], int) { float x = v[0];
#pragma unroll
        for (int o = OFF; o >= 1; o >>= 1) x += __shfl_xor(x, o);
        return x; } };
DI void phase_norm2(const Frame& F0, const Params& P, const int l) {
    const Frame F = relaunder(F0);
    const float* xres = wsp<float>(P, WS_XRES); bf16_t* hb = wsp<bf16_t>(P, WS_H); float* aff = wsp<float>(P, WS_AFF);
    const float* modL = wsp<float>(P, WS_MODL); const float* modC = wsp<float>(P, WS_MODC);
    const float* wr = P.in[I_WR] + (size_t)l * D * NEXP;
    constexpr int EC = NEXP / 4, LGE = lg2c(NEXP);
    LAS f32x4* wl = (LAS f32x4*)F.lds;
    for (int i = F.tid; i < 16 * EC * 64; i += 512) { const int ln = i & 63, c = (i >> 6) % EC, jq = (i >> 6) / EC, col = 4 * ln + 256 * (jq >> 2) + (jq & 3);
        wl[i] = *(const f32x4*)(wr + (size_t)col * NEXP + 4 * c); }
    __syncthreads();
    const int lane = F.lane;
    int elane = 0;
#pragma unroll
    for (int s = 0; s < LGE; ++s) elane |= ((lane >> (5 - s)) & 1) << (LGE - 1 - s);
    const int nrows = (l < DEPTH - 1) ? RT : R_LAT;
    const bf16_t* dmix = wsp<bf16_t>(P, WS_DMIX);
#define N2_XSRC(r_) ((l == 0) ? (const f32x4*)((r_) < R_LAT ? P.in[I_X] + (size_t)(r_) * D : P.in[I_CTX] + (size_t)((r_) - R_LAT) * D) + lane : (const f32x4*)(xres + (size_t)(r_) * D) + lane)
    f32x4 vn[4]; u32x2 dn[4];
    const int R2 = (nrows + F.ngw - 1) / F.ngw, rbeg = F.gw * R2, rend = (rbeg + R2 < nrows) ? rbeg + R2 : nrows;
    { const int r0 = rbeg < nrows ? rbeg : 0; const f32x4* xr = N2_XSRC(r0); const u32x2* dm = (const u32x2*)(dmix + (size_t)r0 * D) + lane;
#pragma unroll
      for (int j = 0; j < 4; ++j) { vn[j] = xr[64 * j]; dn[j] = dm[64 * j]; } }
    f32x4 mg[4], msh[4], mscl[4]; int bkey = -2;
    { const f32x4* g = (const f32x4*)(P.in[I_N2G] + (size_t)l * D) + lane;
#pragma unroll
      for (int j = 0; j < 4; ++j) mg[j] = g[64 * j]; }
    for (int row = rbeg; row < rend; ++row) {
        const bool lat = row < R_LAT; const int b = lat ? row / SEQ : 0;
        if ((lat ? b : -1) != bkey) { bkey = lat ? b : -1; const float* mp = lat ? modL + ((size_t)l * NB + b) * 6 * D : modC + (size_t)l * 6 * D;
#pragma unroll
            for (int j = 0; j < 4; ++j) { msh[j] = *((const f32x4*)(mp + 3 * D) + lane + 64 * j); mscl[j] = *((const f32x4*)(mp + 4 * D) + lane + 64 * j); } }
        const LAS f32x4* wlr = wl; LAUNDER_V(wlr);
        f32x4 v[4]; float ss = 0.f;
#pragma unroll
        for (int j = 0; j < 4; ++j) { const u32x2 w = dn[j]; v[j] = vn[j] + (f32x4){bflo(w.x), bfhi(w.x), bflo(w.y), bfhi(w.y)}; ss += (v[j].x * v[j].x + v[j].y * v[j].y) + (v[j].z * v[j].z + v[j].w * v[j].w); }
        { const int rn = row + 1 < rend ? row + 1 : row; const f32x4* xr = N2_XSRC(rn); const u32x2* dm = (const u32x2*)(dmix + (size_t)rn * D) + lane;
#pragma unroll
          for (int j = 0; j < 4; ++j) { vn[j] = xr[64 * j]; dn[j] = dm[64 * j]; } }
        const float rstd = 1.0f / sqrtf(wave_sum(ss) * (1.0f / D) + RMS_EPS);
        u32x2* ho = (u32x2*)(hb + (size_t)row * D) + lane;
        float lg[NEXP];
#pragma unroll
        for (int e = 0; e < NEXP; ++e) lg[e] = 0.f;
#pragma unroll
        for (int j = 0; j < 4; ++j) { const float* mpx = lat ? modL + ((size_t)l * NB + b) * 6 * D : modC + (size_t)l * 6 * D; const f32x4 sh = *((const f32x4*)(mpx + 3 * D) + lane + 64 * j), scl = *((const f32x4*)(mpx + 4 * D) + lane + 64 * j);
            const f32x4 hv = v[j] * rstd * mg[j] * (scl + 1.0f) + sh; u32x2 w; w.x = pk2(hv.x, hv.y); w.y = pk2(hv.z, hv.w); ho[64 * j] = w;
#pragma unroll
            for (int q = 0; q < 4; ++q)
#pragma unroll
                for (int c = 0; c < EC; ++c) { const f32x4 wv = wlr[((j * 4 + q) * EC + c) * 64 + lane]; lg[4 * c] += hv[q] * wv.x; lg[4 * c + 1] += hv[q] * wv.y; lg[4 * c + 2] += hv[q] * wv.z; lg[4 * c + 3] += hv[q] * wv.w; } }
        const float logit = RouterRed<NEXP>::template run<32>(lg, lane);
        float mx = logit;
#pragma unroll
        for (int s = 0; s < LGE; ++s) mx = fmaxf(mx, __shfl_xor(mx, 32 >> s));
        const float ex = __expf(logit - mx); float sum = ex;
#pragma unroll
        for (int s = 0; s < LGE; ++s) sum += __shfl_xor(sum, 32 >> s);
        if ((lane & ((64 >> LGE) - 1)) == 0) aff[(size_t)row * NEXP + elane] = ex / sum;
    }
    __syncthreads();
}

DI int xcd_remap(int L, int total) { const int q = total / 8, r = total % 8, x = L % 8, off = L / 8; return (x < r ? x * (q + 1) : r * (q + 1) + (x - r) * q) + off; }
DI void decode2d(int L, int nM, int nN, int& pm, int& pn) { const int nig = 8 * nN, gid = L / nig, fm = gid * 8, gsz = (nM - fm) < 8 ? (nM - fm) : 8; pm = fm + (L % nig) % gsz; pn = (L % nig) / gsz; }

struct SchedW {
    int G, c; const char* mz; const char* wf;
    DI bool next(int i, g8::Unit& u) const { const int L = i * G + c; if (L >= DEPTH * 8) return false; const int l = L / 8, pm = (L % 8) / 4, pn = L % 4;
        u.A = mz + ((size_t)l * 512 + pm * 256) * 256 * 2; u.B = wf + ((size_t)l * D + pn * 256) * 256 * 2; u.gidx = nullptr; u.pm = pm; u.pn = pn; u.aux = l; u.nt = 4; u.half = 0; return true; }
};
struct EpiW { static constexpr bool ALIGN = G8_ALIGN_W; static constexpr bool PERM = true; bf16_t* WinT;
    DI void operator()(const f32x4 (&acc)[2][2][4][2], const g8::Unit& u, int wr, int wc, int fr, int fq) const {
#pragma unroll
        for (int ai = 0; ai < 2; ++ai)
#pragma unroll
            for (int m = 0; m < 4; ++m) { const int r = u.pm * 256 + ai * 128 + wr * 64 + m * 16 + fr; bf16_t* rowp = WinT + ((size_t)u.aux * NPROJ + 2560 + r) * D + u.pn * 256 + wc * 32 + 8 * fq;
#pragma unroll
                for (int bj = 0; bj < 2; ++bj) { const f32x4 v0 = acc[ai][bj][m][0], v1 = acc[ai][bj][m][1]; u32x4 w; w.x = pk2(v0.x, v0.y); w.y = pk2(v0.z, v0.w); w.z = pk2(v1.x, v1.y); w.w = pk2(v1.z, v1.w); *(u32x4*)(rowp + bj * 128) = w; } }
    }
};
struct SchedProj {
    int G, c, last; const char* A; const char* B;
    DI bool next(int i, g8::Unit& u) const {
        constexpr int nLat = R_LAT / 256, nCtx = R_CTX / 256;
        const int ntc = last ? 8 : NTILE, total = nLat * NTILE + nCtx * ntc;
        int L = i * G + c; if (L >= total) return false; L = xcd_remap(L, total);
        int pm, pn;
        if (L < nLat * NTILE) decode2d(L, nLat, NTILE, pm, pn);
        else { L -= nLat * NTILE; pm = nLat + L / ntc; pn = L % ntc; if (last) { const int k = pn; pn = (k < 5) ? k + 1 : (k == 5 ? 8 : (k == 6 ? 9 : 12)); } }
        u.A = A + (size_t)pm * 256 * D * 2; u.B = B + (size_t)pn * 256 * D * 2; u.gidx = nullptr; u.pm = pm; u.pn = pn; u.aux = 0; u.nt = D / 64; u.half = 0; return true; }
};
struct EpiProj { static constexpr bool ALIGN = G8_ALIGN_PROJ; static constexpr bool PERM = true; bf16_t* proj; float* ab; bf16_t* ztl; bf16_t* ztc; const float* rope;
    DI void operator()(const f32x4 (&acc)[2][2][4][2], const g8::Unit& u, int wr, int wc, int fr, int fq) const {
        const int pn = u.pn; const bool lat = u.pm * 256 < R_LAT;
#pragma unroll
        for (int ai = 0; ai < 2; ++ai)
#pragma unroll
            for (int m = 0; m < 4; ++m) {
                const int row = u.pm * 256 + ai * 128 + wr * 64 + m * 16 + fr;
                int b, t; if (lat) { b = row / SEQ; t = row % SEQ; } else { const int rr = row - R_LAT; b = rr / CTX; t = rr % CTX; }
#pragma unroll
                for (int bj = 0; bj < 2; ++bj) {
                    const int c8 = 128 * bj + 32 * wc + 8 * fq; f32x4 v0 = acc[ai][bj][m][0], v1 = acc[ai][bj][m][1];
                    if (pn == 0) { v0 = v0 * (0.125f * LOG2E); v1 = v1 * (0.125f * LOG2E); }
                    if (pn == 7) { v0 = v0 * (0.17677669529663687f * LOG2E); v1 = v1 * (0.17677669529663687f * LOG2E); }
                    if (pn < 10) {
                        if ((pn == 7 || pn == 8) && lat) { const f32x4* cs = (const f32x4*)(rope + ((size_t)t * 16 + 4 * fq) * 2); const f32x4 c0 = cs[0], c1 = cs[1];
                            v0 = (f32x4){v0.x * c0.x - v0.y * c0.y, v0.x * c0.y + v0.y * c0.x, v0.z * c0.z - v0.w * c0.w, v0.z * c0.w + v0.w * c0.z};
                            v1 = (f32x4){v1.x * c1.x - v1.y * c1.y, v1.x * c1.y + v1.y * c1.x, v1.z * c1.z - v1.w * c1.w, v1.z * c1.w + v1.w * c1.z}; }
                        u32x4 w; w.x = pk2(v0.x, v0.y); w.y = pk2(v0.z, v0.w); w.z = pk2(v1.x, v1.y); w.w = pk2(v1.z, v1.w);
                        *(u32x4*)(proj + (size_t)row * PLD + pn * 256 + c8) = w;
                    } else if (pn < 12) {
                        bf16_t* base = (lat ? ztl : ztc) + ((size_t)(b * 256 + c8)) * (2 * SEQ) + (pn - 10) * (lat ? SEQ : CTX) + t;
#pragma unroll
                        for (int j = 0; j < 4; ++j) { base[(size_t)j * 2 * SEQ] = f2bf(v0[j]); base[(size_t)(j + 4) * 2 * SEQ] = f2bf(v1[j]); }
                    } else if (bj == 0 && wc == 0 && fq < 2) { f32x4* o = (f32x4*)(ab + (size_t)row * 16 + 8 * fq); o[0] = v0; o[1] = v1; }
                }
            }
    }
};
struct SchedOut {
    int G, c, last; const char* A; const char* B;
    DI bool next(int i, g8::Unit& u) const { const int nM = last ? R_LAT / 256 : RT / 256, total = nM * 4; int L = i * G + c; if (L >= total) return false; L = xcd_remap(L, total);
        int pm, pn; decode2d(L, nM, 4, pm, pn);
        u.A = A + (size_t)pm * 256 * D * 2; u.B = B + (size_t)pn * 256 * D * 2; u.gidx = nullptr; u.pm = pm; u.pn = pn; u.aux = 0; u.nt = D / 64; u.half = 0; return true; }
};
struct EpiOut { static constexpr bool ALIGN = G8_ALIGN_OUT; static constexpr bool PERM = true; bf16_t* dmix; const float* modL; const float* modC;
    DI void operator()(const f32x4 (&acc)[2][2][4][2], const g8::Unit& u, int wr, int wc, int fr, int fq) const {
        const bool lat = u.pm * 256 < R_LAT; const int b = lat ? (u.pm * 256) / SEQ : 0;
        const float* g2 = lat ? modL + (size_t)b * 6 * D : modC;
#pragma unroll
        for (int bj = 0; bj < 2; ++bj) { const int c = u.pn * 256 + 128 * bj + 32 * wc + 8 * fq; const f32x4 g0 = *(const f32x4*)(g2 + c), g1 = *(const f32x4*)(g2 + c + 4);
#pragma unroll
            for (int ai = 0; ai < 2; ++ai)
#pragma unroll
                for (int m = 0; m < 4; ++m) { const int row = u.pm * 256 + ai * 128 + wr * 64 + m * 16 + fr; const f32x4 v0 = g0 * acc[ai][bj][m][0], v1 = g1 * acc[ai][bj][m][1];
                    u32x4 w; w.x = pk2(v0.x, v0.y); w.y = pk2(v0.z, v0.w); w.z = pk2(v1.x, v1.y); w.w = pk2(v1.z, v1.w); *(u32x4*)(dmix + (size_t)row * D + c) = w; } }
    }
};
struct SchedDft {
    int G, c, lat_on, ctx_on; const char* dl; const char* dc; const char* zl; const char* zc;
    DI bool next(int i, g8::Unit& u) const { constexpr int nlatc = (HSEQ / 256) * 2 * KSPLIT * NB, nctx = (CTX / 256) * NB; const int nlat = lat_on ? nlatc : 0, nc = ctx_on ? nctx : 0, total = nlat + nc;
        int L = i * G + c; if (L >= total) return false;
        if (L >= nc) { L = xcd_remap(L - nc, nlat); const int b = L % NB, ks = (L / NB) % (2 * KSPLIT), pm = L / (NB * 2 * KSPLIT);
            const size_t ko = (ks < KSPLIT) ? (size_t)ks * KCH : (size_t)SEQ + (size_t)(ks - KSPLIT) * KCH;
            u.A = dl + ((size_t)(1 + pm * 256) * 2 * SEQ + ko) * 2; u.B = zl + ((size_t)b * 256 * 2 * SEQ + ko) * 2; u.pm = pm; u.pn = b; u.aux = ks; u.nt = KCH / 64; }
        else { const int b = L % NB, pm = L / NB; u.A = dc + (size_t)pm * 256 * 2 * SEQ * 2; u.B = zc + (size_t)b * 256 * 2 * SEQ * 2; u.pm = pm; u.pn = b; u.aux = -1; u.nt = 2 * CTX / 64; }
        u.gidx = nullptr; u.half = 0; return true; }
};
struct EpiDft { static constexpr bool ALIGN = G8_ALIGN_DFT; static constexpr bool PERM = false; float* slab; bf16_t* mix;
    DI void operator()(const f32x4 (&acc)[2][2][4][2], const g8::Unit& u, int wr, int wc, int fr, int fq) const {
        if (u.aux < 0) {
#pragma unroll
            for (int ai = 0; ai < 2; ++ai)
#pragma unroll
                for (int m = 0; m < 4; ++m) { bf16_t* rowp = mix + (size_t)(R_LAT + u.pn * CTX + u.pm * 256 + ai * 128 + wr * 64 + m * 16 + fr) * D + 768 + 32 * wc + 4 * fq;
#pragma unroll
                    for (int bj = 0; bj < 2; ++bj)
#pragma unroll
                        for (int n = 0; n < 2; ++n) { const f32x4 v = acc[ai][bj][m][n]; u32x2 o; o.x = pk2(v.x, v.y); o.y = pk2(v.z, v.w); *(u32x2*)(rowp + 128 * bj + 16 * n) = o; } }
            return;
        }
        float* base = slab + ((size_t)u.aux * (NB * HSEQ) + (size_t)u.pn * HSEQ + u.pm * 256) * 256;
#pragma unroll
        for (int ai = 0; ai < 2; ++ai)
#pragma unroll
            for (int m = 0; m < 4; ++m) { float* rowp = base + (size_t)(ai * 128 + wr * 64 + m * 16 + fr) * 256 + 32 * wc + 4 * fq;
#pragma unroll
                for (int bj = 0; bj < 2; ++bj)
#pragma unroll
                    for (int n = 0; n < 2; ++n) *(f32x4*)(rowp + 128 * bj + 16 * n) = acc[ai][bj][m][n]; }
    }
};
constexpr bool EHALF = (EROWS % 256 != 0) && (EROWS % 256 <= 128);
struct SchedGU {
    int G, c, epan; const char* A; const char* B; const int* ridx;
    DI bool next(int i, g8::Unit& u) const { constexpr int NN = 2 * DEXP / 256; const int total = NEXP * epan * NN; int L = i * G + c; if (L >= total) return false;
        const bool hp = EHALF && (epan == EROWS_PAD / 256); const int ef = hp ? epan - 1 : epan, nfull = NEXP * ef * NN;
        int e, pn, pm, hf = 0;
        if (L < nfull) { L = xcd_remap(L, nfull); e = L / (ef * NN); const int rem = L % (ef * NN); pn = rem / ef; pm = rem % ef; }
        else { L -= nfull; e = L / NN; pn = L % NN; pm = epan - 1; hf = 1; }
        u.A = A; u.gidx = ridx + (size_t)e * EROWS_PAD + pm * 256; u.B = B + ((size_t)e * 2 * DEXP + pn * 256) * D * 2; u.pm = e * (EROWS_PAD / 256) + pm; u.pn = pn; u.aux = e; u.nt = D / 64; u.half = hf; return true; }
};
struct EpiGU { static constexpr bool ALIGN = G8_ALIGN_GU; static constexpr bool PERM = true; bf16_t* hid;
    DI void operator()(const f32x4 (&acc)[2][2][4][2], const g8::Unit& u, int wr, int wc, int fr, int fq) const {
#pragma unroll
        for (int ai = 0; ai < 2; ++ai)
#pragma unroll
            for (int m = 0; m < 4; ++m) { if (ai == 1 && u.half) continue; const int row = u.pm * 256 + ai * 128 + wr * 64 + m * 16 + fr;
                const f32x4 g0 = acc[ai][0][m][0], g1 = acc[ai][0][m][1], u0 = acc[ai][1][m][0], u1 = acc[ai][1][m][1];
                u32x4 w; w.x = pk2(siluf(g0.x) * u0.x, siluf(g0.y) * u0.y); w.y = pk2(siluf(g0.z) * u0.z, siluf(g0.w) * u0.w); w.z = pk2(siluf(g1.x) * u1.x, siluf(g1.y) * u1.y); w.w = pk2(siluf(g1.z) * u1.z, siluf(g1.w) * u1.w);
                *(u32x4*)(hid + (size_t)row * DEXP + u.pn * 128 + 32 * wc + 8 * fq) = w; }
    }
};
struct SchedDown {
    int G, c, epan; const char* A; const char* B;
    DI bool next(int i, g8::Unit& u) const { const int total = NEXP * epan * 4; int L = i * G + c; if (L >= total) return false;
        const bool hp = EHALF && (epan == EROWS_PAD / 256); const int ef = hp ? epan - 1 : epan, nfull = NEXP * ef * 4;
        int e, pn, pm, hf = 0;
        if (L < nfull) { L = xcd_remap(L, nfull); e = L / (ef * 4); const int rem = L % (ef * 4); pn = rem / ef; pm = rem % ef; }
        else { L -= nfull; e = L / 4; pn = L % 4; pm = epan - 1; hf = 1; }
        u.A = A + ((size_t)e * EROWS_PAD + pm * 256) * DEXP * 2; u.gidx = nullptr; u.B = B + ((size_t)e * D + pn * 256) * DEXP * 2; u.pm = e * (EROWS_PAD / 256) + pm; u.pn = pn; u.aux = e; u.nt = DEXP / 64; u.half = hf; return true; }
};
struct EpiDown { static constexpr bool ALIGN = G8_ALIGN_DOWN; static constexpr bool PERM = true; bf16_t* y; const float* gatev;
    DI void operator()(const f32x4 (&acc)[2][2][4][2], const g8::Unit& u, int wr, int wc, int fr, int fq) const {
#pragma unroll
        for (int ai = 0; ai < 2; ++ai)
#pragma unroll
            for (int m = 0; m < 4; ++m) { if (ai == 1 && u.half) continue; const int row = u.pm * 256 + ai * 128 + wr * 64 + m * 16 + fr; const float gv = gatev[row];
#pragma unroll
                for (int bj = 0; bj < 2; ++bj) { const f32x4 v0 = acc[ai][bj][m][0] * gv, v1 = acc[ai][bj][m][1] * gv; u32x4 w; w.x = pk2(v0.x, v0.y); w.y = pk2(v0.z, v0.w); w.z = pk2(v1.x, v1.y); w.w = pk2(v1.z, v1.w);
                    *(u32x4*)(y + (size_t)row * D + u.pn * 256 + 128 * bj + 32 * wc + 8 * fq) = w; } }
    }
};

DI int block_sum_i(const Frame& F, int v, LAS int* tmp) {
#pragma unroll
    for (int o = 1; o < 64; o <<= 1) v += __shfl_xor(v, o);
    if (F.lane == 0) tmp[F.wave] = v;
    __syncthreads();
    int s = 0;
#pragma unroll
    for (int w = 0; w < 8; ++w) s += tmp[w];
    __syncthreads();
    return s;
}
DI int block_excl_scan_i(const Frame& F, int v, LAS int* tmp) {
    int inc = v;
#pragma unroll
    for (int o = 1; o < 64; o <<= 1) { const int t = __shfl_up(inc, o); if (F.lane >= o) inc += t; }
    if (F.lane == 63) tmp[F.wave] = inc;
    __syncthreads();
    int base = 0;
#pragma unroll
    for (int w = 0; w < 8; ++w) base += (w < F.wave) ? tmp[w] : 0;
    __syncthreads();
    return base + inc - v;
}
template <int KPT>
DI void topk_problem(const Frame& F, const float* aff, int* ridx, float* gatev, int* inv, int e, int N, int cap, int rowbase, int slotbase) {
    LAS int* tmp = (LAS int*)F.lds;
    unsigned key[KPT];
#pragma unroll
    for (int j = 0; j < KPT; ++j) { const int tok = F.tid * KPT + j; key[j] = (tok < N) ? __float_as_uint(aff[(size_t)(rowbase + tok) * NEXP + e]) : 0u; }
    unsigned T = 0u;
    for (int bit = 30; bit >= 0; --bit) { const unsigned cand = T | (1u << bit); int c = 0;
#pragma unroll
        for (int j = 0; j < KPT; ++j) c += __popcll(__ballot(key[j] >= cand));
        LAS int* tb = tmp + 16 + (bit & 1) * 8;
        if (F.lane == 0) tb[F.wave] = c;
        __syncthreads();
        int sum = 0;
#pragma unroll
        for (int w = 0; w < 8; ++w) sum += tb[w];
        if (sum >= cap) T = cand; }
    int cg = 0, ce = 0;
#pragma unroll
    for (int j = 0; j < KPT; ++j) { cg += (key[j] > T) ? 1 : 0; ce += (key[j] == T) ? 1 : 0; }
    const int need_eq = cap - block_sum_i(F, cg, tmp);
    int eqb = block_excl_scan_i(F, ce, tmp);
    int sel[KPT]; int ns = 0;
#pragma unroll
    for (int j = 0; j < KPT; ++j) { const bool s = (key[j] > T) || (key[j] == T && eqb < need_eq); if (key[j] == T) ++eqb; sel[j] = s ? 1 : 0; ns += sel[j]; }
    int ord = block_excl_scan_i(F, ns, tmp);
#pragma unroll
    for (int j = 0; j < KPT; ++j) { const int tok = F.tid * KPT + j; if (tok < N) { const int row = rowbase + tok; int ix = -1;
            if (sel[j]) { ix = e * EROWS_PAD + slotbase + ord; ridx[ix] = row; gatev[ix] = __uint_as_float(key[j]); ++ord; }
            inv[(size_t)e * RT + row] = ix; } }
}
DI void phase_topk(const Frame& F0, const Params& P, const int l) {
    const Frame F = relaunder(F0);
    const float* aff = wsp<float>(P, WS_AFF); int* ridx = wsp<int>(P, WS_RIDX); float* gatev = wsp<float>(P, WS_GATEV); int* inv = wsp<int>(P, WS_INV);
    const int nprob = NEXP * NB * ((l < DEPTH - 1) ? 2 : 1);
    for (int p = F.bid; p < nprob; p += F.G) { const int seg = p / (NEXP * NB), b = (p / NEXP) % NB, e = p % NEXP;
        if (seg == 0) topk_problem<(SEQ + 511) / 512>(F, aff, ridx, gatev, inv, e, SEQ, CAP_LAT, b * SEQ, b * CAP_LAT);
        else topk_problem<(CTX + 511) / 512>(F, aff, ridx, gatev, inv, e, CTX, CAP_CTX, R_LAT + b * CTX, NB * CAP_LAT + b * CAP_CTX); }
}

DI float softplusf_(float x) { const float t = __expf(-fabsf(x)); return fmaxf(x, 0.f) + (t < 1e-3f ? t * (1.0f - 0.5f * t) : __logf(1.0f + t)); }
DI float fexp2(float x) { return __builtin_amdgcn_exp2f(x); }
DI float rdlane(float v, int l) { return __builtin_bit_cast(float, __builtin_amdgcn_readlane(__builtin_bit_cast(int, v), l)); }

DI void phase_dn0(const Frame& F0, const Params& P, const int l) {
    const Frame F = relaunder(F0);
    const bf16_t* proj = wsp<bf16_t>(P, WS_PROJ); bf16_t* dnp = wsp<bf16_t>(P, WS_DNP); const float* ab = wsp<float>(P, WS_AB); float* gb = wsp<float>(P, WS_GB);
    const float* convw = P.in[I_CONVW] + (size_t)l * 5 * 768; const float* alog = P.in[I_ALOG] + l * 8; const float* dtb = P.in[I_DTB] + l * 8;
    const int lane = F.lane;
    constexpr int DR = 9, UL = (SEQ + DR - 1) / DR, UC = (CTX + DR - 1) / DR, NU0 = NB * (UL + UC);
    for (int u = F.gw; u < NU0; u += F.ngw) {
        int base, t0, T; if (u < NB * UL) { base = (u / UL) * SEQ; t0 = (u % UL) * DR; T = SEQ; } else { const int uu = u - NB * UL; base = R_LAT + (uu / UC) * CTX; t0 = (uu % UC) * DR; T = CTX; }
        const int row0 = base + t0;
        u32x2 w[3][DR + 4];
#pragma unroll
        for (int r = 0; r < DR + 4; ++r) { const int tt = t0 - 2 + r; const bool ok = (tt >= 0) && (tt < T);
#pragma unroll
            for (int part = 0; part < 3; ++part) w[part][r] = ok ? *(const u32x2*)(proj + (size_t)(base + tt) * PLD + 768 + part * 256 + 4 * lane) : (u32x2){0u, 0u}; }
#pragma unroll
        for (int ps = 0; ps < (DR + 7) / 8; ++ps) { const int ri = 8 * ps + (lane >> 3), k = lane & 7;
            if (ri < DR && t0 + ri < T) { const size_t row = (size_t)row0 + ri; const float av = ab[row * 16 + k], bv = ab[row * 16 + 8 + k];
                gb[row * 16 + k] = -__expf(alog[k]) * softplusf_(av + dtb[k]); gb[row * 16 + 8 + k] = __builtin_amdgcn_rcpf(1.0f + __expf(-bv)); } }
#pragma unroll
        for (int part = 0; part < 3; ++part) {
            f32x4 cw[5];
#pragma unroll
            for (int j = 0; j < 5; ++j) cw[j] = *(const f32x4*)(convw + j * 768 + part * 256 + 4 * lane);
#pragma unroll
            for (int i = 0; i < DR; ++i) {
                f32x4 a = {0.f, 0.f, 0.f, 0.f};
#pragma unroll
                for (int j = 0; j < 5; ++j) { const u32x2 x = w[part][i + j]; a += cw[j] * (f32x4){bflo(x.x), bfhi(x.x), bflo(x.y), bfhi(x.y)}; }
                a = (f32x4){siluf(a.x), siluf(a.y), siluf(a.z), siluf(a.w)};
                if (part < 2) { float ss = (a.x * a.x + a.y * a.y) + (a.z * a.z + a.w * a.w);
                    ss += __shfl_xor(ss, 1); ss += __shfl_xor(ss, 2); ss += __shfl_xor(ss, 4); ss += __shfl_xor(ss, 8);
                    const float r = (part == 0 ? 0.125f : 1.0f) * __builtin_amdgcn_rsqf(ss + 1e-6f); a = a * r; }
                u32x2 o; o.x = pk2(a.x, a.y); o.y = pk2(a.z, a.w); if (t0 + i < T) *(u32x2*)(dnp + (size_t)(row0 + i) * 768 + part * 256 + 4 * lane) = o;
            }
        }
    }
}

#define DN_TILE(jt, it) ((jt) == 0 ? ((it) == 0 ? 0 : 1) : 2)
template <int I> struct DnSolve {
    static DI void run(float (&X)[64], const f32x16 (&Lt)[3]) {
        DnSolve<I - 1>::run(X, Lt);
        float a = X[I];
#pragma unroll
        for (int j = 0; j < I; ++j) { const int jl = j & 31, reg = (jl & 3) + 4 * (jl >> 3), hj = (jl >> 2) & 1, src = (I & 31) + 32 * hj;
            a -= rdlane(Lt[DN_TILE(j >> 5, I >> 5)][reg], src) * X[j]; }
        X[I] = a;
        __builtin_amdgcn_sched_barrier(0);
    }
};
template <> struct DnSolve<-1> { static DI void run(float (&)[64], const f32x16 (&)[3]) {} };

DI void phase_dn1(const Frame& F0, const Params& P) {
    const Frame F = relaunder(F0);
    const bf16_t* dnp = wsp<bf16_t>(P, WS_DNP); const float* gb = wsp<float>(P, WS_GB);
    bf16_t* An_g = wsp<bf16_t>(P, WS_AN); bf16_t* Qe_g = wsp<bf16_t>(P, WS_QE); unsigned* Bn_g = wsp<unsigned>(P, WS_BN); float* Oi_g = wsp<float>(P, WS_OI);
    LAS unsigned char* XT = F.lds + F.wave * 16384;
    LAS float* gcs = (LAS float*)(XT + 9216); LAS float* bts = gcs + 64; LAS unsigned char* QpL = XT + 9728;
#define QP(tl, s) (*(const LAS bf16x8*)(QpL + (((tl) * 2 + (s)) * 64 + lane) * 16))
    const int nfull = (NUNIT / F.ngw) * F.ngw, nrem = NUNIT - nfull;
    for (int lin = F.gw; ; lin += F.ngw) {
        int uid, part;
        if (lin < nfull) { uid = lin; part = 2; } else { const int r = lin - nfull; if (r >= 2 * nrem) break; uid = nfull + (r >> 1); part = r & 1; }
        int lane = F.lane; LAUNDER_V(lane); const int r32 = lane & 31, hh = lane >> 5;
        const int n = uid % NCH, dir = (uid / NCH) & 1, h = (uid / (2 * NCH)) % NH, b = uid / (2 * NCH * NH);
        int seqb, T, nn; if (n < NCC) { seqb = R_LAT + b * CTX; T = CTX; nn = n; } else { seqb = b * SEQ; T = SEQ; nn = n - NCC; }
        const int rbase = dir ? seqb + T - 1 - 64 * nn : seqb + 64 * nn, sgn = dir ? -1 : 1;
#define ROWI(i) ((size_t)(rbase + sgn * (i)))
        const bf16_t* qb_ = dnp + h * 64; const bf16_t* kb_ = dnp + 256 + h * 64; const bf16_t* vb_ = dnp + 512 + h * 64;
        float gc = gb[ROWI(lane) * 16 + dir * 4 + h]; const float beta = gb[ROWI(lane) * 16 + 8 + dir * 4 + h];
#pragma unroll
        for (int o = 1; o < 64; o <<= 1) { const float t = __shfl_up(gc, o); if (lane >= o) gc += t; }
        gcs[lane] = gc; bts[lane] = beta;
        const float glast = __shfl(gc, 63), eglast = __expf(glast);
        WAIT_LGKM(0); CFENCE();
        f32x16 Lt[3];
        {
            bf16x8 Ak[2][4], Bq[2][4];
#pragma unroll
            for (int t2 = 0; t2 < 2; ++t2)
#pragma unroll
                for (int ks = 0; ks < 4; ++ks) { const size_t ro = ROWI(32 * t2 + r32) * 768 + 16 * ks + 8 * hh; Ak[t2][ks] = *(const bf16x8*)(kb_ + ro); Bq[t2][ks] = *(const bf16x8*)(qb_ + ro); }
            const float gci[2] = {gcs[r32], gcs[32 + r32]}, bti[2] = {bts[r32], bts[32 + r32]};
#pragma unroll
            for (int tl = 0; tl < 3; ++tl) { const int jt = (tl == 2) ? 1 : 0, it = (tl == 0) ? 0 : 1;
                f32x16 kk = zero16(), qk = zero16();
#pragma unroll
                for (int ks = 0; ks < 4; ++ks) { kk = MFMA32(Ak[jt][ks], Ak[it][ks], kk); qk = MFMA32(Ak[jt][ks], Bq[it][ks], qk); }
                const int i = 32 * it + r32;
#pragma unroll
                for (int reg = 0; reg < 16; ++reg) { const int j = 32 * jt + crow(reg, hh); const float dec = (i >= j) ? __expf(gci[it] - gcs[j]) : 0.f;
                    qk[reg] = qk[reg] * dec; kk[reg] = (i > j) ? bti[it] * kk[reg] * dec : 0.f; }
                Lt[tl] = kk; *(LAS bf16x8*)(QpL + ((tl * 2 + 0) * 64 + lane) * 16) = pack8(qk, 0); *(LAS bf16x8*)(QpL + ((tl * 2 + 1) * 64 + lane) * 16) = pack8(qk, 1); }
        }
        __builtin_amdgcn_sched_barrier(0);
        float X[64];
        if (part != 1) {
#pragma unroll
        for (int i = 0; i < 64; ++i) X[i] = bf2f(vb_[ROWI(i) * 768 + lane]) * rdlane(beta, i);
        __builtin_amdgcn_sched_barrier(0);
        DnSolve<63>::run(X, Lt);
#pragma unroll
        for (int q = 0; q < 8; ++q) { u32x4 w; w.x = pk2(X[8 * q], X[8 * q + 1]); w.y = pk2(X[8 * q + 2], X[8 * q + 3]); w.z = pk2(X[8 * q + 4], X[8 * q + 5]); w.w = pk2(X[8 * q + 6], X[8 * q + 7]); *(LAS u32x4*)(XT + lane * 144 + 16 * q) = w; }
        WAIT_LGKM(0); CFENCE();
        __builtin_amdgcn_sched_barrier(0);
#pragma unroll
        for (int it = 0; it < 2; ++it)
#pragma unroll
            for (int et = 0; et < 2; ++et) { f32x16 z = zero16();
#pragma unroll
                for (int jt = 0; jt <= it; ++jt)
#pragma unroll
                    for (int s = 0; s < 2; ++s) { const LAS unsigned char* p = XT + (32 * et + r32) * 144 + (32 * jt + 16 * s + 4 * hh) * 2;
                        z = MFMA32(QP(DN_TILE(jt, it), s), cat44(*(const LAS u32x2*)p, *(const LAS u32x2*)(p + 16)), z); }
                float* op = Oi_g + (size_t)uid * 4096 + 32 * et + r32;
#pragma unroll
                for (int reg = 0; reg < 16; ++reg) op[(32 * it + crow(reg, hh)) * 64] = z[reg]; }
        }
        __builtin_amdgcn_sched_barrier(0);
        bf16x8 Kd[2][4];
#pragma unroll
        for (int dt = 0; dt < 2; ++dt)
#pragma unroll
            for (int s4 = 0; s4 < 4; ++s4) { float v[8];
#pragma unroll
                for (int jj = 0; jj < 8; ++jj) { const int j = 16 * s4 + 8 * hh + jj; v[jj] = bf2f(kb_[ROWI(j) * 768 + 32 * dt + r32]) * __expf(glast - gcs[j]); }
                u32x4 w; w.x = pk2(v[0], v[1]); w.y = pk2(v[2], v[3]); w.z = pk2(v[4], v[5]); w.w = pk2(v[6], v[7]); Kd[dt][s4] = __builtin_bit_cast(bf16x8, w); }
        if (part != 1) {
#pragma unroll
        for (int dt = 0; dt < 2; ++dt)
#pragma unroll
            for (int et = 0; et < 2; ++et) { f32x16 z = zero16();
#pragma unroll
                for (int s4 = 0; s4 < 4; ++s4) z = MFMA32(Kd[dt][s4], *(const LAS bf16x8*)(XT + (32 * et + r32) * 144 + (16 * s4 + 8 * hh) * 2), z);
                u32x4* op = (u32x4*)(Bn_g + (size_t)uid * 2048 + ((dt * 2 + et) * 64 + lane) * 8);
                op[0] = (u32x4){pk2(z[0], z[1]), pk2(z[2], z[3]), pk2(z[4], z[5]), pk2(z[6], z[7])}; op[1] = (u32x4){pk2(z[8], z[9]), pk2(z[10], z[11]), pk2(z[12], z[13]), pk2(z[14], z[15])}; }
        }
        if (part != 0) {
        CFENCE();
        LAUNDER_V(Lt[0]); LAUNDER_V(Lt[1]); LAUNDER_V(Lt[2]);
        { const float bw = beta * __expf(gc);
#pragma unroll
          for (int i = 0; i < 64; ++i) X[i] = bf2f(kb_[ROWI(i) * 768 + lane]) * rdlane(bw, i); }
        __builtin_amdgcn_sched_barrier(0);
        DnSolve<63>::run(X, Lt);
#pragma unroll
        for (int q = 0; q < 8; ++q) { u32x4 w; w.x = pk2(X[8 * q], X[8 * q + 1]); w.y = pk2(X[8 * q + 2], X[8 * q + 3]); w.z = pk2(X[8 * q + 4], X[8 * q + 5]); w.w = pk2(X[8 * q + 6], X[8 * q + 7]); *(LAS u32x4*)(XT + lane * 144 + 16 * q) = w; }
        WAIT_LGKM(0); CFENCE();
        __builtin_amdgcn_sched_barrier(0);
#pragma unroll
        for (int dt = 0; dt < 2; ++dt)
#pragma unroll
            for (int et = 0; et < 2; ++et) { f32x16 z = zero16();
#pragma unroll
                for (int s4 = 0; s4 < 4; ++s4) z = MFMA32(Kd[dt][s4], *(const LAS bf16x8*)(XT + (32 * et + r32) * 144 + (16 * s4 + 8 * hh) * 2), z);
                const int x = r32 & 15, hhA = (x >> 2) & 1, jj = ((x >> 3) << 2) | (x & 3);
                bf16_t* op = An_g + (size_t)uid * 4096 + (((dt * 2 + et) * 2 + (r32 >> 4)) * 64 + 32 * hhA) * 8 + jj;
#pragma unroll
                for (int reg = 0; reg < 16; ++reg) { const int dl = crow(reg, hh); op[dl * 8] = f2bf(((32 * dt + dl == 32 * et + r32) ? eglast : 0.f) - z[reg]); } }
        __builtin_amdgcn_sched_barrier(0);
#pragma unroll
        for (int it = 0; it < 2; ++it) { const int i = 32 * it + r32; const float eg = __expf(gcs[i]);
#pragma unroll
            for (int dt = 0; dt < 2; ++dt) { f32x16 y = zero16();
#pragma unroll
                for (int jt = 0; jt <= it; ++jt)
#pragma unroll
                    for (int s = 0; s < 2; ++s) { const LAS unsigned char* p = XT + (32 * dt + r32) * 144 + (32 * jt + 16 * s + 4 * hh) * 2;
                        y = MFMA32(cat44(*(const LAS u32x2*)p, *(const LAS u32x2*)(p + 16)), QP(DN_TILE(jt, it), s), y); }
#pragma unroll
                for (int a = 0; a < 4; ++a) { const int d0 = 32 * dt + 8 * a + 4 * hh; const u32x2 qv = *(const u32x2*)(qb_ + ROWI(i) * 768 + d0);
                    u32x2 o; o.x = pk2(bflo(qv.x) * eg - y[4 * a], bfhi(qv.x) * eg - y[4 * a + 1]); o.y = pk2(bflo(qv.y) * eg - y[4 * a + 2], bfhi(qv.y) * eg - y[4 * a + 3]);
                    *(u32x2*)(Qe_g + (size_t)uid * 4096 + i * 64 + d0) = o; } } }
        }
        WAIT_LGKM(0); CFENCE();
#undef ROWI
    }
}

DI void dn2_load(const bf16_t* An_g, const unsigned* Bn_g, size_t uid, int et, int lane, u32x4 (&Ar)[8], u32x4 (&Br)[4]) {
#pragma unroll
    for (int f = 0; f < 8; ++f) Ar[f] = *(const u32x4*)(An_g + uid * 4096 + (f * 64 + lane) * 8);
#pragma unroll
    for (int dt = 0; dt < 2; ++dt) { const u32x4* bp = (const u32x4*)(Bn_g + uid * 2048 + ((dt * 2 + et) * 64 + lane) * 8); Br[2 * dt] = bp[0]; Br[2 * dt + 1] = bp[1]; }
}
DI void dn2_step(bf16_t* Sn_g, size_t uid, int et, int lane, f32x16 (&S)[2], const u32x4 (&Ar)[8], const u32x4 (&Br)[4]) {
    bf16x8 Sp[2][2];
#pragma unroll
    for (int dp = 0; dp < 2; ++dp)
#pragma unroll
        for (int s = 0; s < 2; ++s) { Sp[dp][s] = pack8(S[dp], s); *(bf16x8*)(Sn_g + uid * 4096 + (((et * 2 + dp) * 2 + s) * 64 + lane) * 8) = Sp[dp][s]; }
#pragma unroll
    for (int dt = 0; dt < 2; ++dt) { f32x16 z;
#pragma unroll
        for (int h2 = 0; h2 < 2; ++h2) { const u32x4 w = Br[2 * dt + h2]; z[8 * h2] = bflo(w.x); z[8 * h2 + 1] = bfhi(w.x); z[8 * h2 + 2] = bflo(w.y); z[8 * h2 + 3] = bfhi(w.y); z[8 * h2 + 4] = bflo(w.z); z[8 * h2 + 5] = bfhi(w.z); z[8 * h2 + 6] = bflo(w.w); z[8 * h2 + 7] = bfhi(w.w); }
#pragma unroll
        for (int dp = 0; dp < 2; ++dp)
#pragma unroll
            for (int s = 0; s < 2; ++s) z = MFMA32(__builtin_bit_cast(bf16x8, Ar[(dt * 2 + dp) * 2 + s]), Sp[dp][s], z);
        S[dt] = z; }
}
DI void phase_dn2(const Frame& F0, const Params& P) {
    const Frame F = relaunder(F0);
    const bf16_t* An_g = wsp<bf16_t>(P, WS_AN); const unsigned* Bn_g = wsp<unsigned>(P, WS_BN); bf16_t* Sn_g = wsp<bf16_t>(P, WS_SN);
    const int lane = F.lane;
    constexpr int NCHAIN = NB * NH * 2 * 2;
    if (F.wave < 4)
    for (int cid = F.bid * 4 + F.wave; cid < NCHAIN; cid += F.G * 4) {
        const int et = cid & 1; const size_t uid0 = (size_t)(cid >> 1) * NCH;
        f32x16 S[2] = {zero16(), zero16()};
        u32x4 A0[8], A1[8], A2[8], B0[4], B1[4], B2[4];
        dn2_load(An_g, Bn_g, uid0, et, lane, A0, B0);
        dn2_load(An_g, Bn_g, uid0 + (1 < NCH ? 1 : 0), et, lane, A1, B1);
        dn2_load(An_g, Bn_g, uid0 + (2 < NCH ? 2 : 0), et, lane, A2, B2);
        for (int n = 0; n < NCH; n += 3) {
            dn2_step(Sn_g, uid0 + n, et, lane, S, A0, B0);
            dn2_load(An_g, Bn_g, uid0 + (n + 3 < NCH ? n + 3 : n), et, lane, A0, B0);
            if (n + 1 < NCH) { dn2_step(Sn_g, uid0 + n + 1, et, lane, S, A1, B1); dn2_load(An_g, Bn_g, uid0 + (n + 4 < NCH ? n + 4 : n), et, lane, A1, B1); }
            if (n + 2 < NCH) { dn2_step(Sn_g, uid0 + n + 2, et, lane, S, A2, B2); dn2_load(An_g, Bn_g, uid0 + (n + 5 < NCH ? n + 5 : n), et, lane, A2, B2); }
        }
    }
}

DI void phase_dn3(const Frame& F0, const Params& P, const int l, const int pidx, const int np) {
    const Frame F = relaunder(F0);
    const bf16_t* Qe_g = wsp<bf16_t>(P, WS_QE); const bf16_t* Sn_g = wsp<bf16_t>(P, WS_SN); const float* Oi_g = wsp<float>(P, WS_OI);
    const bf16_t* proj = wsp<bf16_t>(P, WS_PROJ); bf16_t* mix = wsp<bf16_t>(P, WS_MIX); const float* ng = P.in[I_DNG] + l * 64;
    const int lane = F.lane, r32 = lane & 31, hh = lane >> 5;
    const int NC = NCL + ((l < DEPTH - 1) ? NCC : 0);
    for (int u = F.wave * np + pidx; u < NB * NH * NC; u += np * 8) {
        const int ca = u % NC, h = (u / NC) % NH, b = u / (NC * NH);
        int rowb, nf, nbk; if (ca < NCL) { rowb = b * SEQ + 64 * ca; nf = NCC + ca; nbk = NCC + (NCL - 1 - ca); } else { const int c = ca - NCL; rowb = R_LAT + b * CTX + 64 * c; nf = c; nbk = NCC - 1 - c; }
        f32x16 O[2][2] = {{zero16(), zero16()}, {zero16(), zero16()}};
#pragma unroll
        for (int dir = 0; dir < 2; ++dir) { const size_t uid = (size_t)((b * NH + h) * 2 + dir) * NCH + (dir ? nbk : nf);
#pragma unroll
            for (int it = 0; it < 2; ++it) { const int x = 32 * it + r32, xi = dir ? 63 - x : x;
                bf16x8 Bq[2][2];
#pragma unroll
                for (int dp = 0; dp < 2; ++dp)
#pragma unroll
                    for (int s = 0; s < 2; ++s) { const bf16_t* p = Qe_g + uid * 4096 + xi * 64 + 32 * dp + 16 * s + 4 * hh; Bq[dp][s] = cat44(*(const u32x2*)p, *(const u32x2*)(p + 8)); }
#pragma unroll
                for (int et = 0; et < 2; ++et) { f32x16 z = O[et][it];
#pragma unroll
                    for (int dp = 0; dp < 2; ++dp)
#pragma unroll
                        for (int s = 0; s < 2; ++s) z = MFMA32(*(const bf16x8*)(Sn_g + uid * 4096 + (((et * 2 + dp) * 2 + s) * 64 + lane) * 8), Bq[dp][s], z);
#pragma unroll
                    for (int a = 0; a < 4; ++a) { const f32x4 oi = *(const f32x4*)(Oi_g + uid * 4096 + xi * 64 + 32 * et + 8 * a + 4 * hh); z[4 * a] += oi.x; z[4 * a + 1] += oi.y; z[4 * a + 2] += oi.z; z[4 * a + 3] += oi.w; }
                    O[et][it] = z; } } }
#pragma unroll
        for (int it = 0; it < 2; ++it) { const size_t row = (size_t)rowb + 32 * it + r32; float ss = 0.f;
#pragma unroll
            for (int et = 0; et < 2; ++et)
#pragma unroll
                for (int reg = 0; reg < 16; ++reg) ss += O[et][it][reg] * O[et][it][reg];
            ss += __shfl_xor(ss, 32);
            const float r = 1.0f / sqrtf(ss * (1.0f / 64.0f) + RMS_EPS);
#pragma unroll
            for (int et = 0; et < 2; ++et)
#pragma unroll
                for (int a = 0; a < 4; ++a) { const int e0 = 32 * et + 8 * a + 4 * hh; const f32x4 g = *(const f32x4*)(ng + e0); const u32x2 gt = *(const u32x2*)(proj + row * PLD + 6 * 256 + h * 64 + e0);
                    const f32x16& z = O[et][it];
                    u32x2 o; o.x = pk2(z[4 * a] * r * g.x * siluf(bflo(gt.x)), z[4 * a + 1] * r * g.y * siluf(bfhi(gt.x))); o.y = pk2(z[4 * a + 2] * r * g.z * siluf(bflo(gt.y)), z[4 * a + 3] * r * g.w * siluf(bfhi(gt.y)));
                    *(u32x2*)(mix + row * D + 256 + h * 64 + e0) = o; } }
    }
}

struct TileInfo { int row0, dyb, kc0; };
#ifdef EMU
DI s16x4 lds_tr16(const LAS unsigned char* p) {
    emu::Wave* w = emu::cur->wave; const int lane = emu::cur->lane;
    const int slot = emu::rendezvous(&p, sizeof(p), [](emu::Wave*, int) {});
    s16x4 r; const int g = lane >> 4, i = lane & 15;
    for (int q = 0; q < 4; ++q) { const unsigned char* a; memcpy(&a, w->stage[slot][16 * g + 4 * q + (i >> 2)], sizeof(a)); short v; memcpy(&v, a + 2 * (i & 3), 2); r[q] = v; }
    emu::rendezvous(nullptr, 0, [](emu::Wave*, int) {});
    return r;
}
#else
DI s16x4 lds_tr16(const LAS unsigned char* p) { return __builtin_amdgcn_ds_read_tr16_b64_v4i16((LAS s16x4*)p); }
#endif
DI int att_off(int row, int ch) { return 256 * row + 16 * (ch ^ (((row & 3) << 2) | ((row >> 2) & 3))); }
template <int NMAP, int TC, int SUBS, class TF>
DI void attn_core(const Frame& F, LAS unsigned char* lds, const bf16_t* proj, const bool active, const int qrow, const int qcol, const int kcol, const int vcol, const int hoff,
                  const int ntiles32, const TF& tf, const float sc, const LAS float* bias, const int qc, float (&mS)[NMAP], float (&lS)[NMAP], f32x16 (&O)[NMAP][2]) {
    static_assert(SUBS == 1, "one 32-key tile per stage");
    constexpr int KS = 4 / NMAP, NIMG = TC / 64, BUFB = NIMG * 8192, PIECES = 4 * TC, PPT = (2 * PIECES + 511) / 512, CPR = TC / 8;
    constexpr bool FULL = (2 * PIECES) % 512 == 0;
    const int ntiles = ntiles32;
    const int lane = F.lane, r32 = lane & 31, hh = lane >> 5, tid = F.tid;
    const int c0q = (qc - 8 < 0) ? 0 : ((qc - 8 > 48) ? 48 : qc - 8);
    (void)sc;
    bf16x8 qf[NMAP][KS];
#pragma unroll
    for (int mi = 0; mi < NMAP; ++mi)
#pragma unroll
        for (int ks = 0; ks < KS; ++ks) qf[mi][ks] = *(const bf16x8*)(proj + (size_t)(active ? qrow : 0) * PLD + qcol + mi * 32 + ks * 16 + hh * 8);
#pragma unroll
    for (int mi = 0; mi < NMAP; ++mi) { mS[mi] = 0.f; lS[mi] = 0.f; O[mi][0] = zero16(); O[mi][1] = zero16(); }
    u32x4 stg[PPT], stg2[PPT];
#define ATT_LOAD(ti_, dst_) do { _Pragma("unroll") for (int j = 0; j < PPT; ++j) { const int idx = tid + 512 * j; if (FULL || idx < 2 * PIECES) { const bool isV = idx >= PIECES; const int p = isV ? idx - PIECES : idx; \
        dst_[j] = *(const u32x4*)(proj + (size_t)((ti_).row0 + p / CPR) * PLD + (isV ? vcol : kcol) + (p % CPR) * 8); } } } while (0)
#define ATT_STORE_FROM(buf_, src_) do { _Pragma("unroll") for (int j = 0; j < PPT; ++j) { const int idx = tid + 512 * j; if (FULL || idx < 2 * PIECES) { const bool isV = idx >= PIECES; const int p = isV ? idx - PIECES : idx; const int cc = p % CPR; \
        *(LAS u32x4*)(lds + (buf_) * BUFB + (cc >> 3) * 8192 + att_off(p / CPR, (cc & 7) + (isV ? 8 : 0))) = src_[j]; } } } while (0)
    const int img = hoff / 64 * 8192;
    int kaddr[4];
#pragma unroll
    for (int s = 0; s < 4; ++s) kaddr[s] = img + att_off(r32, 2 * s + hh);
    const int trq = (lane & 15) >> 2, trp = lane & 3, trb = (lane >> 4) & 1;
    int vaddr[2][2][2];
#pragma unroll
    for (int dt = 0; dt < 2; ++dt)
#pragma unroll
        for (int s2 = 0; s2 < 2; ++s2)
#pragma unroll
            for (int t = 0; t < 2; ++t) vaddr[dt][s2][t] = img + att_off(16 * s2 + 8 * t + 4 * hh + trq, 8 + 4 * dt + 2 * trb + (trp >> 1)) + 8 * (trp & 1);
    f32x16 negm[NMAP], Lacc[NMAP];
#pragma unroll
    for (int mi = 0; mi < NMAP; ++mi) { negm[mi] = zero16(); Lacc[mi] = zero16(); }
    const bf16x8 ones8 = {(short)0x3f80, (short)0x3f80, (short)0x3f80, (short)0x3f80, (short)0x3f80, (short)0x3f80, (short)0x3f80, (short)0x3f80};
    auto compute = [&](const int buf, const TileInfo ti, const bool first) {
        if (active) {
            const LAS unsigned char* Tb = lds + buf * BUFB;
            bf16x8 vf[2][2];
#pragma unroll
            for (int dt = 0; dt < 2; ++dt)
#pragma unroll
                for (int s2 = 0; s2 < 2; ++s2) { const s16x4 lo = lds_tr16(Tb + vaddr[dt][s2][0]), hi = lds_tr16(Tb + vaddr[dt][s2][1]);
                    vf[dt][s2] = __builtin_shufflevector(lo, hi, 0, 1, 2, 3, 4, 5, 6, 7); }
#pragma unroll
            for (int mi = 0; mi < NMAP; ++mi) {
                f32x16 st = negm[mi];
#pragma unroll
                for (int ks = 0; ks < KS; ++ks) st = MFMA32(*(const LAS bf16x8*)(Tb + kaddr[mi * KS + ks]), qf[mi][ks], st);
                float tmax = -3.0e38f;
                if (ti.dyb >= 0) {
#pragma unroll
                    for (int reg = 0; reg < 16; ++reg) { const int kc = ti.kc0 + crow(reg, hh); const bool ok = (kc >= c0q) && (kc < c0q + 16); const float bv = bias[ti.dyb + (ok ? kc - qc + 15 : 0)];
                        const float x = ok ? st[reg] + bv : -1.0e30f; st[reg] = x; tmax = fmaxf(tmax, x); }
                } else {
#pragma unroll
                    for (int reg = 0; reg < 16; ++reg) tmax = fmaxf(tmax, st[reg]);
                }
                tmax = fmaxf(tmax, __shfl_xor(tmax, 32));
                if (first || __any(tmax > 6.0f)) { const float delta = first ? tmax : fmaxf(tmax, 0.f), alpha = fexp2(-delta);
                    if (!first) { Lacc[mi] = Lacc[mi] * alpha; O[mi][0] = O[mi][0] * alpha; O[mi][1] = O[mi][1] * alpha; }
                    negm[mi] = negm[mi] - delta; st = st - delta; }
#pragma unroll
                for (int reg = 0; reg < 16; ++reg) st[reg] = fexp2(st[reg]);
#pragma unroll
                for (int s2 = 0; s2 < 2; ++s2) { const bf16x8 pf = pack8(st, s2);
                    Lacc[mi] = MFMA32(ones8, pf, Lacc[mi]);
#pragma unroll
                    for (int dt = 0; dt < 2; ++dt) O[mi][dt] = MFMA32(vf[dt][s2], pf, O[mi][dt]); }
            }
        }
    };
    constexpr int NSTG = (PPT == 1) ? 4 : 2;
    u32x4 stg3[PPT], stg4[PPT];
    { const TileInfo t0 = tf(0); ATT_LOAD(t0, stg); }
    { const TileInfo t1 = tf(1 < ntiles ? 1 : 0); ATT_LOAD(t1, stg2); }
    if (NSTG == 4) { { const TileInfo t2 = tf(2 < ntiles ? 2 : 0); ATT_LOAD(t2, stg3); } { const TileInfo t3 = tf(3 < ntiles ? 3 : 0); ATT_LOAD(t3, stg4); } }
#define ATT_STEP(k_, reg_) do { ATT_STORE_FROM((k_) & 1, reg_); \
        WAIT_LGKM(0); __builtin_amdgcn_s_barrier(); CFENCE();     \
        { const int nx = (i + (k_) + NSTG < ntiles) ? i + (k_) + NSTG : ntiles - 1; const TileInfo tn = tf(nx); ATT_LOAD(tn, reg_); } \
        compute((k_) & 1, tf(i + (k_)), i + (k_) == 0); } while (0)
    for (int i = 0; i < ntiles; i += NSTG) {
        ATT_STEP(0, stg); ATT_STEP(1, stg2);
        if (NSTG == 4) { ATT_STEP(2, stg3); ATT_STEP(3, stg4); }
    }
#undef ATT_STEP
#pragma unroll
    for (int mi = 0; mi < NMAP; ++mi) lS[mi] = 0.5f * Lacc[mi][0];
    __syncthreads();
#undef ATT_LOAD
#undef ATT_STORE_FROM
}

constexpr int NCHB = (NB * NH * 4 + 3) / 4;
DI bool chain_dedicated(int G) { return G >= 4 * NCHB; }
constexpr int NA_BUFB = 4 * 8192;
constexpr int NA_BIAS_OFF = 2 * NA_BUFB;
template <int PART> DI void phase_attn(const Frame& F0, const Params& P, const int l, const bool lat_on = true, const bool ctx_on = true, const int Gd = 0, const int cd = 0) {
    const Frame F = relaunder(F0);
    const bf16_t* proj = wsp<bf16_t>(P, WS_PROJ); bf16_t* mix = wsp<bf16_t>(P, WS_MIX);
    const bool last = (l == DEPTH - 1);
    const int lane = F.lane, r32 = lane & 31, hh = lane >> 5, wave = F.wave;
    LAS float* bias = (LAS float*)(F.lds + NA_BIAS_OFF);
    const bool dedicated = chain_dedicated(F.G); const int first = dedicated ? NCHB : 0;
    if (PART == 0 && (!dedicated || F.bid >= NCHB)) {
    for (int i = F.tid; i < 4 * 465; i += 512) bias[i] = P.in[I_RPB][(size_t)l * 4 * 465 + i] * LOG2E;
    __syncthreads();
    { const int nlat = NB * GROWS, nctx = last ? 0 : NB * (CTX / 64);
      for (int uq = F.bid - first; uq < nlat + nctx; uq += F.G - first) {
        const int u = (uq < nlat && nlat % 8 == 0) ? (uq % 8) * (nlat / 8) + uq / 8 : uq;
        const int h = wave >> 1, qh = wave & 1; int qrow, ntiles, b, r = 0, wstart = 0; const int nct = CTX / 32;
        if (u < nlat) { b = u / GROWS; r = u % GROWS; qrow = b * SEQ + r * 64 + qh * 32 + r32; int ws = r - WH / 2; ws = ws < 0 ? 0 : (ws > GROWS - WH ? GROWS - WH : ws); wstart = ws; ntiles = nct + 2 * WH; }
        else { const int uu = u - nlat; b = uu / (CTX / 64); qrow = R_LAT + b * CTX + (uu % (CTX / 64)) * 64 + qh * 32 + r32; ntiles = nct; }
        auto tf = [&](int i) { TileInfo t; if (i < nct) { t.row0 = R_LAT + b * CTX + 32 * i; t.dyb = -1; t.kc0 = 0; } else { const int w = (i - nct) >> 1, half = (i - nct) & 1, wrow = wstart + w; t.row0 = b * SEQ + wrow * 64 + 32 * half; t.dyb = (wrow - r + 7) * 31; t.kc0 = 32 * half; } return t; };
        float mS[1], lS[1]; f32x16 O[1][2];
        attn_core<1, 256, 1>(F, F.lds, proj, true, qrow, h * 64, 256, 512, 64 * h, ntiles, tf, 0.125f * LOG2E, bias + h * 465, qh * 32 + r32, mS, lS, O);
        const float inv = 1.0f / (lS[0] + __shfl_xor(lS[0], 32));
#pragma unroll
        for (int dt = 0; dt < 2; ++dt)
#pragma unroll
            for (int a = 0; a < 4; ++a) { const int d0 = 32 * dt + 8 * a + 4 * hh; u32x2 o; o.x = pk2(O[0][dt][4 * a] * inv, O[0][dt][4 * a + 1] * inv); o.y = pk2(O[0][dt][4 * a + 2] * inv, O[0][dt][4 * a + 3] * inv);
                *(u32x2*)(mix + (size_t)qrow * D + h * 64 + d0) = o; }
      } }
    }
    if (PART == 1) { const float lam_init = 0.8f - 0.6f * expf(-0.3f * (float)l);
      const float* dl = P.in[I_DFLAM] + (size_t)l * 128; const float p1 = (lane < 32) ? dl[lane] * dl[32 + lane] : 0.f, p2 = (lane < 32) ? dl[64 + lane] * dl[96 + lane] : 0.f;
      const float lam = expf(wave_sum(p1)) - expf(wave_sum(p2)) + lam_init;
      const float* dg = P.in[I_DFG] + l * 64;
      constexpr int QBL = SEQ / 256, QBC = (CTX + 255) / 256; const int nlat = lat_on ? NB * NH * QBL : 0, nctx = (last || !ctx_on) ? 0 : NB * NH * QBC; const int nct = CTX / 32;
      for (int u0 = cd; u0 < nlat + nctx; u0 += Gd) {
        const int ul = u0 - nctx, u = (u0 < nctx) ? nlat + u0 : ((nlat % 8 == 0) ? (ul % 8) * (nlat / 8) + ul / 8 : ul);
        int b, h, qrow, ntiles; bool active = true;
        if (u < nlat) { const int qb = u % QBL; h = (u / QBL) % NH; b = u / (QBL * NH); qrow = b * SEQ + qb * 256 + 32 * wave + r32; ntiles = nct + SEQ / 32; }
        else { const int uu = u - nlat, qb = uu % QBC; h = (uu / QBC) % NH; b = uu / (QBC * NH); active = (qb * 256 + 32 * wave) < CTX; qrow = R_LAT + b * CTX + qb * 256 + 32 * wave + r32; ntiles = nct; }
        auto tf = [&](int i) { TileInfo t; t.row0 = (i < nct) ? R_LAT + b * CTX + 32 * i : b * SEQ + 32 * (i - nct); t.dyb = -1; t.kc0 = 0; return t; };
        float mS[2], lS[2]; f32x16 O[2][2];
        attn_core<2, 64, 1>(F, F.lds, proj, active, qrow, 7 * 256 + h * 64, 8 * 256 + h * 64, 9 * 256 + h * 64, 0, ntiles, tf, 0.17677669529663687f * LOG2E, bias, 0, mS, lS, O);
        if (active) {
            const float i1 = 1.0f / (lS[0] + __shfl_xor(lS[0], 32)), i2 = lam / (lS[1] + __shfl_xor(lS[1], 32));
            float ss = 0.f;
#pragma unroll
            for (int dt = 0; dt < 2; ++dt)
#pragma unroll
                for (int reg = 0; reg < 16; ++reg) { const float o = O[0][dt][reg] * i1 - O[1][dt][reg] * i2; O[0][dt][reg] = o; ss += o * o; }
            ss += __shfl_xor(ss, 32);
            const float rr = (1.0f - lam_init) / sqrtf(ss * (1.0f / 64.0f) + RMS_EPS);
#pragma unroll
            for (int dt = 0; dt < 2; ++dt)
#pragma unroll
                for (int a = 0; a < 4; ++a) { const int d0 = 32 * dt + 8 * a + 4 * hh; const f32x4 g = *(const f32x4*)(dg + d0);
                    u32x2 o; o.x = pk2(O[0][dt][4 * a] * rr * g.x, O[0][dt][4 * a + 1] * rr * g.y); o.y = pk2(O[0][dt][4 * a + 2] * rr * g.z, O[0][dt][4 * a + 3] * rr * g.w);
                    *(u32x2*)(mix + (size_t)qrow * D + 512 + h * 64 + d0) = o; }
        }
      } }
}
DI void phase_ftreduce(const Frame& F0, const Params& P, const int l, const int pidx, const int np, const bool lat_on, const bool ctx_on) {
    const Frame F = relaunder(F0);
    const float* slab = wsp<float>(P, WS_SLAB); const float* slabc = wsp<float>(P, WS_SLABC); bf16_t* mix = wsp<bf16_t>(P, WS_MIX);
    const int gt = pidx * 512 + F.tid, ngt = np * 512;
    const int nl = lat_on ? R_LAT * 64 : 0, nc = (ctx_on && l < DEPTH - 1) ? R_CTX * 64 : 0;
    constexpr size_t SLABSZ = (size_t)NB * HSEQ * 64;
    for (int i = gt; i < nl + nc; i += ngt) {
        f32x4 v; int row; int c4;
        if (i < nl) { row = i / 64; c4 = i % 64; const int b = row / SEQ, k = row % SEQ;
            if (k == 0) continue;
            const int kk = (k <= HSEQ) ? k : SEQ - k; const size_t o = ((size_t)b * HSEQ + kk - 1) * 64 + c4;
            f32x4 p = *((const f32x4*)slab + o), q = *((const f32x4*)slab + (size_t)KSPLIT * SLABSZ + o);
#pragma unroll
            for (int ks = 1; ks < KSPLIT; ++ks) { p += *((const f32x4*)slab + (size_t)ks * SLABSZ + o); q += *((const f32x4*)slab + (size_t)(KSPLIT + ks) * SLABSZ + o); }
            v = (k <= HSEQ) ? p + q : p - q; }
        else { const int j = i - nl; row = R_LAT + j / 64; c4 = j % 64; v = *((const f32x4*)slabc + j); }
        u32x2 o; o.x = pk2(v.x, v.y); o.y = pk2(v.z, v.w); *(u32x2*)(mix + (size_t)row * D + 768 + 4 * c4) = o;
    }
    if (lat_on) { const bf16_t* ztl = wsp<bf16_t>(P, WS_ZTL); const float sc = 1.0f / sqrtf((float)SEQ);
      for (int u = F.wave * np + pidx; u < NB * 256; u += np * 8) { const bf16_t* zr = ztl + (size_t)u * 2 * SEQ; float s = 0.f;
          for (int t = 8 * F.lane; t < SEQ; t += 512) { const u32x4 w = *(const u32x4*)(zr + t); s += (bflo(w.x) + bfhi(w.x)) + (bflo(w.y) + bfhi(w.y)) + (bflo(w.z) + bfhi(w.z)) + (bflo(w.w) + bfhi(w.w)); }
          s = wave_sum(s);
          if (F.lane == 0) mix[((size_t)(u / 256) * SEQ) * D + 768 + (u % 256)] = f2bf(s * sc); } }
}

#define REP_P0 1
#define REP_PROJ 1
#define REP_DN0 1
#define REP_DN1 1
#define REP_CHAIN 1
#define REP_DFT 1
#define REP_ATT 1
#define REP_N2 1
#define REP_TOPK 1
#define REP_GU 1
#define REP_DOWN 1
__global__ void __launch_bounds__(512, 2) fwd_kernel(Params P) {
#ifdef EMU
    unsigned char* lds_raw = emu::cur->blk->lds;
#else
    extern __shared__ __attribute__((aligned(16))) unsigned char lds_raw[];
#endif
    Frame F; F.lds = (LAS unsigned char*)lds_raw; F.tid = threadIdx.x; F.lane = F.tid & 63; F.wave = __builtin_amdgcn_readfirstlane(F.tid >> 6);
    F.G = gridDim.x; F.bid = blockIdx.x; F.gw = F.wave * F.G + F.bid; F.ngw = F.G * 8;
    volatile LAS unsigned* misc = (volatile LAS unsigned*)(F.lds + LDS_MISC);
    if (F.tid < 64) misc[F.tid] = 0u;
    __syncthreads();
    XcdBarrier bar = xcd_barrier_post(wsp<unsigned>(P, WS_CTL) + CW_BAR, misc + 8);
#define GRID_BAR() xcd_barrier(bar)
#ifdef EMU
    const int emu_stop = getenv("EMU_STOP") ? atoi(getenv("EMU_STOP")) : -1;
#define EMU_STOP(l, ph) do { if (emu_stop == (l) * 100 + (ph)) return; } while (0)
#else
#define EMU_STOP(l, ph)
#endif

#pragma unroll
        for (int rep_ = 0; rep_ < REP_P0; ++rep_) {
    p0_weights(F, P);
    __syncthreads();
    p0_mod(F, P);
    p0_misc(F, P);
    GRID_BAR();
        }
    { SchedW S{F.G, F.bid, (const char*)wsp<bf16_t>(P, WS_MZT), (const char*)wsp<bf16_t>(P, WS_WFT)}; EpiW E{wsp<bf16_t>(P, WS_WIN)};
      g8::gemm_phase<EpiW, SchedW, false>(F.lds, 256, 256, S, E); }
    phase_norm1(F, P, 0);
    GRID_BAR();
    for (int l = 0; l < DEPTH; ++l) {
        const int last = (l == DEPTH - 1) ? 1 : 0;
        if (l > 0) { phase_norm1(F, P, l); GRID_BAR(); }
        EMU_STOP(l, 1);
#pragma unroll
        for (int rep_ = 0; rep_ < REP_PROJ; ++rep_) {
        { SchedProj S{F.G, F.bid, last, (const char*)wsp<bf16_t>(P, WS_H), (const char*)(wsp<bf16_t>(P, WS_WIN) + (size_t)l * NPROJ * D)};
          EpiProj E{wsp<bf16_t>(P, WS_PROJ), wsp<float>(P, WS_AB), wsp<bf16_t>(P, WS_ZTL), wsp<bf16_t>(P, WS_ZTC), wsp<float>(P, WS_ROPE)};
          g8::gemm_phase<EpiProj, SchedProj, false>(F.lds, D, D, S, E); }
        GRID_BAR();
        }
        EMU_STOP(l, 2);
#pragma unroll
        for (int rep_ = 0; rep_ < REP_DN0; ++rep_) {
        phase_dn0(F, P, l);
        GRID_BAR();
        }
        EMU_STOP(l, 3);
#pragma unroll
        for (int rep_ = 0; rep_ < REP_DN1; ++rep_) {
        { SchedDft S{F.G, F.bid, 1, (!last && !chain_dedicated(F.G)) ? 1 : 0, (const char*)wsp<bf16_t>(P, WS_DFTL), (const char*)wsp<bf16_t>(P, WS_DFTC), (const char*)wsp<bf16_t>(P, WS_ZTL), (const char*)wsp<bf16_t>(P, WS_ZTC)};
          EpiDft E{wsp<float>(P, WS_SLAB), wsp<bf16_t>(P, WS_MIX)};
          g8::gemm_phase<EpiDft, SchedDft, false>(F.lds, 2 * SEQ, 2 * SEQ, S, E); }
        phase_dn1(F, P);
        GRID_BAR();
        }
        EMU_STOP(l, 4);
#pragma unroll
        for (int rep_ = 0; rep_ < REP_CHAIN; ++rep_) {
        phase_dn2(F, P);
        unsigned* chc = wsp<unsigned>(P, WS_CTL) + CW_CHC + 64 * l;
        if (chain_dedicated(F.G) && F.bid < NCHB) {
            WAIT_VM(0);
            __syncthreads();
            if (F.tid == 0) { __builtin_amdgcn_fence(__ATOMIC_RELEASE, "agent"); WAIT_VM(0); (void)xb_add(chc, 1u); }
        }
        if (chain_dedicated(F.G) && F.bid < NCHB && !last) {
            __syncthreads();
            phase_attn<1>(F, P, l, false, true, NCHB, F.bid);
        }
        phase_attn<0>(F, P, l);
        if (chain_dedicated(F.G) && F.bid >= NCHB) {
            constexpr int ND = (CTX / 256) * NB;
            const int nb_na = F.G - NCHB, units = NB * GROWS + (last ? 0 : NB * (CTX / 64)), extra = units % nb_na, idx = F.bid - NCHB;
            const int nd = last ? 0 : ((nb_na - extra > ND) ? ND : 1), keep = (nb_na - extra > ND) ? 0 : 1;
            if (idx >= extra && idx < extra + nd) {
                SchedDft S{nd, idx - extra, 0, 1, (const char*)wsp<bf16_t>(P, WS_DFTL), (const char*)wsp<bf16_t>(P, WS_DFTC), (const char*)wsp<bf16_t>(P, WS_ZTL), (const char*)wsp<bf16_t>(P, WS_ZTC)};
                EpiDft E{wsp<float>(P, WS_SLAB), wsp<bf16_t>(P, WS_MIX)};
                g8::gemm_phase<EpiDft, SchedDft, false>(F.lds, 2 * SEQ, 2 * SEQ, S, E); }
            const int skip = keep ? 0 : nd;
            if (idx >= extra + skip) { phase_ftreduce(F, P, l, idx - extra - skip, nb_na - extra - skip, true, false);
                { unsigned sp = 0u; while (xb_ld(chc) < (unsigned)NCHB) { __builtin_amdgcn_s_sleep(2); if (++sp > (1u << 22)) break; } }
                __builtin_amdgcn_fence(__ATOMIC_ACQUIRE, "agent");
                phase_dn3(F, P, l, idx - extra - skip, nb_na - extra - skip); }
        }
        GRID_BAR();
        }
        EMU_STOP(l, 5);
#pragma unroll
        for (int rep_ = 0; rep_ < REP_ATT; ++rep_) {
        if (!chain_dedicated(F.G)) phase_dn3(F, P, l, F.bid, F.G);
        phase_attn<1>(F, P, l, true, !chain_dedicated(F.G), F.G, F.bid);
        if (!chain_dedicated(F.G)) phase_ftreduce(F, P, l, F.bid, F.G, true, false);
        GRID_BAR();
        }
        EMU_STOP(l, 7);
        { SchedOut S{F.G, F.bid, last, (const char*)wsp<bf16_t>(P, WS_MIX), (const char*)(wsp<bf16_t>(P, WS_WOUT) + (size_t)l * D * D)};
          EpiOut E{wsp<bf16_t>(P, WS_DMIX), wsp<float>(P, WS_MODL) + (size_t)l * NB * 6 * D + 2 * D, wsp<float>(P, WS_MODC) + (size_t)l * 6 * D + 2 * D};
          g8::gemm_phase<EpiOut, SchedOut, false>(F.lds, D, D, S, E); }
        GRID_BAR();
        EMU_STOP(l, 8);
#pragma unroll
        for (int rep_ = 0; rep_ < REP_N2; ++rep_) {
        phase_norm2(F, P, l);
        GRID_BAR();
        }
        EMU_STOP(l, 9);
#pragma unroll
        for (int rep_ = 0; rep_ < REP_TOPK; ++rep_) {
        phase_topk(F, P, l);
        GRID_BAR();
        }
        EMU_STOP(l, 10);
        const int epan = (last ? EROWS_LAT_PAD : EROWS_PAD) / 256;
#pragma unroll
        for (int rep_ = 0; rep_ < REP_GU; ++rep_) {
        { SchedGU S{F.G, F.bid, epan, (const char*)wsp<bf16_t>(P, WS_H), (const char*)(wsp<bf16_t>(P, WS_WGU) + (size_t)l * NEXP * 2 * DEXP * D), wsp<int>(P, WS_RIDX)};
          EpiGU E{wsp<bf16_t>(P, WS_HID)};
          g8::gemm_phase<EpiGU, SchedGU, true>(F.lds, D, D, S, E); }
        GRID_BAR();
        }
        EMU_STOP(l, 11);
#pragma unroll
        for (int rep_ = 0; rep_ < REP_DOWN; ++rep_) {
        { SchedDown S{F.G, F.bid, epan, (const char*)wsp<bf16_t>(P, WS_HID), (const char*)(wsp<bf16_t>(P, WS_WD) + (size_t)l * NEXP * D * DEXP)};
          EpiDown E{wsp<bf16_t>(P, WS_Y), wsp<float>(P, WS_GATEV)};
          g8::gemm_phase<EpiDown, SchedDown, false>(F.lds, DEXP, DEXP, S, E); }
        GRID_BAR();
        }
        EMU_STOP(l, 12);
    }
    phase_norm1(F, P, DEPTH);
}

extern "C" void kernel_launch(void* const* d_in, const int* in_sizes, int n_in, void* d_out, int out_size, void* d_ws, size_t ws_size, hipStream_t stream) {
    static int grid = 0;
    if (grid == 0) {
        if (n_in != 23 || ws_size < WS_END) { fprintf(stderr, "kernel_launch: expected 23 inputs and >= %zu bytes of workspace (got %d, %zu)\n", (size_t)WS_END, n_in, ws_size); grid = -1; return; }
#ifdef EMU
        const char* g = getenv("EMU_GRID"); grid = g ? atoi(g) : 3;
#else
        int dev = 0, cus = 0;
        if (hipGetDevice(&dev) != hipSuccess || hipDeviceGetAttribute(&cus, hipDeviceAttributeMultiprocessorCount, dev) != hipSuccess) { grid = -1; return; }
        if (hipFuncSetAttribute((const void*)fwd_kernel, hipFuncAttributeMaxDynamicSharedMemorySize, LDS_BYTES) != hipSuccess) { fprintf(stderr, "kernel_launch: hipFuncSetAttribute failed\n"); grid = -1; return; }
        int per_cu = 0;
        if (hipOccupancyMaxActiveBlocksPerMultiprocessor(&per_cu, (const void*)fwd_kernel, 512, LDS_BYTES) != hipSuccess || per_cu < 1) fprintf(stderr, "kernel_launch: occupancy query says %d\n", per_cu);
        (void)hipGetLastError();
        grid = cus;
#endif
    }
    if (grid < 0) return;
    (void)in_sizes; (void)out_size;
    hipMemsetAsync((char*)d_ws + WS_CTL, 0, CTL_BYTES, stream);
    Params p{};
    for (int i = 0; i < 23; ++i) p.in[i] = (const float*)d_in[i];
    p.out = (float*)d_out; p.ws = (unsigned char*)d_ws;
#ifdef EMU
    emu::launch([=]() { fwd_kernel(p); }, grid, 512, LDS_BYTES);
#else
    hipLaunchKernelGGL(fwd_kernel, dim3(grid), dim3(512), LDS_BYTES, stream, p);
#endif
}
```
